# Optimizing an MI355X kernel written in HIP

```python
import math
import jax, jax.numpy as jnp
from jax import lax
import numpy as np

D_MODEL = 1024
BATCH = 16
SEQ = 4096
DEPTH = 4

D_MIX = D_MODEL
D_HYENA = D_MIX // 2
D_FNET = D_MIX - D_HYENA
FNET_GROUPS = 8
FNET_GROUP_DIM = D_FNET // FNET_GROUPS
HYENA_ORDER = 2
D_IN_PROJ = (HYENA_ORDER + 1) * D_HYENA + D_FNET
SHORT_CONV = 3
FILTER_BANDS = 16
FILTER_EMB = 2 * FILTER_BANDS + 1
FILTER_HIDDEN = 64
N_DIRS = 2
DECAY_TARGET = 1e-2
FAST_DECAY_PCT = 0.3
SLOW_DECAY_PCT = 1.5
D_FF = 2816
FFN_CONV = 3
N_MOD = 6
NORM_EPS = 1e-6
FILTER_EPS = 1e-6

kernel_name = "hyena_fnet_hybrid_encoder"


def _rmsnorm(x, g):
    xf = x.astype(jnp.float32)
    y = xf * lax.rsqrt(jnp.mean(xf * xf, axis=-1, keepdims=True) + NORM_EPS)
    return (y * g.astype(jnp.float32)).astype(x.dtype)


def _centred_dwconv(u, w, b):
    width = w.shape[0]
    half = width // 2
    L = u.shape[1]
    up = jnp.pad(u, ((0, 0), (half, half), (0, 0)))
    y = b
    for k in range(width):
        y = y + up[:, k:k + L] * w[k]
    return y


def _filter_pos_features(L):
    pos = jnp.arange(L, dtype=jnp.float32)
    t = pos / max(L - 1, 1)
    bands = jnp.linspace(1e-4, FILTER_BANDS - 1, FILTER_BANDS, dtype=jnp.float32)
    ang = (2.0 * math.pi / L) * pos[:, None] * bands[None, :]
    z = jnp.concatenate([t[:, None], jnp.cos(ang), -jnp.sin(ang)], axis=-1)
    return z, t


def _hyena_filters_freq(L, w1, b1, w2, b2, freq, w3):
    f32 = jnp.float32
    z, t = _filter_pos_features(L)
    fr = freq.astype(f32)
    h = jnp.sin(fr * (z @ w1.astype(f32) + b1.astype(f32)))
    h = jnp.sin(fr * (h @ w2.astype(f32) + b2.astype(f32)))
    h = (h @ w3.astype(f32)).reshape(L, HYENA_ORDER, N_DIRS, D_HYENA)
    min_decay = math.log(DECAY_TARGET) / SLOW_DECAY_PCT
    max_decay = math.log(DECAY_TARGET) / FAST_DECAY_PCT
    deltas = jnp.linspace(min_decay, max_decay, D_HYENA, dtype=f32)
    decay = jnp.exp(-t[:, None] * jnp.abs(deltas)[None, :])
    h = h * decay[:, None, None, :]
    fwd = h[:, :, 0]
    bwd = h[:, :, 1]
    k = jnp.concatenate([fwd, jnp.zeros((1, HYENA_ORDER, D_HYENA), f32), bwd[:0:-1]], axis=0)
    k = k / (jnp.sum(jnp.abs(k), axis=0, keepdims=True) + FILTER_EPS)
    return jnp.fft.rfft(k, axis=0)


def _bidir_long_conv(u, k_f):
    L = u.shape[1]
    u_f = jnp.fft.rfft(u.astype(jnp.float32), n=2 * L, axis=1)
    y = jnp.fft.irfft(u_f * k_f[None], n=2 * L, axis=1)[:, :L]
    return y.astype(u.dtype)


def _hyena_mixer(p, short_w, short_b, k_f, d_skip):
    u = _centred_dwconv(p, short_w, short_b)
    v = u[..., :D_HYENA]
    gates = [u[..., (n + 1) * D_HYENA:(n + 2) * D_HYENA] for n in range(HYENA_ORDER)]
    z = v
    for n in range(HYENA_ORDER):
        z = gates[n] * (_bidir_long_conv(z, k_f[:, n]) + d_skip[n] * z)
    return z


def _fnet_mixer(p, w_grp):
    B, L, _ = p.shape
    r = p.reshape(B, L, FNET_GROUPS, FNET_GROUP_DIM).astype(jnp.float32)
    r = jnp.fft.fft2(r, axes=(1, 3), norm="ortho").real.astype(p.dtype)
    y = jnp.einsum("blgc,gcd->blgd", r, w_grp)
    return y.reshape(B, L, D_FNET)


def setup_inputs(seed: int = 0) -> dict:
    key = jax.random.key(seed)
    ks = jax.random.split(key, 24)
    f32 = jnp.float32
    nrm = lambda k, shape, s: (jax.random.normal(k, shape, f32) * s)
    return {
        "x": nrm(ks[0], (BATCH, SEQ, D_MODEL), 1.0),
        "c": nrm(ks[1], (BATCH, D_MODEL), 1.0),
        "ada_w": nrm(ks[2], (DEPTH, D_MODEL, N_MOD * D_MODEL), D_MODEL ** -0.5),
        "ada_b": nrm(ks[3], (DEPTH, N_MOD * D_MODEL), 0.02),
        "g_mix_pre": 1.0 + nrm(ks[4], (DEPTH, D_MODEL), 0.05),
        "g_mix_post": 1.0 + nrm(ks[5], (DEPTH, D_MODEL), 0.05),
        "w_in": nrm(ks[6], (DEPTH, D_MODEL, D_IN_PROJ), D_MODEL ** -0.5),
        "short_w": nrm(ks[7], (DEPTH, SHORT_CONV, (HYENA_ORDER + 1) * D_HYENA), SHORT_CONV ** -0.5),
        "short_b": nrm(ks[8], (DEPTH, (HYENA_ORDER + 1) * D_HYENA), 0.02),
        "filt_w1": nrm(ks[9], (DEPTH, FILTER_EMB, FILTER_HIDDEN), FILTER_EMB ** -0.5),
        "filt_b1": nrm(ks[10], (DEPTH, FILTER_HIDDEN), 0.02),
        "filt_w2": nrm(ks[11], (DEPTH, FILTER_HIDDEN, FILTER_HIDDEN), FILTER_HIDDEN ** -0.5),
        "filt_b2": nrm(ks[12], (DEPTH, FILTER_HIDDEN), 0.02),
        "filt_freq": 1.0 + nrm(ks[13], (DEPTH, FILTER_HIDDEN), 0.05),
        "filt_w3": nrm(ks[14], (DEPTH, FILTER_HIDDEN, HYENA_ORDER * N_DIRS * D_HYENA), FILTER_HIDDEN ** -0.5),
        "hyena_d": nrm(ks[15], (DEPTH, HYENA_ORDER, D_HYENA), 0.5),
        "fnet_w": nrm(ks[16], (DEPTH, FNET_GROUPS, FNET_GROUP_DIM, FNET_GROUP_DIM), FNET_GROUP_DIM ** -0.5),
        "w_out": nrm(ks[17], (DEPTH, D_MIX, D_MODEL), D_MIX ** -0.5),
        "g_ffn_pre": 1.0 + nrm(ks[18], (DEPTH, D_MODEL), 0.05),
        "g_ffn_post": 1.0 + nrm(ks[19], (DEPTH, D_MODEL), 0.05),
        "w_up": nrm(ks[20], (DEPTH, D_MODEL, 2 * D_FF), D_MODEL ** -0.5),
        "dw_w": nrm(ks[21], (DEPTH, FFN_CONV, 2 * D_FF), FFN_CONV ** -0.5),
        "dw_b": nrm(ks[22], (DEPTH, 2 * D_FF), 0.02),
        "w_down": nrm(ks[23], (DEPTH, D_FF, D_MODEL), D_FF ** -0.5),
    }


def reference(x, c, ada_w, ada_b, g_mix_pre, g_mix_post, w_in, short_w, short_b,
              filt_w1, filt_b1, filt_w2, filt_b2, filt_freq, filt_w3, hyena_d,
              fnet_w, w_out, g_ffn_pre, g_ffn_post, w_up, dw_w, dw_b, w_down):
    L = x.shape[1]
    c_act = jax.nn.silu(c.astype(jnp.float32))
    for l in range(DEPTH):
        mod = (c_act @ ada_w[l].astype(jnp.float32) + ada_b[l].astype(jnp.float32)).astype(x.dtype)
        shift_m, scale_m, gate_m, shift_f, scale_f, gate_f = jnp.split(mod[:, None, :], N_MOD, axis=-1)

        h = _rmsnorm(x, g_mix_pre[l]) * (1.0 + scale_m) + shift_m
        p = jnp.einsum("bld,de->ble", h, w_in[l])
        k_f = _hyena_filters_freq(L, filt_w1[l], filt_b1[l], filt_w2[l], filt_b2[l],
                                  filt_freq[l], filt_w3[l])
        y_hyena = _hyena_mixer(p[..., :(HYENA_ORDER + 1) * D_HYENA], short_w[l], short_b[l],
                               k_f, hyena_d[l])
        y_fnet = _fnet_mixer(p[..., (HYENA_ORDER + 1) * D_HYENA:], fnet_w[l])
        y = jnp.einsum("ble,ed->bld", jnp.concatenate([y_hyena, y_fnet], axis=-1), w_out[l])
        x = x + gate_m * _rmsnorm(y, g_mix_post[l])

        h = _rmsnorm(x, g_ffn_pre[l]) * (1.0 + scale_f) + shift_f
        u = _centred_dwconv(jnp.einsum("bld,df->blf", h, w_up[l]), dw_w[l], dw_b[l])
        a, b = jnp.split(u, 2, axis=-1)
        y = jnp.einsum("blf,fd->bld", jax.nn.gelu(a, approximate=False) * b, w_down[l])
        x = x + gate_f * _rmsnorm(y, g_ffn_post[l])
    return x
```

```cpp
#include <hip/hip_runtime.h>
#include <hip/hip_cooperative_groups.h>
#include <cstdio>
namespace cg = cooperative_groups;
#define MK_MULTI_LAUNCH 1
namespace pg8 {
#define PG8_LAS __attribute__((address_space(3)))
typedef unsigned short bf16_t;
typedef short bf16x8 __attribute__((ext_vector_type(8)));
typedef float f32x4 __attribute__((ext_vector_type(4)));
typedef unsigned u32x4 __attribute__((ext_vector_type(4)));
constexpr int BM = 256, BK = 64, HALF = 128, HTB = HALF * BK * 2  , STAGE_BYTES = 8 * HTB, NXCD = 8, WGM = 8;

__host__ __device__ __forceinline__ int lds_byte(int r, int c) { const int st = (r >> 4) * 2 + (c >> 5), rr = r & 15, cc = c & 31, ob = rr * 64 + cc * 2; return st * 1024 + (ob ^ (((ob >> 9) & 1) << 5)); }
__host__ __device__ __forceinline__ void stage_rc(int b, int& R, int& C) { const int st = b / 1024, sb = b % 1024, swz = sb ^ (((sb >> 9) & 1) << 5); R = (st >> 1) * 16 + swz / 64; C = (st & 1) * 32 + (swz % 64) / 2; }
__host__ __device__ __forceinline__ int perm32(int rho) { const int n = rho >> 4, i = rho & 15; return 8 * (i >> 2) + 4 * n + (i & 3); }

struct Unit { int pm, pn; };
struct Gemm { const bf16_t* A; const bf16_t* Bt; int M, N, K; };

struct StaticOrder {
    int nM, nN, nwg, G, c;
    __host__ __device__ void init(int M, int N, int G_, int c_) { nM = M / BM; nN = N / BM; nwg = nM * nN; G = G_; c = c_; }
    __host__ __device__ bool next(int i, Unit& u) const {
        const long L = (long)i * G + c; if (L >= nwg) return false;
        int wgid = (int)L; { const int q = nwg / NXCD, r = nwg % NXCD, xcd = wgid % NXCD, off = wgid / NXCD; wgid = (xcd < r ? xcd * (q + 1) : r * (q + 1) + (xcd - r) * q) + off; }
        const int nig = WGM * nN, gid = wgid / nig, fm = gid * WGM, gsz = (nM - fm) < WGM ? (nM - fm) : WGM;
        u.pm = fm + ((wgid % nig) % gsz); u.pn = (wgid % nig) / gsz; return true;
    }
    __device__ __forceinline__ void a_ready(const Unit&) const {}
    __device__ __forceinline__ void done(const Unit&) const {}
};
__device__ __forceinline__ unsigned cvt_pk_bf16(float lo, float hi) { unsigned r; asm volatile("v_cvt_pk_bf16_f32 %0, %1, %2" : "=v"(r) : "v"(lo), "v"(hi)); return r; }
typedef float f32x2 __attribute__((ext_vector_type(2)));
__device__ __forceinline__ f32x2 gelu_pk(f32x2 v) {
    const f32x2 av = __builtin_elementwise_abs(v), d = av * 0.2316418882f + 1.0f;
    f32x2 t; t.x = __builtin_amdgcn_rcpf(d.x); t.y = __builtin_amdgcn_rcpf(d.y);
    f32x2 q = t * 0.5307027145f + (-0.7265760135f); q = q * t + 0.7107068705f; q = q * t + (-0.142248368f); q = q * t + 0.127414796f; q = q * t;
    const f32x2 s = (v * v) * (-0.72134752044f);
    f32x2 e; e.x = __builtin_amdgcn_exp2f(s.x); e.y = __builtin_amdgcn_exp2f(s.y);
    const f32x2 m = v * (q * e), r = v - m;
    f32x2 o; o.x = v.x < 0.f ? m.x : r.x; o.y = v.y < 0.f ? m.y : r.y; return o;
}

struct EpiF32 {
    static constexpr bool PERM = false, AFTER_DRAIN = false;
    float* C; int ldc; const float* bias;
    __device__ __forceinline__ void operator()(const f32x4 (&acc)[2][2][4][2], const Unit& u, int wr, int wc, int fr, int fq) const {
        const int row0 = u.pm * BM + wr * 64 + fr, col0 = u.pn * BM + wc * 32 + 4 * fq;
        f32x4 bv[2][2];
#pragma unroll
        for (int bj = 0; bj < 2; ++bj)
#pragma unroll
            for (int n = 0; n < 2; ++n) bv[bj][n] = bias ? *(const f32x4*)(bias + col0 + bj * HALF + n * 16) : (f32x4){0.f, 0.f, 0.f, 0.f};
#pragma unroll
        for (int ai = 0; ai < 2; ++ai)
#pragma unroll
            for (int m = 0; m < 4; ++m) { float* rowp = C + (size_t)(row0 + ai * HALF + m * 16) * ldc + col0;
#pragma unroll
                for (int bj = 0; bj < 2; ++bj)
#pragma unroll
                    for (int n = 0; n < 2; ++n) *(f32x4*)(rowp + bj * HALF + n * 16) = acc[ai][bj][m][n] + bv[bj][n]; }
    }
};
template <int ACT  > struct EpiBf16 {
    static constexpr bool PERM = true, AFTER_DRAIN = false;
    bf16_t* O; int ldc; const float* bias; int split_cols; size_t split_stride;
    __device__ __forceinline__ void operator()(const f32x4 (&acc)[2][2][4][2], const Unit& u, int wr, int wc, int fr, int fq) const {
        const int row0 = u.pm * BM + wr * 64 + fr; int colt = u.pn * BM; bf16_t* base = O;
        if (split_cols) { const int t = colt / split_cols; base += (size_t)t * split_stride; colt -= t * split_cols; }
        const int col0 = colt + wc * 32 + 8 * fq, bcol0 = u.pn * BM + wc * 32 + 8 * fq;
        f32x4 bv[2][2];
#pragma unroll
        for (int bj = 0; bj < 2; ++bj)
#pragma unroll
            for (int n = 0; n < 2; ++n) bv[bj][n] = bias ? *(const f32x4*)(bias + bcol0 + bj * HALF + 4 * n) : (f32x4){0.f, 0.f, 0.f, 0.f};
#pragma unroll
        for (int ai = 0; ai < 2; ++ai)
#pragma unroll
            for (int m = 0; m < 4; ++m) { bf16_t* rowp = base + (size_t)(row0 + ai * HALF + m * 16) * ldc + col0;
#pragma unroll
                for (int bj = 0; bj < 2; ++bj) { f32x4 v0 = acc[ai][bj][m][0] + bv[bj][0], v1 = acc[ai][bj][m][1] + bv[bj][1];
                    if (ACT == 1) { f32x2 a = gelu_pk((f32x2){v0[0], v0[1]}), b = gelu_pk((f32x2){v0[2], v0[3]}), c = gelu_pk((f32x2){v1[0], v1[1]}), d = gelu_pk((f32x2){v1[2], v1[3]});
                        v0 = (f32x4){a.x, a.y, b.x, b.y}; v1 = (f32x4){c.x, c.y, d.x, d.y}; }
                    if (ACT == 2) {
#pragma unroll
                        for (int j = 0; j < 4; ++j) { v0[j] = 0.5f * v0[j] * (1.0f + erff(v0[j] * 0.70710678f)); v1[j] = 0.5f * v1[j] * (1.0f + erff(v1[j] * 0.70710678f)); } }
                    u32x4 w; w.x = cvt_pk_bf16(v0[0], v0[1]); w.y = cvt_pk_bf16(v0[2], v0[3]); w.z = cvt_pk_bf16(v1[0], v1[1]); w.w = cvt_pk_bf16(v1[2], v1[3]);
                    *(u32x4*)(rowp + bj * HALF) = w; } }
    }
};
template <class Epi, class Sched, bool STAMP = false>
__device__ __forceinline__ void gemm_phase(PG8_LAS unsigned char* lds, const Gemm g, const Sched& S, const Epi& E, unsigned long long* stamps) {
    int tid_ = threadIdx.x; asm volatile("" : "+v"(tid_)); const int tid = tid_, wid = __builtin_amdgcn_readfirstlane(tid >> 6), lane = tid & 63, wr = wid >> 2, wc = wid & 3, fr = lane & 15, fq = lane >> 4;
    const int K = g.K, nt = K / BK;
    int ts_lo = 0, ts_hi = 0, nts = 0; const unsigned long long rt_entry = STAMP ? (unsigned long long)wall_clock64() : 0ull;
#define PG8_STAMP() do { if (STAMP && wid == 0 && nts < 64) { const unsigned long long _c = (unsigned long long)clock64(); \
        ts_lo = (lane == nts) ? (int)(unsigned)_c : ts_lo; ts_hi = (lane == nts) ? (int)(unsigned)(_c >> 32) : ts_hi; ++nts; } } while (0)
    PG8_STAMP();
    unsigned voffA[2], voffB[2];
#pragma unroll
    for (int i = 0; i < 2; ++i) { int R, C; stage_rc(tid * 16 + i * 8192, R, C); const int Rb = Epi::PERM ? ((R & ~31) + perm32(R & 31)) : R;
        voffA[i] = (unsigned)(R * K + C) * 2u; voffB[i] = (unsigned)(Rb * K + C) * 2u; }
    const size_t kstep = (size_t)(BK * 2);
    const size_t hstep = (size_t)HALF * K * 2;
    const size_t tstep = 2 * hstep;
    const unsigned ldsw = (unsigned)wid * 1024u;
    const int aoff = lds_byte(wr * 64 + fr, fq * 8), boff = lds_byte(wc * 32 + fr, fq * 8);
#define PG8_SA(b, h) (((b) * 2 + (h)) * HTB)
#define PG8_SB(b, h) ((4 + (b) * 2 + (h)) * HTB)
#define PG8_STAGE(bufoff, gbase, voff) do { _Pragma("unroll") for (int _i = 0; _i < 2; ++_i) \
        __builtin_amdgcn_global_load_lds((const unsigned*)((const char*)(gbase) + (voff)[_i]), (PG8_LAS unsigned*)(lds + (bufoff) + ldsw + _i * 8192), 16, 0, 0); } while (0)
#define PG8_LDA(dst, b, h) do { _Pragma("unroll") for (int m = 0; m < 4; ++m) _Pragma("unroll") for (int k = 0; k < 2; ++k) dst[m][k] = *(const PG8_LAS bf16x8*)(lds + PG8_SA(b, h) + aoff + m * 2048 + k * 1024); } while (0)
#define PG8_LDB(dst, b, h) do { _Pragma("unroll") for (int n = 0; n < 2; ++n) _Pragma("unroll") for (int k = 0; k < 2; ++k) dst[n][k] = *(const PG8_LAS bf16x8*)(lds + PG8_SB(b, h) + boff + n * 2048 + k * 1024); } while (0)
#define PG8_MMA(ai, bj, At, Bt) do { __builtin_amdgcn_s_setprio(1); _Pragma("unroll") for (int m = 0; m < 4; ++m) _Pragma("unroll") for (int n = 0; n < 2; ++n) _Pragma("unroll") for (int k = 0; k < 2; ++k) \
        acc[ai][bj][m][n] = __builtin_amdgcn_mfma_f32_16x16x32_bf16(Bt[n][k], At[m][k], acc[ai][bj][m][n], 0, 0, 0); __builtin_amdgcn_s_setprio(0); } while (0)
#define PG8_WAIT_V(n) asm volatile("s_waitcnt vmcnt(" #n ")" ::: "memory")
#define PG8_WAIT_L(n) asm volatile("s_waitcnt lgkmcnt(" #n ")" ::: "memory")
#define PG8_BAR __builtin_amdgcn_s_barrier()
#define PG8_SCHED __builtin_amdgcn_sched_barrier(0)
    Unit cur, nxt; int ui = 0;
    if (!S.next(0, cur)) return;
    f32x4 acc[2][2][4][2];
#pragma unroll
    for (int a = 0; a < 2; ++a)
#pragma unroll
        for (int b = 0; b < 2; ++b)
#pragma unroll
            for (int m = 0; m < 4; ++m)
#pragma unroll
                for (int n = 0; n < 2; ++n) acc[a][b][m][n] = (f32x4){0.f, 0.f, 0.f, 0.f};
    bf16x8 At[4][2], B0[2][2], B1[2][2];
    const char* cA = (const char*)g.A + (size_t)cur.pm * tstep; const char* cB = (const char*)g.Bt + (size_t)cur.pn * tstep;
    S.a_ready(cur);
    PG8_STAGE(PG8_SB(0, 0), cB, voffB); PG8_STAGE(PG8_SA(0, 0), cA, voffA); PG8_STAGE(PG8_SB(0, 1), cB + hstep, voffB); PG8_STAGE(PG8_SA(0, 1), cA + hstep, voffA);
    if (wr == 1) PG8_BAR;
    PG8_WAIT_V(4); PG8_BAR;
    PG8_STAGE(PG8_SB(1, 0), cB + kstep, voffB); PG8_STAGE(PG8_SA(1, 0), cA + kstep, voffA); PG8_STAGE(PG8_SB(1, 1), cB + hstep + kstep, voffB);
    PG8_WAIT_V(6); PG8_BAR;
    PG8_STAMP();
    for (;;) {
        const bool has_next = S.next(ui + 1, nxt);
        const char* nA = has_next ? (const char*)g.A + (size_t)nxt.pm * tstep : cA; const char* nB = has_next ? (const char*)g.Bt + (size_t)nxt.pn * tstep : cB;
        for (int t = 0; t < nt; t += 2) {
            const bool last = (t == nt - 2);
            const char* a1 = cA + (size_t)(t + 1) * kstep;
            const char* a2 = last ? nA : cA + (size_t)(t + 2) * kstep; const char* b2 = last ? nB : cB + (size_t)(t + 2) * kstep;
            const char* a3 = a2 + kstep; const char* b3 = b2 + kstep;
            if (last && has_next) S.a_ready(nxt);
            PG8_LDB(B0, 0, 0); PG8_SCHED; PG8_LDA(At, 0, 0); PG8_STAGE(PG8_SA(1, 1), a1 + hstep, voffA);
            PG8_WAIT_L(8); PG8_BAR; PG8_WAIT_L(0); PG8_MMA(0, 0, At, B0); PG8_BAR; PG8_SCHED;
            PG8_LDB(B1, 0, 1); PG8_STAGE(PG8_SB(0, 0), b2, voffB);
            PG8_BAR; PG8_WAIT_L(0); PG8_MMA(0, 1, At, B1); PG8_BAR;
            PG8_LDA(At, 0, 1); PG8_STAGE(PG8_SA(0, 0), a2, voffA);
            PG8_BAR; PG8_WAIT_L(0); PG8_MMA(1, 0, At, B0); PG8_BAR; PG8_SCHED;
            PG8_STAGE(PG8_SB(0, 1), b2 + hstep, voffB);
            PG8_WAIT_V(6); PG8_BAR; PG8_MMA(1, 1, At, B1); PG8_BAR;
            PG8_LDB(B0, 1, 0); PG8_SCHED; PG8_LDA(At, 1, 0); PG8_STAGE(PG8_SA(0, 1), a2 + hstep, voffA);
            PG8_WAIT_L(8); PG8_BAR; PG8_WAIT_L(0); PG8_MMA(0, 0, At, B0); PG8_BAR; PG8_SCHED;
            PG8_LDB(B1, 1, 1); PG8_STAGE(PG8_SB(1, 0), b3, voffB);
            PG8_BAR; PG8_WAIT_L(0); PG8_MMA(0, 1, At, B1); PG8_BAR;
            PG8_LDA(At, 1, 1); PG8_STAGE(PG8_SA(1, 0), a3, voffA);
            PG8_BAR; PG8_WAIT_L(0); PG8_MMA(1, 0, At, B0); PG8_BAR; PG8_SCHED;
            PG8_STAGE(PG8_SB(1, 1), b3 + hstep, voffB);
            PG8_WAIT_V(6); PG8_BAR; PG8_MMA(1, 1, At, B1); PG8_BAR;
        }
        PG8_STAMP();
        if constexpr (!Epi::AFTER_DRAIN) { E(acc, cur, wr, wc, fr, fq); S.done(cur); }
        PG8_STAMP();
        if (!has_next) break;
#pragma unroll
        for (int a = 0; a < 2; ++a)
#pragma unroll
            for (int b = 0; b < 2; ++b)
#pragma unroll
                for (int m = 0; m < 4; ++m)
#pragma unroll
                    for (int n = 0; n < 2; ++n) acc[a][b][m][n] = (f32x4){0.f, 0.f, 0.f, 0.f};
        cur = nxt; cA = nA; cB = nB; ++ui;
    }
    PG8_WAIT_V(0);
    if (wr == 0) PG8_BAR;
    PG8_BAR;
    if constexpr (Epi::AFTER_DRAIN) { E.fused(acc, cur, wr, wc, fr, fq, lds, wid, lane); S.done(cur); }
    PG8_STAMP();
    if (STAMP && wid == 0) { stamps[lane] = lane < nts ? (((unsigned long long)(unsigned)ts_hi << 32) | (unsigned)ts_lo) : 0ull;
        if (lane == 62) stamps[62] = rt_entry; if (lane == 63) stamps[63] = (unsigned long long)wall_clock64(); }
#undef PG8_STAMP
#undef PG8_SA
#undef PG8_SB
#undef PG8_STAGE
#undef PG8_LDA
#undef PG8_LDB
#undef PG8_MMA
#undef PG8_WAIT_V
#undef PG8_WAIT_L
#undef PG8_BAR
#undef PG8_SCHED
}
}
using pg8::bf16_t;
typedef float f32x4v __attribute__((ext_vector_type(4)));
typedef float f32x2v __attribute__((ext_vector_type(2)));
typedef unsigned u32x4v __attribute__((ext_vector_type(4)));
typedef unsigned u32x2v __attribute__((ext_vector_type(2)));

constexpr int DM = 1024, NB = 16, SEQ = 4096, DEPTH = 4, NTOK = NB * SEQ;
constexpr int DH = 512, NPT = 2560, DFF = 2816, DUP = 5632, HTOK = NTOK / 2;
constexpr int NTHR = 512;

constexpr size_t WL_WIN = 0, WL_WOUT = WL_WIN + (size_t)NPT * DM, WL_WUP = WL_WOUT + (size_t)DM * DM, WL_WDN = WL_WUP + (size_t)DUP * DM, WL_END = WL_WDN + (size_t)DM * DFF;
constexpr size_t WS_WBF = 0;
constexpr size_t WS_KF = WS_WBF + WL_END * 2 * DEPTH;
constexpr size_t WS_H3T = WS_KF + (size_t)2 * DH * 2 * SEQ * 8;
constexpr size_t WS_FH2 = WS_H3T + (size_t)2048 * SEQ * 4;
constexpr size_t WS_MOD = WS_FH2 + (size_t)DEPTH * SEQ * 64 * 4;
constexpr size_t WS_TW = WS_MOD + (size_t)DEPTH * NB * 6144 * 4;
constexpr size_t WS_H = WS_TW + 8192 * 8;
constexpr size_t WS_BIG = WS_H + (size_t)NTOK * DM * 2;
constexpr size_t WS_PT = WS_BIG, WS_YT = WS_PT + (size_t)NB * NPT * SEQ * 2, WS_Y = WS_YT + (size_t)NTOK * DM * 2, WS_MIX_END = WS_Y + (size_t)NTOK * DM * 2;
constexpr size_t WS_YO = WS_PT;
constexpr size_t WS_U = WS_BIG, WS_G = WS_U + (size_t)HTOK * DUP * 2, WS_YD = WS_G + (size_t)HTOK * DFF * 2, WS_FFN_END = WS_YD + (size_t)NTOK * DM * 2;
constexpr size_t WS_NEED = WS_MIX_END > WS_FFN_END ? WS_MIX_END : WS_FFN_END;
static_assert(WS_KF % 256 == 0 && WS_H % 256 == 0 && WS_BIG % 256 == 0 && WS_G % 256 == 0 && WS_YD % 256 == 0, "align");

enum { I_X = 0, I_C, I_ADAW, I_ADAB, I_GMPRE, I_GMPOST, I_WIN, I_SW, I_SB, I_FW1, I_FB1, I_FW2, I_FB2, I_FFREQ, I_FW3, I_HD, I_FNW, I_WOUT, I_GFPRE, I_GFPOST, I_WUP, I_DWW, I_DWB, I_WDOWN };
struct Params { const float* in[24]; float* out; unsigned char* ws; int ph_lo, ph_hi; };

__device__ __forceinline__ float bf2f(bf16_t v) { return __uint_as_float(((unsigned)v) << 16); }
__device__ __forceinline__ bf16_t f2bf(float f) { unsigned u = __float_as_uint(f); u += 0x7FFFu + ((u >> 16) & 1u); return (bf16_t)(u >> 16); }
__device__ __forceinline__ unsigned pack2(float lo, float hi) { return (unsigned)f2bf(lo) | ((unsigned)f2bf(hi) << 16); }
__device__ __forceinline__ int opaque_tid() { int t = threadIdx.x; asm volatile("" : "+v"(t)); return t; }
__device__ __forceinline__ float wave_sum(float v) {
#pragma unroll
    for (int o = 32; o >= 1; o >>= 1) v += __shfl_xor(v, o);
    return v;
}

__device__ __forceinline__ void dft4(float& r0, float& i0, float& r1, float& i1, float& r2, float& i2, float& r3, float& i3) {
    const float s0r = r0 + r2, s0i = i0 + i2, s1r = r0 - r2, s1i = i0 - i2;
    const float s2r = r1 + r3, s2i = i1 + i3, s3r = r1 - r3, s3i = i1 - i3;
    r0 = s0r + s2r; i0 = s0i + s2i; r2 = s0r - s2r; i2 = s0i - s2i;
    r1 = s1r + s3i; i1 = s1i - s3r; r3 = s1r - s3i; i3 = s1i + s3r;
}
template <int K> __device__ __forceinline__ void tw16(float& r, float& i) {
    if constexpr (K == 0) { }
    else if constexpr (K == 4) { const float t = r; r = i; i = -t; }
    else {
        constexpr float C[10] = {1.f, 0.92387953251128674f, 0.70710678118654752f, 0.38268343236508977f, 0.f, -0.38268343236508977f, -0.70710678118654752f, -0.92387953251128674f, -1.f, -0.92387953251128674f};
        constexpr float S[10] = {0.f, -0.38268343236508977f, -0.70710678118654752f, -0.92387953251128674f, -1.f, -0.92387953251128674f, -0.70710678118654752f, -0.38268343236508977f, 0.f, 0.38268343236508977f};
        const float c = C[K], s = S[K], t = r * c - i * s; i = r * s + i * c; r = t;
    }
}
__device__ __forceinline__ void dft16(float (&xr)[16], float (&xi)[16]) {
#pragma unroll
    for (int b = 0; b < 4; ++b) dft4(xr[b], xi[b], xr[4 + b], xi[4 + b], xr[8 + b], xi[8 + b], xr[12 + b], xi[12 + b]);
    tw16<1>(xr[5], xi[5]); tw16<2>(xr[6], xi[6]); tw16<3>(xr[7], xi[7]);
    tw16<2>(xr[9], xi[9]); tw16<4>(xr[10], xi[10]); tw16<6>(xr[11], xi[11]);
    tw16<3>(xr[13], xi[13]); tw16<6>(xr[14], xi[14]); tw16<9>(xr[15], xi[15]);
#pragma unroll
    for (int c = 0; c < 4; ++c) dft4(xr[4 * c], xi[4 * c], xr[4 * c + 1], xi[4 * c + 1], xr[4 * c + 2], xi[4 * c + 2], xr[4 * c + 3], xi[4 * c + 3]);
#pragma unroll
    for (int c = 0; c < 4; ++c)
#pragma unroll
        for (int d = c + 1; d < 4; ++d) { float t = xr[4 * c + d]; xr[4 * c + d] = xr[4 * d + c]; xr[4 * d + c] = t; t = xi[4 * c + d]; xi[4 * c + d] = xi[4 * d + c]; xi[4 * d + c] = t; }
}
constexpr int FS1 = 272, FS2 = 258, FBUF = 16 * FS1;
__device__ __forceinline__ void fft4096(float (&xr)[16], float (&xi)[16], f32x2v* buf, const int t, const f32x2v* __restrict__ TW) {
    dft16(xr, xi);
    __syncthreads();
    {
        f32x2v w1 = TW[2 * t]; asm volatile("" : "+v"(w1.x), "+v"(w1.y));
        float wr = w1.x, wi = w1.y;
        buf[t] = (f32x2v){xr[0], xi[0]};
#pragma unroll
        for (int k = 1; k < 16; ++k) {
            const float r = xr[k], i = xi[k];
            buf[k * FS1 + t] = (f32x2v){r * wr - i * wi, r * wi + i * wr};
            if (k < 15) { const float nr = wr * w1.x - wi * w1.y; wi = wr * w1.y + wi * w1.x; wr = nr; }
        }
    }
    __syncthreads();
    const int k1 = t >> 4, m2 = t & 15;
#pragma unroll
    for (int m = 0; m < 16; ++m) { const f32x2v v = buf[k1 * FS1 + 16 * m + m2]; xr[m] = v.x; xi[m] = v.y; }
    __syncthreads();
    dft16(xr, xi);
    {
        f32x2v w1 = TW[32 * m2]; asm volatile("" : "+v"(w1.x), "+v"(w1.y));
        float wr = w1.x, wi = w1.y;
        buf[m2 * FS2 + k1] = (f32x2v){xr[0], xi[0]};
#pragma unroll
        for (int j = 1; j < 16; ++j) {
            const float r = xr[j], i = xi[j];
            buf[m2 * FS2 + k1 + 16 * j] = (f32x2v){r * wr - i * wi, r * wi + i * wr};
            if (j < 15) { const float nr = wr * w1.x - wi * w1.y; wi = wr * w1.y + wi * w1.x; wr = nr; }
        }
    }
    __syncthreads();
#pragma unroll
    for (int m = 0; m < 16; ++m) { const f32x2v v = buf[m * FS2 + t]; xr[m] = v.x; xi[m] = v.y; }
    dft16(xr, xi);
}
__device__ __forceinline__ f32x2v w32(int j) {
    constexpr float C[16] = {1.f, 0.98078528040323043f, 0.92387953251128674f, 0.83146961230254524f, 0.70710678118654752f, 0.55557023301960218f, 0.38268343236508977f, 0.19509032201612825f, 0.f, -0.19509032201612825f, -0.38268343236508977f, -0.55557023301960218f, -0.70710678118654752f, -0.83146961230254524f, -0.92387953251128674f, -0.98078528040323043f};
    constexpr float S[16] = {0.f, -0.19509032201612825f, -0.38268343236508977f, -0.55557023301960218f, -0.70710678118654752f, -0.83146961230254524f, -0.92387953251128674f, -0.98078528040323043f, -1.f, -0.98078528040323043f, -0.92387953251128674f, -0.83146961230254524f, -0.70710678118654752f, -0.55557023301960218f, -0.38268343236508977f, -0.19509032201612825f};
    return (f32x2v){C[j], S[j]};
}
__device__ __forceinline__ bf16_t* wbf(const Params& P, int l, size_t off) { return (bf16_t*)(P.ws + WS_WBF) + (size_t)l * WL_END + off; }
__device__ __forceinline__ const float* modp(const Params& P, int l, int which) { return (const float*)(P.ws + WS_MOD) + (size_t)l * NB * 6144 + which * 1024; }

__device__ __forceinline__ void ph_tconv(const Params& P, float* tile) {
    const int tid = opaque_tid();
    for (int it = blockIdx.x; it < DEPTH * 2752; it += gridDim.x) {
        const int l = it / 2752; int r = it % 2752;
        const float* src; int ldsrc, lddst, tk, tn; bf16_t* dst;
        if (r < 384) { src = P.in[I_WIN] + (size_t)l * DM * 2048; ldsrc = 2048; lddst = DM; tk = r / 24; tn = r % 24; dst = wbf(P, l, WL_WIN); }
        else if (r < 640) { r -= 384; src = P.in[I_WOUT] + (size_t)l * DM * DM; ldsrc = DM; lddst = DM; tk = r / 16; tn = r % 16; dst = wbf(P, l, WL_WOUT); }
        else if (r < 2048) { r -= 640; src = P.in[I_WUP] + (size_t)l * DM * DUP; ldsrc = DUP; lddst = DM; tk = r / 88; tn = r % 88; dst = wbf(P, l, WL_WUP); }
        else { r -= 2048; src = P.in[I_WDOWN] + (size_t)l * DFF * DM; ldsrc = DM; lddst = DFF; tk = r / 16; tn = r % 16; dst = wbf(P, l, WL_WDN); }
#pragma unroll
        for (int i = 0; i < 8; ++i) { const int idx = tid + 512 * i, kk = idx >> 6, nn = idx & 63; tile[kk * 65 + nn] = src[(size_t)(tk * 64 + kk) * ldsrc + tn * 64 + nn]; }
        __syncthreads();
#pragma unroll
        for (int i = 0; i < 8; ++i) { const int idx = tid + 512 * i, nn = idx >> 6, kk = idx & 63; dst[(size_t)(tn * 64 + nn) * lddst + tk * 64 + kk] = f2bf(tile[kk * 65 + nn]); }
        __syncthreads();
    }
}
__device__ __forceinline__ void ph_fold(const Params& P, float* lds) {
    const int tid = opaque_tid();
    float* CW = lds; float* SWm = lds + 4096; float* ct = lds + 8192; float* st = lds + 8192 + 64;
    for (int it = blockIdx.x; it < DEPTH * 64; it += gridDim.x) {
        const int l = it >> 6, g = (it >> 3) & 7, kc = it & 7;
        const float* Wg = P.in[I_FNW] + ((size_t)l * 8 + g) * 4096;
        if (tid < 64) { float s, c; sincospif((float)tid * (1.0f / 32.0f), &s, &c); ct[tid] = c; st[tid] = s; }
        __syncthreads();
        for (int idx = tid; idx < 4096; idx += NTHR) { const int c = idx >> 6, d = idx & 63; float ac = 0.f, as = 0.f;
            for (int m = 0; m < 64; ++m) { const float w = Wg[m * 64 + d]; const int ph = (c * m) & 63; ac += ct[ph] * w; as += st[ph] * w; }
            CW[idx] = ac * (1.0f / 512.0f); SWm[idx] = as * (1.0f / 512.0f); }
        __syncthreads();
        bf16_t* WinT = wbf(P, l, WL_WIN);
        for (int idx = tid; idx < 2 * 64 * 128; idx += NTHR) { const int which = idx >> 13, d = (idx >> 7) & 63, kk = idx & 127, k = kc * 128 + kk;
            const float* row = P.in[I_WIN] + ((size_t)l * DM + k) * 2048 + 1536 + 64 * g; const float* Mx = which ? SWm : CW; float a = 0.f;
            for (int c = 0; c < 64; ++c) a += row[c] * Mx[c * 64 + d];
            WinT[(size_t)(1536 + which * 512 + g * 64 + d) * DM + k] = f2bf(a); }
        __syncthreads();
    }
}
__device__ __forceinline__ void ph_mod(const Params& P, float* lds) {
    const int tid = opaque_tid();
    float* cact = lds;
    float* red = lds + 16384;
    if ((int)blockIdx.x >= DEPTH * 96) return;
    for (int idx = tid; idx < NB * DM; idx += NTHR) { const int b = idx >> 10, k = idx & 1023; const float v = P.in[I_C][idx]; cact[k * 16 + b] = v / (1.0f + __expf(-v)); }
    __syncthreads();
    for (int it = blockIdx.x; it < DEPTH * 96; it += gridDim.x) {
        const int l = it / 96, n0 = (it % 96) * 64, ks = tid >> 6, nn = tid & 63;
        float acc[16];
#pragma unroll
        for (int b = 0; b < 16; ++b) acc[b] = 0.f;
        const float* w = P.in[I_ADAW] + ((size_t)l * DM + ks * 128) * 6144 + n0 + nn;
        for (int k = 0; k < 128; ++k) { const float wv = w[(size_t)k * 6144]; const f32x4v* cp = (const f32x4v*)(cact + (ks * 128 + k) * 16);
#pragma unroll
            for (int q = 0; q < 4; ++q) { const f32x4v cv = cp[q]; acc[4 * q] += cv.x * wv; acc[4 * q + 1] += cv.y * wv; acc[4 * q + 2] += cv.z * wv; acc[4 * q + 3] += cv.w * wv; } }
#pragma unroll
        for (int b = 0; b < 16; ++b) red[(ks * 64 + nn) * 16 + b] = acc[b];
        __syncthreads();
        for (int idx = tid; idx < 1024; idx += NTHR) { const int b = idx >> 6, n = idx & 63; float s = P.in[I_ADAB][(size_t)l * 6144 + n0 + n];
#pragma unroll
            for (int q = 0; q < 8; ++q) s += red[(q * 64 + n) * 16 + b];
            ((float*)(P.ws + WS_MOD))[((size_t)l * NB + b) * 6144 + n0 + n] = s; }
        __syncthreads();
    }
}
__device__ __forceinline__ void ph_tw(const Params& P) {
    f32x2v* TW = (f32x2v*)(P.ws + WS_TW);
    const int tid = opaque_tid();
    for (int j = blockIdx.x * NTHR + tid; j < 8192; j += gridDim.x * NTHR) { float s, c; sincospif((float)j * (1.0f / 4096.0f), &s, &c); TW[j] = (f32x2v){c, -s}; }
}
__device__ __forceinline__ void ph_fh2(const Params& P, float* lds) {
    const int tid = opaque_tid(), p = tid >> 6, j = tid & 63;
    float* z = lds;
    float* h1 = lds + 8 * 36;
    for (int it = blockIdx.x; it < DEPTH * 512; it += gridDim.x) {
        const int l = it >> 9, pos = (it & 511) * 8 + p;
        if (j < 33) { float v;
            if (j == 0) v = (float)pos / 4095.0f;
            else { const int bi = (j - 1) & 15; const float band = 1e-4f + (float)bi * ((15.0f - 1e-4f) / 15.0f); float s, c; sincospif((float)pos * band * (2.0f / 4096.0f), &s, &c); v = (j <= 16) ? c : -s; }
            z[p * 36 + j] = v; }
        __syncthreads();
        const float fr = P.in[I_FFREQ][l * 64 + j];
        { float a = P.in[I_FB1][l * 64 + j]; const float* w1 = P.in[I_FW1] + (size_t)l * 33 * 64 + j;
          for (int i = 0; i < 33; ++i) a += z[p * 36 + i] * w1[i * 64];
          h1[p * 64 + j] = sinf(fr * a); }
        __syncthreads();
        { float a = P.in[I_FB2][l * 64 + j]; const float* w2 = P.in[I_FW2] + (size_t)l * 64 * 64 + j;
          for (int i = 0; i < 64; ++i) a += h1[p * 64 + i] * w2[i * 64];
          ((float*)(P.ws + WS_FH2))[((size_t)l * SEQ + pos) * 64 + j] = sinf(fr * a); }
        __syncthreads();
    }
}
__device__ __forceinline__ void ph_h3t(const Params& P, int l, float* lds) {
    const int tid = opaque_tid(), pp = tid & 63, cc = tid >> 6;
    float* A = lds;
    float* B = lds + 64 * 65;
    const float* FH2 = (const float*)(P.ws + WS_FH2) + (size_t)l * SEQ * 64; const float* w3 = P.in[I_FW3] + (size_t)l * 64 * 2048; float* H3T = (float*)(P.ws + WS_H3T);
    for (int it = blockIdx.x; it < 64 * 32; it += gridDim.x) {
        const int p0 = (it & 63) * 64, c0 = (it >> 6) * 64;
#pragma unroll
        for (int i = 0; i < 8; ++i) { const int idx = tid + 512 * i, r = idx >> 6, q = idx & 63; A[r * 65 + q] = FH2[(size_t)(p0 + r) * 64 + q]; B[r * 64 + q] = w3[(size_t)r * 2048 + c0 + q]; }
        __syncthreads();
        float acc[8];
#pragma unroll
        for (int i = 0; i < 8; ++i) acc[i] = 0.f;
        for (int q = 0; q < 64; ++q) { const float a = A[pp * 65 + q]; const f32x4v b0 = *(const f32x4v*)(B + q * 64 + cc * 8), b1 = *(const f32x4v*)(B + q * 64 + cc * 8 + 4);
            acc[0] += a * b0.x; acc[1] += a * b0.y; acc[2] += a * b0.z; acc[3] += a * b0.w; acc[4] += a * b1.x; acc[5] += a * b1.y; acc[6] += a * b1.z; acc[7] += a * b1.w; }
#pragma unroll
        for (int i = 0; i < 8; ++i) H3T[(size_t)(c0 + cc * 8 + i) * SEQ + p0 + pp] = acc[i];
        __syncthreads();
    }
}
__device__ __forceinline__ void ph_kf(const Params& P, int l, float* lds) {
    const int tid = opaque_tid(), h = tid >> 8, t = tid & 255;
    f32x2v* buf = (f32x2v*)lds + h * FBUF; float* red = lds + 2 * FBUF * 2;
    const f32x2v* TW = (const f32x2v*)(P.ws + WS_TW); const float* H3T = (const float*)(P.ws + WS_H3T); f32x2v* KF = (f32x2v*)(P.ws + WS_KF);
    const float min_decay = -4.605170185988091f / 1.5f, max_decay = -4.605170185988091f / 0.3f;
    for (int it = blockIdx.x; it < 2 * DH; it += gridDim.x) {
        const int n = it >> 9, c = it & 511;
        int tv = t; asm volatile("" : "+v"(tv));
        const float ad = fabsf(min_decay + (float)c * ((max_decay - min_decay) / 511.0f));
        const float* fw = H3T + (size_t)(n * 1024 + c) * SEQ; const float* bw = H3T + (size_t)(n * 1024 + 512 + c) * SEQ;
        float xr[16], xi[16]; float l1 = 0.f;
#pragma unroll
        for (int j = 0; j < 16; ++j) { const int m = tv + 256 * j;
            const float f = fw[m] * __expf(-((float)m * (1.0f / 4095.0f)) * ad);
            const float b = (m == 0) ? 0.f : bw[SEQ - m] * __expf(-((float)(SEQ - m) * (1.0f / 4095.0f)) * ad);
            l1 += fabsf(f) + fabsf(b); xr[j] = f; xi[j] = b; }
        l1 = wave_sum(l1);
        __syncthreads();
        if ((tid & 63) == 0) red[tid >> 6] = l1;
        __syncthreads();
        float tot = 0.f;
#pragma unroll
        for (int w = 0; w < 8; ++w) tot += red[w];
        const float sc = 1.0f / ((0.5f * tot + 1e-6f) * 8192.0f);
        f32x2v wt = TW[t]; asm volatile("" : "+v"(wt.x), "+v"(wt.y));
#pragma unroll
        for (int j = 0; j < 16; ++j) { const int m = t + 256 * j; const float f = xr[j], b = xi[j];
            if (h == 0) { xr[j] = (f + b) * sc; xi[j] = 0.f; }
            else { const f32x2v wj = w32(j); const float wx = wt.x * wj.x - wt.y * wj.y, wy = wt.x * wj.y + wt.y * wj.x; const float d = (f - b) * sc; xr[j] = d * wx; xi[j] = d * wy; } }
        fft4096(xr, xi, buf, t, TW);
        f32x2v* o = KF + (size_t)(it * 2 + h) * SEQ;
#pragma unroll
        for (int j = 0; j < 16; ++j) o[tv + 256 * j] = (f32x2v){xr[j], xi[j]};
    }
    __syncthreads();
}
__device__ __forceinline__ void ph_resnorm(const float* xin, float* xout, const bf16_t* y, const float* gpost, const float* gate, const float* gnext, const float* scale, const float* shift, bf16_t* hout) {
    const int tid = opaque_tid(); const int lane = tid & 63, wv = tid >> 6;
    for (int row = blockIdx.x * 8 + wv; row < NTOK; row += gridDim.x * 8) {
        const int b = row >> 12; f32x4v x[4];
#pragma unroll
        for (int q = 0; q < 4; ++q) x[q] = *(const f32x4v*)(xin + (size_t)row * DM + q * 256 + lane * 4);
        if (y) {
            f32x4v yv[4]; float ss = 0.f;
#pragma unroll
            for (int q = 0; q < 4; ++q) { const u32x2v w = *(const u32x2v*)(y + (size_t)row * DM + q * 256 + lane * 4);
                yv[q] = (f32x4v){__uint_as_float(w.x << 16), __uint_as_float(w.x & 0xffff0000u), __uint_as_float(w.y << 16), __uint_as_float(w.y & 0xffff0000u)};
                ss += yv[q].x * yv[q].x + yv[q].y * yv[q].y + yv[q].z * yv[q].z + yv[q].w * yv[q].w; }
            ss = wave_sum(ss); const float rinv = rsqrtf(ss * (1.0f / 1024.0f) + 1e-6f);
#pragma unroll
            for (int q = 0; q < 4; ++q) { const int c = q * 256 + lane * 4; const f32x4v g = *(const f32x4v*)(gpost + c), gt = *(const f32x4v*)(gate + (size_t)b * 6144 + c);
                x[q] = x[q] + gt * (yv[q] * rinv * g); *(f32x4v*)(xout + (size_t)row * DM + c) = x[q]; }
        }
        if (hout) {
            float ss = 0.f;
#pragma unroll
            for (int q = 0; q < 4; ++q) ss += x[q].x * x[q].x + x[q].y * x[q].y + x[q].z * x[q].z + x[q].w * x[q].w;
            ss = wave_sum(ss); const float rinv = rsqrtf(ss * (1.0f / 1024.0f) + 1e-6f);
#pragma unroll
            for (int q = 0; q < 4; ++q) { const int c = q * 256 + lane * 4; const f32x4v g = *(const f32x4v*)(gnext + c), sc = *(const f32x4v*)(scale + (size_t)b * 6144 + c), sh = *(const f32x4v*)(shift + (size_t)b * 6144 + c);
                const f32x4v hv = x[q] * rinv * g * (sc + 1.0f) + sh; u32x2v w; w.x = pack2(hv.x, hv.y); w.y = pack2(hv.z, hv.w);
                *(u32x2v*)(hout + (size_t)row * DM + c) = w; }
        }
    }
}
__device__ __forceinline__ void stage_sconv(const bf16_t* PT, int col, int b0, float w0, float w1, float w2, float bs, float* gl, int tid) {
    const int rsel = tid >> 8, seg = tid & 255; const bf16_t* row = PT + ((size_t)(b0 + rsel) * NPT + col) * SEQ + seg * 16;
    const u32x4v A = *(const u32x4v*)row, B = *(const u32x4v*)(row + 8);
    float e[18]; e[0] = seg ? bf2f(row[-1]) : 0.f; e[17] = (seg < 255) ? bf2f(row[16]) : 0.f;
    e[1] = __uint_as_float(A.x << 16); e[2] = __uint_as_float(A.x & 0xffff0000u); e[3] = __uint_as_float(A.y << 16); e[4] = __uint_as_float(A.y & 0xffff0000u);
    e[5] = __uint_as_float(A.z << 16); e[6] = __uint_as_float(A.z & 0xffff0000u); e[7] = __uint_as_float(A.w << 16); e[8] = __uint_as_float(A.w & 0xffff0000u);
    e[9] = __uint_as_float(B.x << 16); e[10] = __uint_as_float(B.x & 0xffff0000u); e[11] = __uint_as_float(B.y << 16); e[12] = __uint_as_float(B.y & 0xffff0000u);
    e[13] = __uint_as_float(B.z << 16); e[14] = __uint_as_float(B.z & 0xffff0000u); e[15] = __uint_as_float(B.w << 16); e[16] = __uint_as_float(B.w & 0xffff0000u);
    f32x4v* o = (f32x4v*)(gl + rsel * SEQ + seg * 16);
#pragma unroll
    for (int q = 0; q < 4; ++q) { f32x4v v;
        v.x = bs + e[4 * q] * w0 + e[4 * q + 1] * w1 + e[4 * q + 2] * w2; v.y = bs + e[4 * q + 1] * w0 + e[4 * q + 2] * w1 + e[4 * q + 3] * w2;
        v.z = bs + e[4 * q + 2] * w0 + e[4 * q + 3] * w1 + e[4 * q + 4] * w2; v.w = bs + e[4 * q + 3] * w0 + e[4 * q + 4] * w1 + e[4 * q + 5] * w2; o[q] = v; }
}
__device__ __forceinline__ void ph_mix(const Params& P, int l, float* lds) {
    const int tid = opaque_tid(), h = tid >> 8, t = tid & 255;
    f32x2v* buf = (f32x2v*)lds + h * FBUF; f32x2v* obuf = (f32x2v*)lds + (1 - h) * FBUF; float* gl = lds + 4 * FBUF;
    const f32x2v* TW = (const f32x2v*)(P.ws + WS_TW); const f32x2v* KF = (const f32x2v*)(P.ws + WS_KF);
    const bf16_t* PT = (const bf16_t*)(P.ws + WS_PT); bf16_t* YT = (bf16_t*)(P.ws + WS_YT);
    const float* sw = P.in[I_SW] + (size_t)l * 3 * 1536; const float* sb = P.in[I_SB] + (size_t)l * 1536; const float* hd = P.in[I_HD] + (size_t)l * 2 * DH;
    for (int it = blockIdx.x; it < DH * 8; it += gridDim.x) {
        const int c = it >> 3, bp = it & 7, b0 = 2 * bp, b1 = b0 + 1;
        int tv = t; asm volatile("" : "+v"(tv));
        float zr[16], zi[16], ar[16], ai[16];
        __syncthreads();
        stage_sconv(PT, c, b0, sw[c], sw[1536 + c], sw[3072 + c], sb[c], gl, tid);
        __syncthreads();
#pragma unroll
        for (int j = 0; j < 16; ++j) { zr[j] = gl[tv + 256 * j]; zi[j] = gl[SEQ + tv + 256 * j]; }
#pragma unroll
        for (int n = 0; n < 2; ++n) {
            f32x2v wt = TW[t]; asm volatile("" : "+v"(wt.x), "+v"(wt.y));
#pragma unroll
            for (int j = 0; j < 16; ++j) { if (h == 0) { ar[j] = zr[j]; ai[j] = zi[j]; } else { const f32x2v wj = w32(j); const float wx = wt.x * wj.x - wt.y * wj.y, wy = wt.x * wj.y + wt.y * wj.x; ar[j] = zr[j] * wx - zi[j] * wy; ai[j] = zr[j] * wy + zi[j] * wx; } }
            fft4096(ar, ai, buf, t, TW);
            const f32x2v* kf = KF + (size_t)((n * DH + c) * 2 + h) * SEQ;
#pragma unroll
            for (int j = 0; j < 16; ++j) { const f32x2v k = kf[tv + 256 * j]; const float pr = ar[j] * k.x - ai[j] * k.y, pi = ar[j] * k.y + ai[j] * k.x; ar[j] = pr; ai[j] = -pi; }
            fft4096(ar, ai, buf, t, TW);
            const float dsk = hd[n * DH + c]; const int col = (n + 1) * DH + c;
            stage_sconv(PT, col, b0, sw[col], sw[1536 + col], sw[3072 + col], sb[col], gl, tid);
            __syncthreads();
#pragma unroll
            for (int j = 0; j < 16; ++j) { float r = ar[j], i = -ai[j];
                if (h == 1) { const f32x2v wj = w32(j); const float wx = wt.x * wj.x - wt.y * wj.y, wy = wt.x * wj.y + wt.y * wj.x; const float tr = r * wx + i * wy; i = i * wx - r * wy; r = tr; }
                else { r += dsk * zr[j]; i += dsk * zi[j]; }
                ar[j] = r; ai[j] = i; buf[t + 256 * j] = (f32x2v){r, i}; }
            __syncthreads();
#pragma unroll
            for (int j = 0; j < 16; ++j) { const int m = tv + 256 * j; const f32x2v o = obuf[m];
                zr[j] = gl[m] * (ar[j] + o.x); zi[j] = gl[SEQ + m] * (ai[j] + o.y); }
        }
        bf16_t* o = YT + ((size_t)(h ? b1 : b0) * DM + c) * SEQ;
#pragma unroll
        for (int j = 0; j < 16; ++j) o[tv + 256 * j] = f2bf(h ? zi[j] : zr[j]);
    }
    for (int it = blockIdx.x; it < NB * DH / 2; it += gridDim.x) {
        const int s = 2 * it + h, b = s >> 9, ch = s & 511;
        int tv = t; asm volatile("" : "+v"(tv));
        const bf16_t* ra = PT + ((size_t)b * NPT + 1536 + ch) * SEQ; const bf16_t* rb = PT + ((size_t)b * NPT + 2048 + ch) * SEQ;
        float ar[16], ai[16];
#pragma unroll
        for (int j = 0; j < 16; ++j) { ar[j] = bf2f(ra[tv + 256 * j]); ai[j] = -bf2f(rb[tv + 256 * j]); }
        fft4096(ar, ai, buf, t, TW);
        bf16_t* o = YT + ((size_t)b * DM + 512 + ch) * SEQ;
#pragma unroll
        for (int j = 0; j < 16; ++j) o[tv + 256 * j] = f2bf(ar[j]);
    }
    __syncthreads();
}
__device__ __forceinline__ void ph_transpose(const Params& P, float* lds) {
    const int tid = opaque_tid(); bf16_t* tile = (bf16_t*)lds;
    const bf16_t* YT = (const bf16_t*)(P.ws + WS_YT); bf16_t* Y = (bf16_t*)(P.ws + WS_Y);
    for (int it = blockIdx.x; it < NB * 16 * 64; it += gridDim.x) {
        const int b = it >> 10, ct = (it >> 6) & 15, lt = it & 63;
        { const int r = tid >> 3, q = tid & 7; *(u32x4v*)(tile + r * 72 + q * 8) = *(const u32x4v*)(YT + ((size_t)b * DM + ct * 64 + r) * SEQ + lt * 64 + q * 8); }
        __syncthreads();
        { const int lr = tid >> 3, q = tid & 7; unsigned w[4];
#pragma unroll
          for (int i = 0; i < 4; ++i) w[i] = (unsigned)tile[(q * 8 + 2 * i) * 72 + lr] | ((unsigned)tile[(q * 8 + 2 * i + 1) * 72 + lr] << 16);
          *(u32x4v*)(Y + ((size_t)b * SEQ + lt * 64 + lr) * DM + ct * 64 + q * 8) = (u32x4v){w[0], w[1], w[2], w[3]}; }
        __syncthreads();
    }
}
__device__ __forceinline__ void unpack8(const u32x4v w, float (&f)[8]) {
    f[0] = __uint_as_float(w.x << 16); f[1] = __uint_as_float(w.x & 0xffff0000u); f[2] = __uint_as_float(w.y << 16); f[3] = __uint_as_float(w.y & 0xffff0000u);
    f[4] = __uint_as_float(w.z << 16); f[5] = __uint_as_float(w.z & 0xffff0000u); f[6] = __uint_as_float(w.w << 16); f[7] = __uint_as_float(w.w & 0xffff0000u);
}
__device__ __forceinline__ void ph_geglu(const Params& P, int l) {
    const bf16_t* U = (const bf16_t*)(P.ws + WS_U); bf16_t* G = (bf16_t*)(P.ws + WS_G);
    const float* dww = P.in[I_DWW] + (size_t)l * 3 * DUP; const float* dwb = P.in[I_DWB] + (size_t)l * DUP;
    constexpr int NCG = DFF / 8, CH = 16, NUNIT = (HTOK / CH) * NCG;
    const int tid = opaque_tid();
    for (int un = blockIdx.x * NTHR + tid; un < NUNIT; un += gridDim.x * NTHR) {
        const int cg = un % NCG, r0 = (un / NCG) * CH, f0 = cg * 8;
        float wa[3][8], wb[3][8], ba[8], bb[8];
#pragma unroll
        for (int k = 0; k < 3; ++k) { const f32x4v a0 = *(const f32x4v*)(dww + k * DUP + f0), a1 = *(const f32x4v*)(dww + k * DUP + f0 + 4), b0 = *(const f32x4v*)(dww + k * DUP + DFF + f0), b1 = *(const f32x4v*)(dww + k * DUP + DFF + f0 + 4);
            wa[k][0] = a0.x; wa[k][1] = a0.y; wa[k][2] = a0.z; wa[k][3] = a0.w; wa[k][4] = a1.x; wa[k][5] = a1.y; wa[k][6] = a1.z; wa[k][7] = a1.w;
            wb[k][0] = b0.x; wb[k][1] = b0.y; wb[k][2] = b0.z; wb[k][3] = b0.w; wb[k][4] = b1.x; wb[k][5] = b1.y; wb[k][6] = b1.z; wb[k][7] = b1.w; }
        { const f32x4v a0 = *(const f32x4v*)(dwb + f0), a1 = *(const f32x4v*)(dwb + f0 + 4), b0 = *(const f32x4v*)(dwb + DFF + f0), b1 = *(const f32x4v*)(dwb + DFF + f0 + 4);
          ba[0] = a0.x; ba[1] = a0.y; ba[2] = a0.z; ba[3] = a0.w; ba[4] = a1.x; ba[5] = a1.y; ba[6] = a1.z; ba[7] = a1.w; bb[0] = b0.x; bb[1] = b0.y; bb[2] = b0.z; bb[3] = b0.w; bb[4] = b1.x; bb[5] = b1.y; bb[6] = b1.z; bb[7] = b1.w; }
        float pa[8], pb[8], ca[8], cb[8], na[8], nb[8];
        const u32x4v zero = (u32x4v){0u, 0u, 0u, 0u};
        { const bool ok = (r0 & (SEQ - 1)) != 0; unpack8(ok ? *(const u32x4v*)(U + (size_t)(r0 - 1) * DUP + f0) : zero, pa); unpack8(ok ? *(const u32x4v*)(U + (size_t)(r0 - 1) * DUP + DFF + f0) : zero, pb); }
        unpack8(*(const u32x4v*)(U + (size_t)r0 * DUP + f0), ca); unpack8(*(const u32x4v*)(U + (size_t)r0 * DUP + DFF + f0), cb);
        for (int i = 0; i < CH; ++i) { const int r = r0 + i; const bool ok = ((r + 1) & (SEQ - 1)) != 0;
            unpack8(ok ? *(const u32x4v*)(U + (size_t)(r + 1) * DUP + f0) : zero, na); unpack8(ok ? *(const u32x4v*)(U + (size_t)(r + 1) * DUP + DFF + f0) : zero, nb);
            float o[8];
#pragma unroll
            for (int e = 0; e < 8; e += 2) {
                const f32x2v av = (f32x2v){ba[e] + pa[e] * wa[0][e] + ca[e] * wa[1][e] + na[e] * wa[2][e], ba[e + 1] + pa[e + 1] * wa[0][e + 1] + ca[e + 1] * wa[1][e + 1] + na[e + 1] * wa[2][e + 1]};
                const f32x2v gv = pg8::gelu_pk(av);
                o[e] = gv.x * (bb[e] + pb[e] * wb[0][e] + cb[e] * wb[1][e] + nb[e] * wb[2][e]);
                o[e + 1] = gv.y * (bb[e + 1] + pb[e + 1] * wb[0][e + 1] + cb[e + 1] * wb[1][e + 1] + nb[e + 1] * wb[2][e + 1]); }
            *(u32x4v*)(G + (size_t)r * DFF + f0) = (u32x4v){pack2(o[0], o[1]), pack2(o[2], o[3]), pack2(o[4], o[5]), pack2(o[6], o[7])};
#pragma unroll
            for (int e = 0; e < 8; ++e) { pa[e] = ca[e]; pb[e] = cb[e]; ca[e] = na[e]; cb[e] = nb[e]; }
        }
    }
}
constexpr int N_PHASES = 3 + 12 * DEPTH;
#ifndef MK_MULTI_LAUNCH
#define MK_MULTI_LAUNCH 0
#endif
__global__ __launch_bounds__(512, 2) void mk_fwd(Params P) {
    extern __shared__ __attribute__((aligned(16))) unsigned char smem[];
    float* lds = (float*)smem;
    cg::grid_group grid = cg::this_grid();
    bf16_t* H = (bf16_t*)(P.ws + WS_H);
    for (int ph = P.ph_lo; ph < P.ph_hi; ++ph) {
        if (ph > P.ph_lo) grid.sync();
        bool is_gemm = false; const bf16_t* gA = nullptr; const bf16_t* gB = nullptr; int gM = 0, gN = 0, gK = 0, gld = 0, gsplit = 0; size_t gstride = 0; bf16_t* gO = nullptr;
        if (ph == 0) {
#ifndef NO_PRO
 ph_tconv(P, lds); ph_fold(P, lds); ph_mod(P, lds); ph_tw(P); ph_fh2(P, lds);
#endif
 }
        else if (ph == 1) { ph_h3t(P, 0, lds); ph_resnorm(P.in[I_X], nullptr, nullptr, nullptr, nullptr, P.in[I_GMPRE], modp(P, 0, 1), modp(P, 0, 0), H); }
        else if (ph == 2) {
#ifndef NO_KF
 ph_kf(P, 0, lds);
#endif
 }
        else {
            const int l = (ph - 3) / 12, k = (ph - 3) % 12;
            if (k == 0) { is_gemm = true; gA = wbf(P, l, WL_WIN); gB = H; gM = NPT; gN = NTOK; gK = DM; gO = (bf16_t*)(P.ws + WS_PT); gld = SEQ; gsplit = SEQ; gstride = (size_t)NPT * SEQ; }
            else if (k == 1) {
#ifndef NO_MIX
 ph_mix(P, l, lds);
#endif
 }
            else if (k == 2) { ph_transpose(P, lds); if (l + 1 < DEPTH) ph_h3t(P, l + 1, lds); }
            else if (k == 3) { is_gemm = true; gA = (const bf16_t*)(P.ws + WS_Y); gB = wbf(P, l, WL_WOUT); gM = NTOK; gN = DM; gK = DM; gO = (bf16_t*)(P.ws + WS_YO); gld = DM; }
            else if (k == 4) {
                ph_resnorm(l == 0 ? P.in[I_X] : P.out, P.out, (const bf16_t*)(P.ws + WS_YO), P.in[I_GMPOST] + l * DM, modp(P, l, 2), P.in[I_GFPRE] + l * DM, modp(P, l, 4), modp(P, l, 3), H);

#ifndef NO_KF
 if (l + 1 < DEPTH) ph_kf(P, l + 1, lds);
#endif
 }
            else if (k == 5 || k == 8) { const int hf = (k == 8); is_gemm = true; gA = H + (size_t)hf * HTOK * DM; gB = wbf(P, l, WL_WUP); gM = HTOK; gN = DUP; gK = DM; gO = (bf16_t*)(P.ws + WS_U); gld = DUP; }
            else if (k == 6 || k == 9) {
#ifndef NO_GEGLU
 ph_geglu(P, l);
#endif
 }
            else if (k == 7 || k == 10) { const int hf = (k == 10); is_gemm = true; gA = (const bf16_t*)(P.ws + WS_G); gB = wbf(P, l, WL_WDN); gM = HTOK; gN = DM; gK = DFF; gO = (bf16_t*)(P.ws + WS_YD) + (size_t)hf * HTOK * DM; gld = DM; }
            else { const bool more = (l + 1 < DEPTH);
                ph_resnorm(P.out, P.out, (const bf16_t*)(P.ws + WS_YD), P.in[I_GFPOST] + l * DM, modp(P, l, 5), more ? P.in[I_GMPRE] + (l + 1) * DM : nullptr, more ? modp(P, l + 1, 1) : nullptr, more ? modp(P, l + 1, 0) : nullptr, more ? H : nullptr); }
        }
        #ifndef NO_GEMM
        if (is_gemm) {
            __syncthreads();
            pg8::Gemm g{gA, gB, gM, gN, gK}; pg8::StaticOrder S; S.init(gM, gN, (int)gridDim.x, (int)blockIdx.x);
            pg8::EpiBf16<0> E{gO, gld, nullptr, gsplit, gstride};
            pg8::gemm_phase<pg8::EpiBf16<0>, pg8::StaticOrder, false>((PG8_LAS unsigned char*)smem, g, S, E, nullptr);
            __syncthreads();
        }
#endif
    }
}

extern "C" void kernel_launch(void* const* d_in, const int* in_sizes, int n_in, void* d_out, int out_size, void* d_ws, size_t ws_size, hipStream_t stream) {
    static int grid = 0;
    if (grid == 0) {
        if (n_in != 24 || out_size != NTOK * DM || ws_size < WS_NEED) { fprintf(stderr, "kernel_launch: unexpected shapes (n_in %d out %d ws %zu need %zu)\n", n_in, out_size, ws_size, (size_t)WS_NEED); grid = -1; return; }
        int dev = 0, cus = 0, per_cu = 0;
        hipGetDevice(&dev); hipDeviceGetAttribute(&cus, hipDeviceAttributeMultiprocessorCount, dev);
        if (hipFuncSetAttribute((const void*)mk_fwd, hipFuncAttributeMaxDynamicSharedMemorySize, pg8::STAGE_BYTES) != hipSuccess) { fprintf(stderr, "kernel_launch: hipFuncSetAttribute failed\n"); grid = -1; return; }
        hipOccupancyMaxActiveBlocksPerMultiprocessor(&per_cu, (const void*)mk_fwd, NTHR, pg8::STAGE_BYTES);
        (void)hipGetLastError();
        if (per_cu < 1) fprintf(stderr, "kernel_launch: occupancy query says %d blocks per CU\n", per_cu);
        grid = cus > 0 ? cus : 256;
    }
    if (grid < 0) return;
    Params p{};
    for (int i = 0; i < 24; ++i) p.in[i] = (const float*)d_in[i];
    p.out = (float*)d_out; p.ws = (unsigned char*)d_ws;
#if MK_MULTI_LAUNCH
    for (int ph = 0; ph < N_PHASES; ++ph) { p.ph_lo = ph; p.ph_hi = ph + 1; hipLaunchKernelGGL(mk_fwd, dim3(grid), dim3(NTHR), pg8::STAGE_BYTES, stream, p); }
#else
    p.ph_lo = 0; p.ph_hi = N_PHASES;
    void* args[] = {&p};
    hipError_t e = hipLaunchCooperativeKernel((const void*)mk_fwd, dim3(grid), dim3(NTHR), args, pg8::STAGE_BYTES, stream);
    if (e != hipSuccess) fprintf(stderr, "cooperative launch failed: %s (grid %d)\n", hipGetErrorString(e), grid);
#endif
}
```

```cpp
#include <hip/hip_runtime.h>
#include <hip/hip_cooperative_groups.h>
#include <cstdio>
namespace cg = cooperative_groups;
#define MK_MULTI_LAUNCH 0
namespace pg8 {
#define PG8_LAS __attribute__((address_space(3)))
typedef unsigned short bf16_t;
typedef short bf16x8 __attribute__((ext_vector_type(8)));
typedef float f32x4 __attribute__((ext_vector_type(4)));
typedef unsigned u32x4 __attribute__((ext_vector_type(4)));
constexpr int BM = 256, BK = 64, HALF = 128, HTB = HALF * BK * 2  , STAGE_BYTES = 8 * HTB, NXCD = 8, WGM = 8;

__host__ __device__ __forceinline__ int lds_byte(int r, int c) { const int st = (r >> 4) * 2 + (c >> 5), rr = r & 15, cc = c & 31, ob = rr * 64 + cc * 2; return st * 1024 + (ob ^ (((ob >> 9) & 1) << 5)); }
__host__ __device__ __forceinline__ void stage_rc(int b, int& R, int& C) { const int st = b / 1024, sb = b % 1024, swz = sb ^ (((sb >> 9) & 1) << 5); R = (st >> 1) * 16 + swz / 64; C = (st & 1) * 32 + (swz % 64) / 2; }
__host__ __device__ __forceinline__ int perm32(int rho) { const int n = rho >> 4, i = rho & 15; return 8 * (i >> 2) + 4 * n + (i & 3); }

struct Unit { int pm, pn; };
struct Gemm { const bf16_t* A; const bf16_t* Bt; int M, N, K; };

struct StaticOrder {
    int nM, nN, nwg, G, c;
    __host__ __device__ void init(int M, int N, int G_, int c_) { nM = M / BM; nN = N / BM; nwg = nM * nN; G = G_; c = c_; }
    __host__ __device__ bool next(int i, Unit& u) const {
        const long L = (long)i * G + c; if (L >= nwg) return false;
        int wgid = (int)L; { const int q = nwg / NXCD, r = nwg % NXCD, xcd = wgid % NXCD, off = wgid / NXCD; wgid = (xcd < r ? xcd * (q + 1) : r * (q + 1) + (xcd - r) * q) + off; }
        const int nig = WGM * nN, gid = wgid / nig, fm = gid * WGM, gsz = (nM - fm) < WGM ? (nM - fm) : WGM;
        u.pm = fm + ((wgid % nig) % gsz); u.pn = (wgid % nig) / gsz; return true;
    }
    __device__ __forceinline__ void a_ready(const Unit&) const {}
    __device__ __forceinline__ void done(const Unit&) const {}
};
__device__ __forceinline__ unsigned cvt_pk_bf16(float lo, float hi) { unsigned r; asm volatile("v_cvt_pk_bf16_f32 %0, %1, %2" : "=v"(r) : "v"(lo), "v"(hi)); return r; }
typedef float f32x2 __attribute__((ext_vector_type(2)));
__device__ __forceinline__ f32x2 gelu_pk(f32x2 v) {
    const f32x2 av = __builtin_elementwise_abs(v), d = av * 0.2316418882f + 1.0f;
    f32x2 t; t.x = __builtin_amdgcn_rcpf(d.x); t.y = __builtin_amdgcn_rcpf(d.y);
    f32x2 q = t * 0.5307027145f + (-0.7265760135f); q = q * t + 0.7107068705f; q = q * t + (-0.142248368f); q = q * t + 0.127414796f; q = q * t;
    const f32x2 s = (v * v) * (-0.72134752044f);
    f32x2 e; e.x = __builtin_amdgcn_exp2f(s.x); e.y = __builtin_amdgcn_exp2f(s.y);
    const f32x2 m = v * (q * e), r = v - m;
    f32x2 o; o.x = v.x < 0.f ? m.x : r.x; o.y = v.y < 0.f ? m.y : r.y; return o;
}

struct EpiF32 {
    static constexpr bool PERM = false, AFTER_DRAIN = false;
    float* C; int ldc; const float* bias;
    __device__ __forceinline__ void operator()(const f32x4 (&acc)[2][2][4][2], const Unit& u, int wr, int wc, int fr, int fq) const {
        const int row0 = u.pm * BM + wr * 64 + fr, col0 = u.pn * BM + wc * 32 + 4 * fq;
        f32x4 bv[2][2];
#pragma unroll
        for (int bj = 0; bj < 2; ++bj)
#pragma unroll
            for (int n = 0; n < 2; ++n) bv[bj][n] = bias ? *(const f32x4*)(bias + col0 + bj * HALF + n * 16) : (f32x4){0.f, 0.f, 0.f, 0.f};
#pragma unroll
        for (int ai = 0; ai < 2; ++ai)
#pragma unroll
            for (int m = 0; m < 4; ++m) { float* rowp = C + (size_t)(row0 + ai * HALF + m * 16) * ldc + col0;
#pragma unroll
                for (int bj = 0; bj < 2; ++bj)
#pragma unroll
                    for (int n = 0; n < 2; ++n) *(f32x4*)(rowp + bj * HALF + n * 16) = acc[ai][bj][m][n] + bv[bj][n]; }
    }
};
template <int ACT  > struct EpiBf16 {
    static constexpr bool PERM = true, AFTER_DRAIN = false;
    bf16_t* O; int ldc; const float* bias; int split_cols; size_t split_stride; int nt;
    __device__ __forceinline__ void operator()(const f32x4 (&acc)[2][2][4][2], const Unit& u, int wr, int wc, int fr, int fq) const {
        const int row0 = u.pm * BM + wr * 64 + fr; int colt = u.pn * BM; bf16_t* base = O;
        if (split_cols) { const int t = colt / split_cols; base += (size_t)t * split_stride; colt -= t * split_cols; }
        const int col0 = colt + wc * 32 + 8 * fq, bcol0 = u.pn * BM + wc * 32 + 8 * fq;
        f32x4 bv[2][2];
#pragma unroll
        for (int bj = 0; bj < 2; ++bj)
#pragma unroll
            for (int n = 0; n < 2; ++n) bv[bj][n] = (f32x4){0.f, 0.f, 0.f, 0.f};
#pragma unroll
        for (int ai = 0; ai < 2; ++ai)
#pragma unroll
            for (int m = 0; m < 4; ++m) { bf16_t* rowp = base + (size_t)(row0 + ai * HALF + m * 16) * ldc + col0;
#pragma unroll
                for (int bj = 0; bj < 2; ++bj) { f32x4 v0 = acc[ai][bj][m][0] + bv[bj][0], v1 = acc[ai][bj][m][1] + bv[bj][1];
                    if (ACT == 1) { f32x2 a = gelu_pk((f32x2){v0[0], v0[1]}), b = gelu_pk((f32x2){v0[2], v0[3]}), c = gelu_pk((f32x2){v1[0], v1[1]}), d = gelu_pk((f32x2){v1[2], v1[3]});
                        v0 = (f32x4){a.x, a.y, b.x, b.y}; v1 = (f32x4){c.x, c.y, d.x, d.y}; }
                    if (ACT == 2) {
#pragma unroll
                        for (int j = 0; j < 4; ++j) { v0[j] = 0.5f * v0[j] * (1.0f + erff(v0[j] * 0.70710678f)); v1[j] = 0.5f * v1[j] * (1.0f + erff(v1[j] * 0.70710678f)); } }
                    u32x4 w; w.x = cvt_pk_bf16(v0[0], v0[1]); w.y = cvt_pk_bf16(v0[2], v0[3]); w.z = cvt_pk_bf16(v1[0], v1[1]); w.w = cvt_pk_bf16(v1[2], v1[3]);
                    if (nt) __builtin_nontemporal_store(w, (u32x4*)(rowp + bj * HALF)); else *(u32x4*)(rowp + bj * HALF) = w; } }
    }
};
template <class Epi, class Sched, bool STAMP = false>
__device__ __forceinline__ void gemm_phase(PG8_LAS unsigned char* lds, const Gemm g, const Sched& S, const Epi& E, unsigned long long* stamps, const int wid_s) {
    int tid_; asm volatile("v_mbcnt_lo_u32_b32 %0, -1, 0\n\tv_mbcnt_hi_u32_b32 %0, -1, %0" : "=v"(tid_)); tid_ += wid_s * 64; const int tid = tid_, wid = __builtin_amdgcn_readfirstlane(tid >> 6), lane = tid & 63, wr = wid >> 2, wc = wid & 3, fr = lane & 15, fq = lane >> 4;
    const int K = g.K, nt = K / BK;
    int ts_lo = 0, ts_hi = 0, nts = 0; const unsigned long long rt_entry = STAMP ? (unsigned long long)wall_clock64() : 0ull;
#define PG8_STAMP() do { if (STAMP && wid == 0 && nts < 64) { const unsigned long long _c = (unsigned long long)clock64(); \
        ts_lo = (lane == nts) ? (int)(unsigned)_c : ts_lo; ts_hi = (lane == nts) ? (int)(unsigned)(_c >> 32) : ts_hi; ++nts; } } while (0)
    PG8_STAMP();
    unsigned voffA[2], voffB[2];
#pragma unroll
    for (int i = 0; i < 2; ++i) { int R, C; stage_rc(tid * 16 + i * 8192, R, C); const int Rb = Epi::PERM ? ((R & ~31) + perm32(R & 31)) : R;
        voffA[i] = (unsigned)(R * K + C) * 2u; voffB[i] = (unsigned)(Rb * K + C) * 2u; }
    const size_t kstep = (size_t)(BK * 2);
    const size_t hstep = (size_t)HALF * K * 2;
    const size_t tstep = 2 * hstep;
    const unsigned ldsw = (unsigned)wid * 1024u;
    const int aoff = lds_byte(wr * 64 + fr, fq * 8), boff = lds_byte(wc * 32 + fr, fq * 8);
#define PG8_SA(b, h) (((b) * 2 + (h)) * HTB)
#define PG8_SB(b, h) ((4 + (b) * 2 + (h)) * HTB)
#define PG8_STAGE(bufoff, gbase, voff) do { _Pragma("unroll") for (int _i = 0; _i < 2; ++_i) \
        __builtin_amdgcn_global_load_lds((const unsigned*)((const char*)(gbase) + (voff)[_i]), (PG8_LAS unsigned*)(lds + (bufoff) + ldsw + _i * 8192), 16, 0, 0); } while (0)
#define PG8_LDA(dst, b, h) do { _Pragma("unroll") for (int m = 0; m < 4; ++m) _Pragma("unroll") for (int k = 0; k < 2; ++k) dst[m][k] = *(const PG8_LAS bf16x8*)(lds + PG8_SA(b, h) + aoff + m * 2048 + k * 1024); } while (0)
#define PG8_LDB(dst, b, h) do { _Pragma("unroll") for (int n = 0; n < 2; ++n) _Pragma("unroll") for (int k = 0; k < 2; ++k) dst[n][k] = *(const PG8_LAS bf16x8*)(lds + PG8_SB(b, h) + boff + n * 2048 + k * 1024); } while (0)
#define PG8_MMA(ai, bj, At, Bt) do { __builtin_amdgcn_s_setprio(1); _Pragma("unroll") for (int m = 0; m < 4; ++m) _Pragma("unroll") for (int n = 0; n < 2; ++n) _Pragma("unroll") for (int k = 0; k < 2; ++k) \
        acc[ai][bj][m][n] = __builtin_amdgcn_mfma_f32_16x16x32_bf16(Bt[n][k], At[m][k], acc[ai][bj][m][n], 0, 0, 0); __builtin_amdgcn_s_setprio(0); } while (0)
#define PG8_WAIT_V(n) asm volatile("s_waitcnt vmcnt(" #n ")" ::: "memory")
#define PG8_WAIT_L(n) asm volatile("s_waitcnt lgkmcnt(" #n ")" ::: "memory")
#define PG8_BAR __builtin_amdgcn_s_barrier()
#define PG8_SCHED __builtin_amdgcn_sched_barrier(0)
    Unit cur, nxt; int ui = 0;
    if (!S.next(0, cur)) return;
    f32x4 acc[2][2][4][2];
#pragma unroll
    for (int a = 0; a < 2; ++a)
#pragma unroll
        for (int b = 0; b < 2; ++b)
#pragma unroll
            for (int m = 0; m < 4; ++m)
#pragma unroll
                for (int n = 0; n < 2; ++n) acc[a][b][m][n] = (f32x4){0.f, 0.f, 0.f, 0.f};
    bf16x8 At[4][2], B0[2][2], B1[2][2];
    const char* cA = (const char*)g.A + (size_t)cur.pm * tstep; const char* cB = (const char*)g.Bt + (size_t)cur.pn * tstep;
    S.a_ready(cur);
    PG8_STAGE(PG8_SB(0, 0), cB, voffB); PG8_STAGE(PG8_SA(0, 0), cA, voffA); PG8_STAGE(PG8_SB(0, 1), cB + hstep, voffB); PG8_STAGE(PG8_SA(0, 1), cA + hstep, voffA);
    if (wr == 1) PG8_BAR;
    PG8_WAIT_V(4); PG8_BAR;
    PG8_STAGE(PG8_SB(1, 0), cB + kstep, voffB); PG8_STAGE(PG8_SA(1, 0), cA + kstep, voffA); PG8_STAGE(PG8_SB(1, 1), cB + hstep + kstep, voffB);
    PG8_WAIT_V(6); PG8_BAR;
    PG8_STAMP();
    for (;;) {
        const bool has_next = S.next(ui + 1, nxt);
        const char* nA = has_next ? (const char*)g.A + (size_t)nxt.pm * tstep : cA; const char* nB = has_next ? (const char*)g.Bt + (size_t)nxt.pn * tstep : cB;
        for (int t = 0; t < nt; t += 2) {
            const bool last = (t == nt - 2);
            const char* a1 = cA + (size_t)(t + 1) * kstep;
            const char* a2 = last ? nA : cA + (size_t)(t + 2) * kstep; const char* b2 = last ? nB : cB + (size_t)(t + 2) * kstep;
            const char* a3 = a2 + kstep; const char* b3 = b2 + kstep;
            if (last && has_next) S.a_ready(nxt);
            PG8_LDB(B0, 0, 0); PG8_SCHED; PG8_LDA(At, 0, 0); PG8_STAGE(PG8_SA(1, 1), a1 + hstep, voffA);
            PG8_WAIT_L(8); PG8_BAR; PG8_WAIT_L(0); PG8_MMA(0, 0, At, B0); PG8_BAR; PG8_SCHED;
            PG8_LDB(B1, 0, 1); PG8_STAGE(PG8_SB(0, 0), b2, voffB);
            PG8_BAR; PG8_WAIT_L(0); PG8_MMA(0, 1, At, B1); PG8_BAR;
            PG8_LDA(At, 0, 1); PG8_STAGE(PG8_SA(0, 0), a2, voffA);
            PG8_BAR; PG8_WAIT_L(0); PG8_MMA(1, 0, At, B0); PG8_BAR; PG8_SCHED;
            PG8_STAGE(PG8_SB(0, 1), b2 + hstep, voffB);
            PG8_WAIT_V(6); PG8_BAR; PG8_MMA(1, 1, At, B1); PG8_BAR;
            PG8_LDB(B0, 1, 0); PG8_SCHED; PG8_LDA(At, 1, 0); PG8_STAGE(PG8_SA(0, 1), a2 + hstep, voffA);
            PG8_WAIT_L(8); PG8_BAR; PG8_WAIT_L(0); PG8_MMA(0, 0, At, B0); PG8_BAR; PG8_SCHED;
            PG8_LDB(B1, 1, 1); PG8_STAGE(PG8_SB(1, 0), b3, voffB);
            PG8_BAR; PG8_WAIT_L(0); PG8_MMA(0, 1, At, B1); PG8_BAR;
            PG8_LDA(At, 1, 1); PG8_STAGE(PG8_SA(1, 0), a3, voffA);
            PG8_BAR; PG8_WAIT_L(0); PG8_MMA(1, 0, At, B0); PG8_BAR; PG8_SCHED;
            PG8_STAGE(PG8_SB(1, 1), b3 + hstep, voffB);
            PG8_WAIT_V(6); PG8_BAR; PG8_MMA(1, 1, At, B1); PG8_BAR;
        }
        PG8_STAMP();
        if constexpr (!Epi::AFTER_DRAIN) { E(acc, cur, wr, wc, fr, fq); S.done(cur); }
        PG8_STAMP();
        if (!has_next) break;
#pragma unroll
        for (int a = 0; a < 2; ++a)
#pragma unroll
            for (int b = 0; b < 2; ++b)
#pragma unroll
                for (int m = 0; m < 4; ++m)
#pragma unroll
                    for (int n = 0; n < 2; ++n) acc[a][b][m][n] = (f32x4){0.f, 0.f, 0.f, 0.f};
        cur = nxt; cA = nA; cB = nB; ++ui;
    }
    PG8_WAIT_V(0);
    if (wr == 0) PG8_BAR;
    PG8_BAR;
    if constexpr (Epi::AFTER_DRAIN) { E.fused(acc, cur, wr, wc, fr, fq, lds, wid, lane); S.done(cur); }
    PG8_STAMP();
    if (STAMP && wid == 0) { stamps[lane] = lane < nts ? (((unsigned long long)(unsigned)ts_hi << 32) | (unsigned)ts_lo) : 0ull;
        if (lane == 62) stamps[62] = rt_entry; if (lane == 63) stamps[63] = (unsigned long long)wall_clock64(); }
#undef PG8_STAMP
#undef PG8_SA
#undef PG8_SB
#undef PG8_STAGE
#undef PG8_LDA
#undef PG8_LDB
#undef PG8_MMA
#undef PG8_WAIT_V
#undef PG8_WAIT_L
#undef PG8_BAR
#undef PG8_SCHED
}
}
#define XB_TMO      128
#define XB_XCNT(j)  (256  + 64 * (j))
#define XB_XSUB(j)  (1280 + 64 * (j))
#define XB_XGEN(j)  (2304 + 64 * (j))
#define XB_TOP      3328
#define XB_TOPGEN   3392
#define XCD_BAR_WORDS 3456
#define XB_SPIN_CAP (1u << 18)
#define LAS __attribute__((address_space(3)))

__device__ __forceinline__ unsigned xb_ld(unsigned* p)              { return __hip_atomic_load(p, __ATOMIC_RELAXED, __HIP_MEMORY_SCOPE_AGENT); }
__device__ __forceinline__ unsigned xb_add(unsigned* p, unsigned v) { return __hip_atomic_fetch_add(p, v, __ATOMIC_RELAXED, __HIP_MEMORY_SCOPE_AGENT); }
__device__ __forceinline__ unsigned xb_xcc_id() { return (unsigned)__builtin_amdgcn_s_getreg((3 << 11) | 20) & 0xFu; }
#define XB_SPIN(cond, bar) do { unsigned _sp = 0; while (cond) { __builtin_amdgcn_s_sleep(1); \
    if ((++_sp & 255u) == 0u) { if (xb_ld(&(bar)[XB_TMO])) break; if (_sp > XB_SPIN_CAP) { atomicAdd(&(bar)[XB_TMO], 1u); break; } } } } while (0)

struct XcdBarrier {
    unsigned* bar; unsigned x;
    volatile LAS unsigned* st;
};

__device__ __forceinline__ XcdBarrier xcd_barrier_post(unsigned* bar, volatile LAS unsigned* st) {
    XcdBarrier b; b.bar = bar; b.x = xb_xcc_id(); b.st = st;
    if (threadIdx.x == 0) (void)xb_add(&bar[XB_XCNT(b.x)], 1u);
    return b;
}
__device__ __forceinline__ void xcd_barrier_complete(unsigned* bar, unsigned x, unsigned& nloc, unsigned& nx) {
    const unsigned G = gridDim.x * gridDim.y * gridDim.z;
    unsigned sum, cnt, mine, sp = 0u;
    for (;;) {
        sum = 0u; cnt = 0u; mine = 0u;
#pragma unroll
        for (unsigned j = 0; j < 16; ++j) { const unsigned c = xb_ld(&bar[XB_XCNT(j)]); sum += c; cnt += (c > 0u) ? 1u : 0u; mine = (j == x) ? c : mine; }
        if (sum == G) break;
        __builtin_amdgcn_s_sleep(1);
        if ((++sp & 255u) == 0u) { if (xb_ld(&bar[XB_TMO])) break; if (sp > XB_SPIN_CAP) { atomicAdd(&bar[XB_TMO], 1u); break; } }
    }
    nloc = mine > 0u ? mine : 1u; nx = cnt > 0u ? cnt : 1u;
}

__device__ __forceinline__ void xcd_barrier(const XcdBarrier& b, unsigned& st0, unsigned& st1, const bool t0  ) {
    asm volatile("s_waitcnt vmcnt(0)" ::: "memory");
    __syncthreads();
    if (t0) {
        unsigned* bar = b.bar;
        __builtin_amdgcn_s_waitcnt(0);
        unsigned nloc = st0, nx = st1;
        if (nloc == 0u) { xcd_barrier_complete(bar, b.x, nloc, nx); st0 = nloc; st1 = nx; }
        const unsigned old = xb_add(&bar[XB_XSUB(b.x)], 1u);
        const unsigned gen = old / nloc;
        if (old + 1u == (gen + 1u) * nloc) {
            __builtin_amdgcn_fence(__ATOMIC_RELEASE, "agent");
            asm volatile("s_waitcnt vmcnt(0)" ::: "memory");
            const unsigned og = xb_add(&bar[XB_TOP], 1u);
            const unsigned tg = og / nx;
            if (og + 1u == (tg + 1u) * nx) xb_add(&bar[XB_TOPGEN], 1u);
            else XB_SPIN(xb_ld(&bar[XB_TOPGEN]) == tg, bar);
            __builtin_amdgcn_fence(__ATOMIC_ACQUIRE, "agent");
            xb_add(&bar[XB_XGEN(b.x)], 1u);
            asm volatile("s_waitcnt vmcnt(0)" ::: "memory");
        } else {
            XB_SPIN(xb_ld(&bar[XB_XGEN(b.x)]) == gen, bar);
            __builtin_amdgcn_fence(__ATOMIC_ACQUIRE, "agent");
            asm volatile("s_waitcnt vmcnt(0)" ::: "memory");
        }
    }
    __syncthreads();
}

using pg8::bf16_t;
typedef float f32x4v __attribute__((ext_vector_type(4)));
typedef float f32x2v __attribute__((ext_vector_type(2)));
typedef unsigned u32x4v __attribute__((ext_vector_type(4)));
typedef unsigned u32x2v __attribute__((ext_vector_type(2)));

constexpr int DM = 1024, NB = 16, SEQ = 4096, DEPTH = 4, NTOK = NB * SEQ;
constexpr int DH = 512, NPT = 2560, DFF = 2816, DUP = 5632, HTOK = NTOK / 2;
constexpr int NTHR = 512;

constexpr size_t WL_WIN = 0, WL_WOUT = WL_WIN + (size_t)NPT * DM, WL_WUP = WL_WOUT + (size_t)DM * DM, WL_WDN = WL_WUP + (size_t)DUP * DM, WL_END = WL_WDN + (size_t)DM * DFF;
constexpr size_t WS_WBF = 0;
constexpr size_t WS_KF = WS_WBF + WL_END * 2 * DEPTH;
constexpr size_t WS_H3T = WS_KF + (size_t)2 * DH * SEQ * 8;
constexpr size_t WS_FH2 = WS_H3T + (size_t)2048 * SEQ * 4;
constexpr size_t WS_MOD = WS_FH2 + (size_t)DEPTH * SEQ * 64 * 4;
constexpr size_t WS_TW = WS_MOD + (size_t)DEPTH * NB * 6144 * 4;
constexpr size_t WS_H = WS_TW + 8192 * 8;
constexpr size_t WS_BIG = WS_H + (size_t)NTOK * DM * 2;
constexpr size_t WS_PT = WS_BIG, WS_YT = WS_PT + (size_t)NB * NPT * SEQ * 2, WS_Y = WS_YT + (size_t)NTOK * DM * 2, WS_MIX_END = WS_Y + (size_t)NTOK * DM * 2;
constexpr size_t WS_YO = WS_PT;
constexpr size_t WS_U = WS_BIG, WS_G = WS_U + (size_t)HTOK * DUP * 2, WS_YD0 = WS_G + (size_t)HTOK * DFF * 2, WS_FFN_END = WS_YD0 + (size_t)HTOK * DM * 2;
constexpr size_t WS_YD1 = WS_U;
constexpr size_t WS_XB = WS_MIX_END > WS_FFN_END ? WS_MIX_END : WS_FFN_END;
constexpr size_t WS_BAR = WS_XB + (size_t)NTOK * DM * 2;
constexpr size_t WS_NEED = WS_BAR + XCD_BAR_WORDS * 4;

static_assert(WS_KF % 256 == 0 && WS_H % 256 == 0 && WS_BIG % 256 == 0 && WS_G % 256 == 0 && WS_YD0 % 256 == 0 && WS_XB % 256 == 0, "align");

enum { I_X = 0, I_C, I_ADAW, I_ADAB, I_GMPRE, I_GMPOST, I_WIN, I_SW, I_SB, I_FW1, I_FB1, I_FW2, I_FB2, I_FFREQ, I_FW3, I_HD, I_FNW, I_WOUT, I_GFPRE, I_GFPOST, I_WUP, I_DWW, I_DWB, I_WDOWN };
struct Params { const float* in[24]; float* out; unsigned char* ws; int ph_lo, ph_hi; };

__device__ __forceinline__ float bf2f(bf16_t v) { return __uint_as_float(((unsigned)v) << 16); }
__device__ __forceinline__ unsigned pack2(float lo, float hi) { unsigned r; asm("v_cvt_pk_bf16_f32 %0, %1, %2" : "=v"(r) : "v"(lo), "v"(hi)); return r; }
__device__ __forceinline__ bf16_t f2bf(float f) { return (bf16_t)(pack2(f, f) & 0xffffu); }
__device__ __forceinline__ int lane_now() { int l; asm volatile("v_mbcnt_lo_u32_b32 %0, -1, 0\n\tv_mbcnt_hi_u32_b32 %0, -1, %0" : "=v"(l)); return l; }
__device__ __forceinline__ int opaque_tid_(int wid_s) { return wid_s * 64 + lane_now(); }
#define opaque_tid() opaque_tid_(wid_s)
__device__ __forceinline__ float wave_sum(float v) {
#pragma unroll
    for (int o = 32; o >= 1; o >>= 1) v += __shfl_xor(v, o);
    return v;
}

template <class T> __device__ __forceinline__ void dft4(T& r0, T& i0, T& r1, T& i1, T& r2, T& i2, T& r3, T& i3) {
    const T s0r = r0 + r2, s0i = i0 + i2, s1r = r0 - r2, s1i = i0 - i2;
    const T s2r = r1 + r3, s2i = i1 + i3, s3r = r1 - r3, s3i = i1 - i3;
    r0 = s0r + s2r; i0 = s0i + s2i; r2 = s0r - s2r; i2 = s0i - s2i;
    r1 = s1r + s3i; i1 = s1i - s3r; r3 = s1r - s3i; i3 = s1i + s3r;
}
template <int K, class T> __device__ __forceinline__ void tw16(T& r, T& i) {
    if constexpr (K == 0) { }
    else if constexpr (K == 4) { const T t = r; r = i; i = -t; }
    else {
        constexpr float C[10] = {1.f, 0.92387953251128674f, 0.70710678118654752f, 0.38268343236508977f, 0.f, -0.38268343236508977f, -0.70710678118654752f, -0.92387953251128674f, -1.f, -0.92387953251128674f};
        constexpr float S[10] = {0.f, -0.38268343236508977f, -0.70710678118654752f, -0.92387953251128674f, -1.f, -0.92387953251128674f, -0.70710678118654752f, -0.38268343236508977f, 0.f, 0.38268343236508977f};
        const float c = C[K], s = S[K]; const T t = r * c - i * s; i = r * s + i * c; r = t;
    }
}
template <class T> __device__ __forceinline__ void dft16(T (&xr)[16], T (&xi)[16]) {
#pragma unroll
    for (int b = 0; b < 4; ++b) dft4(xr[b], xi[b], xr[4 + b], xi[4 + b], xr[8 + b], xi[8 + b], xr[12 + b], xi[12 + b]);
    tw16<1>(xr[5], xi[5]); tw16<2>(xr[6], xi[6]); tw16<3>(xr[7], xi[7]);
    tw16<2>(xr[9], xi[9]); tw16<4>(xr[10], xi[10]); tw16<6>(xr[11], xi[11]);
    tw16<3>(xr[13], xi[13]); tw16<6>(xr[14], xi[14]); tw16<9>(xr[15], xi[15]);
#pragma unroll
    for (int c = 0; c < 4; ++c) dft4(xr[4 * c], xi[4 * c], xr[4 * c + 1], xi[4 * c + 1], xr[4 * c + 2], xi[4 * c + 2], xr[4 * c + 3], xi[4 * c + 3]);
#pragma unroll
    for (int c = 0; c < 4; ++c)
#pragma unroll
        for (int d = c + 1; d < 4; ++d) { T t = xr[4 * c + d]; xr[4 * c + d] = xr[4 * d + c]; xr[4 * d + c] = t; t = xi[4 * c + d]; xi[4 * c + d] = xi[4 * d + c]; xi[4 * d + c] = t; }
}
constexpr int PBUF = 4096;
constexpr int LDS_MAIN = 2 * PBUF * 16;
constexpr int LDS_KF = LDS_MAIN;
__device__ __forceinline__ void fft4096_pk(f32x2v (&xr)[16], f32x2v (&xi)[16], f32x4v* buf, const int t, const f32x2v* __restrict__ TW) {
    dft16(xr, xi);
    __syncthreads();
    {
        f32x2v w1 = TW[2 * t]; asm volatile("" : "+v"(w1.x), "+v"(w1.y));
        float wr = w1.x, wi = w1.y;
        buf[t] = (f32x4v){xr[0].x, xr[0].y, xi[0].x, xi[0].y};
#pragma unroll
        for (int k = 1; k < 16; ++k) {
            const f32x2v r = xr[k], i = xi[k]; const f32x2v nr = r * wr - i * wi, ni = r * wi + i * wr;
            buf[k * 256 + t] = (f32x4v){nr.x, nr.y, ni.x, ni.y};
            if (k < 15) { const float n2 = wr * w1.x - wi * w1.y; wi = wr * w1.y + wi * w1.x; wr = n2; }
        }
    }
    __syncthreads();
    const int k1 = t >> 4, m2 = t & 15;
#pragma unroll
    for (int m = 0; m < 16; ++m) { const f32x4v v = buf[k1 * 256 + 16 * m + m2]; xr[m] = (f32x2v){v.x, v.y}; xi[m] = (f32x2v){v.z, v.w}; }
    __syncthreads();
    dft16(xr, xi);
    {
        f32x2v w1 = TW[32 * m2]; asm volatile("" : "+v"(w1.x), "+v"(w1.y));
        float wr = w1.x, wi = w1.y;
        buf[m2 * 256 + (k1 ^ (m2 & 7))] = (f32x4v){xr[0].x, xr[0].y, xi[0].x, xi[0].y};
#pragma unroll
        for (int j = 1; j < 16; ++j) {
            const f32x2v r = xr[j], i = xi[j]; const f32x2v nr = r * wr - i * wi, ni = r * wi + i * wr;
            buf[m2 * 256 + ((k1 + 16 * j) ^ (m2 & 7))] = (f32x4v){nr.x, nr.y, ni.x, ni.y};
            if (j < 15) { const float n2 = wr * w1.x - wi * w1.y; wi = wr * w1.y + wi * w1.x; wr = n2; }
        }
    }
    __syncthreads();
#pragma unroll
    for (int m = 0; m < 16; ++m) { const f32x4v v = buf[m * 256 + (t ^ (m & 7))]; xr[m] = (f32x2v){v.x, v.y}; xi[m] = (f32x2v){v.z, v.w}; }
    dft16(xr, xi);
}
__device__ __forceinline__ f32x2v w32(int j) {
    constexpr float C[16] = {1.f, 0.98078528040323043f, 0.92387953251128674f, 0.83146961230254524f, 0.70710678118654752f, 0.55557023301960218f, 0.38268343236508977f, 0.19509032201612825f, 0.f, -0.19509032201612825f, -0.38268343236508977f, -0.55557023301960218f, -0.70710678118654752f, -0.83146961230254524f, -0.92387953251128674f, -0.98078528040323043f};
    constexpr float S[16] = {0.f, -0.19509032201612825f, -0.38268343236508977f, -0.55557023301960218f, -0.70710678118654752f, -0.83146961230254524f, -0.92387953251128674f, -0.98078528040323043f, -1.f, -0.98078528040323043f, -0.92387953251128674f, -0.83146961230254524f, -0.70710678118654752f, -0.55557023301960218f, -0.38268343236508977f, -0.19509032201612825f};
    return (f32x2v){C[j], S[j]};
}
constexpr int LDS_BYTES = LDS_MAIN + 32768;
static_assert(LDS_MAIN >= pg8::STAGE_BYTES, "lds");
typedef _Float16 f16x4v __attribute__((ext_vector_type(4)));
__device__ __forceinline__ void kf_dma(const unsigned char* src, unsigned char* kfl, int tid) {
    const int w = __builtin_amdgcn_readfirstlane(tid >> 6), lane = tid & 63;
#pragma unroll
    for (int q = 0; q < 4; ++q)
        __builtin_amdgcn_global_load_lds((const unsigned*)(src + (w * 4 + q) * 1024 + lane * 16), (LAS unsigned*)(kfl + (w * 4 + q) * 1024), 16, 0, 0);
}
__device__ __forceinline__ bf16_t* wbf(const Params& P, int l, size_t off) { return (bf16_t*)(P.ws + WS_WBF) + (size_t)l * WL_END + off; }
__device__ __forceinline__ const float* modp(const Params& P, int l, int which) { return (const float*)(P.ws + WS_MOD) + (size_t)l * NB * 6144 + which * 1024; }

__device__ __forceinline__ void ph_tconv(const Params& P, float* tile, const int wid_s) {
    const int tid = opaque_tid();
    for (int it = blockIdx.x; it < DEPTH * 2752; it += gridDim.x) {
        const int l = it / 2752; int r = it % 2752;
        const float* src; int ldsrc, lddst, tk, tn; bf16_t* dst;
        if (r < 384) { src = P.in[I_WIN] + (size_t)l * DM * 2048; ldsrc = 2048; lddst = DM; tk = r / 24; tn = r % 24; dst = wbf(P, l, WL_WIN); }
        else if (r < 640) { r -= 384; src = P.in[I_WOUT] + (size_t)l * DM * DM; ldsrc = DM; lddst = DM; tk = r / 16; tn = r % 16; dst = wbf(P, l, WL_WOUT); }
        else if (r < 2048) { r -= 640; src = P.in[I_WUP] + (size_t)l * DM * DUP; ldsrc = DUP; lddst = DM; tk = r / 88; tn = r % 88; dst = wbf(P, l, WL_WUP); }
        else { r -= 2048; src = P.in[I_WDOWN] + (size_t)l * DFF * DM; ldsrc = DM; lddst = DFF; tk = r / 16; tn = r % 16; dst = wbf(P, l, WL_WDN); }
        { const int kk = tid >> 3, c8 = (tid & 7) * 8; const float* s = src + (size_t)(tk * 64 + kk) * ldsrc + tn * 64 + c8; const f32x4v v0 = *(const f32x4v*)s, v1 = *(const f32x4v*)(s + 4);
          float* t = tile + kk * 65 + c8; t[0] = v0.x; t[1] = v0.y; t[2] = v0.z; t[3] = v0.w; t[4] = v1.x; t[5] = v1.y; t[6] = v1.z; t[7] = v1.w; }
        __syncthreads();
        { const int nn = tid >> 3, k8 = (tid & 7) * 8; const float* t = tile + k8 * 65 + nn;
          *(u32x4v*)(dst + (size_t)(tn * 64 + nn) * lddst + tk * 64 + k8) = (u32x4v){pack2(t[0], t[65]), pack2(t[130], t[195]), pack2(t[260], t[325]), pack2(t[390], t[455])}; }
        __syncthreads();
    }
}
__device__ __forceinline__ void ph_fold(const Params& P, float* lds, const int wid_s) {
    const int tid = opaque_tid();
    float* CW = lds; float* SWm = lds + 4096; float* ct = lds + 8192; float* st = lds + 8192 + 64;
    for (int it = blockIdx.x; it < DEPTH * 64; it += gridDim.x) {
        const int l = it >> 6, g = (it >> 3) & 7, kc = it & 7;
        const float* Wg = P.in[I_FNW] + ((size_t)l * 8 + g) * 4096;
        if (tid < 64) { float s, c; sincospif((float)tid * (1.0f / 32.0f), &s, &c); ct[tid] = c; st[tid] = s; }
        __syncthreads();
        for (int idx = tid; idx < 4096; idx += NTHR) { const int c = idx >> 6, d = idx & 63; float ac = 0.f, as = 0.f;
            for (int m = 0; m < 64; ++m) { const float w = Wg[m * 64 + d]; const int ph = (c * m) & 63; ac += ct[ph] * w; as += st[ph] * w; }
            CW[idx] = ac * (1.0f / 512.0f); SWm[idx] = as * (1.0f / 512.0f); }
        __syncthreads();
        bf16_t* WinT = wbf(P, l, WL_WIN);
        for (int idx = tid; idx < 2 * 64 * 128; idx += NTHR) { const int which = idx >> 13, d = (idx >> 7) & 63, kk = idx & 127, k = kc * 128 + kk;
            const float* row = P.in[I_WIN] + ((size_t)l * DM + k) * 2048 + 1536 + 64 * g; const float* Mx = which ? SWm : CW; float a = 0.f;
            for (int c = 0; c < 64; ++c) a += row[c] * Mx[c * 64 + d];
            WinT[(size_t)(1536 + which * 512 + g * 64 + d) * DM + k] = f2bf(a); }
        __syncthreads();
    }
}
__device__ __forceinline__ void ph_mod(const Params& P, float* lds, const int wid_s) {
    const int tid = opaque_tid();
    float* cact = lds;
    float* red = lds + 16384;
    if ((int)blockIdx.x >= DEPTH * 96) return;
    for (int idx = tid; idx < NB * DM; idx += NTHR) { const int b = idx >> 10, k = idx & 1023; const float v = P.in[I_C][idx]; cact[k * 16 + b] = v / (1.0f + __expf(-v)); }
    __syncthreads();
    for (int it = blockIdx.x; it < DEPTH * 96; it += gridDim.x) {
        const int l = it / 96, n0 = (it % 96) * 64, ks = tid >> 6, nn = tid & 63;
        float acc[16];
#pragma unroll
        for (int b = 0; b < 16; ++b) acc[b] = 0.f;
        const float* w = P.in[I_ADAW] + ((size_t)l * DM + ks * 128) * 6144 + n0 + nn;
        for (int k = 0; k < 128; ++k) { const float wv = w[(size_t)k * 6144]; const f32x4v* cp = (const f32x4v*)(cact + (ks * 128 + k) * 16);
#pragma unroll
            for (int q = 0; q < 4; ++q) { const f32x4v cv = cp[q]; acc[4 * q] += cv.x * wv; acc[4 * q + 1] += cv.y * wv; acc[4 * q + 2] += cv.z * wv; acc[4 * q + 3] += cv.w * wv; } }
#pragma unroll
        for (int b = 0; b < 16; ++b) red[(ks * 64 + nn) * 16 + b] = acc[b];
        __syncthreads();
        for (int idx = tid; idx < 1024; idx += NTHR) { const int b = idx >> 6, n = idx & 63; float s = P.in[I_ADAB][(size_t)l * 6144 + n0 + n];
#pragma unroll
            for (int q = 0; q < 8; ++q) s += red[(q * 64 + n) * 16 + b];
            ((float*)(P.ws + WS_MOD))[((size_t)l * NB + b) * 6144 + n0 + n] = s; }
        __syncthreads();
    }
}
__device__ __forceinline__ void ph_tw(const Params& P, const int wid_s) {
    f32x2v* TW = (f32x2v*)(P.ws + WS_TW);
    const int tid = opaque_tid();
    for (int j = blockIdx.x * NTHR + tid; j < 8192; j += gridDim.x * NTHR) { float s, c; sincospif((float)j * (1.0f / 4096.0f), &s, &c); TW[j] = (f32x2v){c, -s}; }
}
__device__ __forceinline__ void ph_fh2(const Params& P, float* lds, const int wid_s) {
    const int tid = opaque_tid(), p = tid >> 6, j = tid & 63;
    float* z = lds;
    float* h1 = lds + 8 * 36;
    for (int it = blockIdx.x; it < DEPTH * 512; it += gridDim.x) {
        const int l = it >> 9, pos = (it & 511) * 8 + p;
        if (j < 33) { float v;
            if (j == 0) v = (float)pos / 4095.0f;
            else { const int bi = (j - 1) & 15; const float band = 1e-4f + (float)bi * ((15.0f - 1e-4f) / 15.0f); float s, c; sincospif((float)pos * band * (2.0f / 4096.0f), &s, &c); v = (j <= 16) ? c : -s; }
            z[p * 36 + j] = v; }
        __syncthreads();
        const float fr = P.in[I_FFREQ][l * 64 + j];
        { float a = P.in[I_FB1][l * 64 + j]; const float* w1 = P.in[I_FW1] + (size_t)l * 33 * 64 + j;
          for (int i = 0; i < 33; ++i) a += z[p * 36 + i] * w1[i * 64];
          h1[p * 64 + j] = sinf(fr * a); }
        __syncthreads();
        { float a = P.in[I_FB2][l * 64 + j]; const float* w2 = P.in[I_FW2] + (size_t)l * 64 * 64 + j;
          for (int i = 0; i < 64; ++i) a += h1[p * 64 + i] * w2[i * 64];
          ((float*)(P.ws + WS_FH2))[((size_t)l * SEQ + pos) * 64 + j] = sinf(fr * a); }
        __syncthreads();
    }
}
__device__ __forceinline__ void ph_h3t(const Params& P, int l, float* lds, const int wid_s) {
    const int tid = opaque_tid(), pq = tid & 31, cq = tid >> 5;
    float* AT = lds;
    float* Bs = lds + 64 * 132;
    const float* FH2 = (const float*)(P.ws + WS_FH2) + (size_t)l * SEQ * 64; const float* w3 = P.in[I_FW3] + (size_t)l * 64 * 2048; float* H3T = (float*)(P.ws + WS_H3T);
    for (int it = blockIdx.x; it < 32 * 16; it += gridDim.x) {
        const int p0 = (it & 31) * 128, c0 = (it >> 5) * 128;
#pragma unroll
        for (int i = 0; i < 16; ++i) { const int idx = tid + 512 * i; { const int r = idx >> 6, q = idx & 63; AT[q * 132 + r] = FH2[(size_t)(p0 + r) * 64 + q]; } { const int q = idx >> 7, cc = idx & 127; Bs[q * 128 + cc] = w3[(size_t)q * 2048 + c0 + cc]; } }
        __syncthreads();
        f32x4v acc[8];
#pragma unroll
        for (int j = 0; j < 8; ++j) acc[j] = (f32x4v){0.f, 0.f, 0.f, 0.f};
#pragma unroll 4
        for (int q = 0; q < 64; ++q) { const f32x4v a = *(const f32x4v*)(AT + q * 132 + pq * 4), b0 = *(const f32x4v*)(Bs + q * 128 + cq * 8), b1 = *(const f32x4v*)(Bs + q * 128 + cq * 8 + 4);
            acc[0] += a * b0.x; acc[1] += a * b0.y; acc[2] += a * b0.z; acc[3] += a * b0.w; acc[4] += a * b1.x; acc[5] += a * b1.y; acc[6] += a * b1.z; acc[7] += a * b1.w; }
#pragma unroll
        for (int j = 0; j < 8; ++j) *(f32x4v*)(H3T + (size_t)(c0 + cq * 8 + j) * SEQ + p0 + pq * 4) = acc[j];
        __syncthreads();
    }
}
__device__ __forceinline__ void ph_kf(const Params& P, int l, float* lds, const int wid_s) {
    const int tid = opaque_tid(), hh = tid >> 8, t = tid & 255;
    f32x4v* buf = (f32x4v*)lds + hh * PBUF; float* red = (float*)((f32x4v*)lds + hh * PBUF);
    const f32x2v* TW = (const f32x2v*)(P.ws + WS_TW); const float* H3T = (const float*)(P.ws + WS_H3T); f16x4v* KF = (f16x4v*)(P.ws + WS_KF);
    const float min_decay = -4.605170185988091f / 1.5f, max_decay = -4.605170185988091f / 0.3f;
    for (int it0 = blockIdx.x * 2; it0 < 2 * DH; it0 += gridDim.x * 2) {
        const int it = it0 + hh, n = it >> 9, c = it & 511;
        int tv = t; asm volatile("" : "+v"(tv));
        const float ad = fabsf(min_decay + (float)c * ((max_decay - min_decay) / 511.0f));
        const float* fw = H3T + (size_t)(n * 1024 + c) * SEQ; const float* bw = H3T + (size_t)(n * 1024 + 512 + c) * SEQ;
        float fr[16], br[16]; float l1 = 0.f;
#pragma unroll
        for (int j = 0; j < 16; ++j) { const int m = tv + 256 * j;
            const float f = fw[m] * __expf(-((float)m * (1.0f / 4095.0f)) * ad);
            const float b = (m == 0) ? 0.f : bw[SEQ - m] * __expf(-((float)(SEQ - m) * (1.0f / 4095.0f)) * ad);
            l1 += fabsf(f) + fabsf(b); fr[j] = f; br[j] = b; }
        l1 = wave_sum(l1);
        __syncthreads();
        if ((tid & 63) == 0) red[(tid >> 6) & 3] = l1;
        __syncthreads();
        const float tot = red[0] + red[1] + red[2] + red[3];
        const float sc = 1.0f / (tot + 1e-6f);
        f32x2v wt = TW[tv]; asm volatile("" : "+v"(wt.x), "+v"(wt.y));
        f32x2v xr[16], xi[16];
#pragma unroll
        for (int j = 0; j < 16; ++j) { const f32x2v wj = w32(j); const float wx = wt.x * wj.x - wt.y * wj.y, wy = wt.x * wj.y + wt.y * wj.x; const float s = (fr[j] + br[j]) * sc, d = (fr[j] - br[j]) * sc;
            xr[j] = (f32x2v){s, d * wx}; xi[j] = (f32x2v){0.f, d * wy}; }
        fft4096_pk(xr, xi, buf, tv, TW);
        const float dsk = P.in[I_HD][(size_t)l * 2 * DH + it];
        f16x4v* o = KF + (size_t)it * SEQ;
#pragma unroll
        for (int j = 0; j < 16; ++j) o[tv + 256 * j] = (f16x4v){(_Float16)(xr[j].x + dsk), (_Float16)(xr[j].y + dsk), (_Float16)xi[j].x, (_Float16)xi[j].y};
    }
    __syncthreads();
}
template <int XI, int XO>
__device__ __forceinline__ void ph_resnorm(const void* xin_, void* xout_, const bf16_t* y, const bf16_t* y_hi  , const float* gpost, const float* gate, const float* gnext, const float* scale, const float* shift, bf16_t* hout, const int wid_s) {
    constexpr int RW = 4;
    const int tid = opaque_tid(); const int lane = tid & 63, wv = tid >> 6;
    for (int row0 = (blockIdx.x * 8 + wv) * RW; row0 < NTOK; row0 += gridDim.x * 8 * RW) {
        const int b = row0 >> 12; f32x4v x[RW][4]; u32x2v yw[RW][4];
#pragma unroll
        for (int r = 0; r < RW; ++r)
#pragma unroll
            for (int q = 0; q < 4; ++q) { const size_t off = (size_t)(row0 + r) * DM + q * 256 + lane * 4;
                if (XI) { const u32x2v w = __builtin_nontemporal_load((const u32x2v*)((const bf16_t*)xin_ + off)); x[r][q] = (f32x4v){__uint_as_float(w.x << 16), __uint_as_float(w.x & 0xffff0000u), __uint_as_float(w.y << 16), __uint_as_float(w.y & 0xffff0000u)}; }
                else x[r][q] = __builtin_nontemporal_load((const f32x4v*)((const float*)xin_ + off));
                if (y) yw[r][q] = __builtin_nontemporal_load((const u32x2v*)((row0 < HTOK ? y : y_hi - (size_t)HTOK * DM) + off)); }
        if (y) {
            f32x4v g[4];
#pragma unroll
            for (int q = 0; q < 4; ++q) { const int c = q * 256 + lane * 4; g[q] = *(const f32x4v*)(gpost + c) * *(const f32x4v*)(gate + (size_t)b * 6144 + c); }
#pragma unroll
            for (int r = 0; r < RW; ++r) {
                f32x4v yv[4]; float ss = 0.f;
#pragma unroll
                for (int q = 0; q < 4; ++q) { const u32x2v w = yw[r][q];
                    yv[q] = (f32x4v){__uint_as_float(w.x << 16), __uint_as_float(w.x & 0xffff0000u), __uint_as_float(w.y << 16), __uint_as_float(w.y & 0xffff0000u)};
                    ss += yv[q].x * yv[q].x + yv[q].y * yv[q].y + yv[q].z * yv[q].z + yv[q].w * yv[q].w; }
                ss = wave_sum(ss); const float rinv = rsqrtf(ss * (1.0f / 1024.0f) + 1e-6f);
#pragma unroll
                for (int q = 0; q < 4; ++q) { const size_t off = (size_t)(row0 + r) * DM + q * 256 + lane * 4; x[r][q] = x[r][q] + g[q] * (yv[q] * rinv);
                    if (XO) { u32x2v w; w.x = pack2(x[r][q].x, x[r][q].y); w.y = pack2(x[r][q].z, x[r][q].w); __builtin_nontemporal_store(w, (u32x2v*)((bf16_t*)xout_ + off));
                        x[r][q] = (f32x4v){__uint_as_float(w.x << 16), __uint_as_float(w.x & 0xffff0000u), __uint_as_float(w.y << 16), __uint_as_float(w.y & 0xffff0000u)}; }
                    else __builtin_nontemporal_store(x[r][q], (f32x4v*)((float*)xout_ + off)); }
            }
        }
        if (hout) {
            f32x4v g[4], sh[4];
#pragma unroll
            for (int q = 0; q < 4; ++q) { const int c = q * 256 + lane * 4; g[q] = *(const f32x4v*)(gnext + c); const f32x4v sc = *(const f32x4v*)(scale + (size_t)b * 6144 + c); sh[q] = *(const f32x4v*)(shift + (size_t)b * 6144 + c); g[q] = g[q] * (sc + 1.0f); }
#pragma unroll
            for (int r = 0; r < RW; ++r) {
                float ss = 0.f;
#pragma unroll
                for (int q = 0; q < 4; ++q) ss += x[r][q].x * x[r][q].x + x[r][q].y * x[r][q].y + x[r][q].z * x[r][q].z + x[r][q].w * x[r][q].w;
                ss = wave_sum(ss); const float rinv = rsqrtf(ss * (1.0f / 1024.0f) + 1e-6f);
#pragma unroll
                for (int q = 0; q < 4; ++q) { const f32x4v hv = x[r][q] * rinv * g[q] + sh[q]; u32x2v w; w.x = pack2(hv.x, hv.y); w.y = pack2(hv.z, hv.w);
                    *(u32x2v*)(hout + (size_t)(row0 + r) * DM + q * 256 + lane * 4) = w; }
            }
        }
    }
}
__device__ __forceinline__ void stage_sconv(const bf16_t* PT, int col, int b0, float w0, float w1, float w2, float bs, float* gl, int t) {
    const int rsel = t >> 7, seg = t & 127;
#pragma unroll
    for (int q = 0; q < 2; ++q) {
        const int e0 = q * 2048 + seg * 16; const bf16_t* row = PT + ((size_t)(b0 + rsel) * NPT + col) * SEQ + e0;
        const u32x4v A = *(const u32x4v*)row, B = *(const u32x4v*)(row + 8);
        float e[18]; e[0] = e0 ? bf2f(row[-1]) : 0.f; e[17] = (e0 + 16 < SEQ) ? bf2f(row[16]) : 0.f;
        e[1] = __uint_as_float(A.x << 16); e[2] = __uint_as_float(A.x & 0xffff0000u); e[3] = __uint_as_float(A.y << 16); e[4] = __uint_as_float(A.y & 0xffff0000u);
        e[5] = __uint_as_float(A.z << 16); e[6] = __uint_as_float(A.z & 0xffff0000u); e[7] = __uint_as_float(A.w << 16); e[8] = __uint_as_float(A.w & 0xffff0000u);
        e[9] = __uint_as_float(B.x << 16); e[10] = __uint_as_float(B.x & 0xffff0000u); e[11] = __uint_as_float(B.y << 16); e[12] = __uint_as_float(B.y & 0xffff0000u);
        e[13] = __uint_as_float(B.z << 16); e[14] = __uint_as_float(B.z & 0xffff0000u); e[15] = __uint_as_float(B.w << 16); e[16] = __uint_as_float(B.w & 0xffff0000u);
        f32x4v* o = (f32x4v*)(gl + rsel * SEQ + e0);
#pragma unroll
        for (int u = 0; u < 4; ++u) { f32x4v v;
            v.x = bs + e[4 * u] * w0 + e[4 * u + 1] * w1 + e[4 * u + 2] * w2; v.y = bs + e[4 * u + 1] * w0 + e[4 * u + 2] * w1 + e[4 * u + 3] * w2;
            v.z = bs + e[4 * u + 2] * w0 + e[4 * u + 3] * w1 + e[4 * u + 4] * w2; v.w = bs + e[4 * u + 3] * w0 + e[4 * u + 4] * w1 + e[4 * u + 5] * w2; o[u] = v; }
    }
}
__device__ __forceinline__ void store_rows2(const float (&v0)[16], const float (&v1)[16], bf16_t* st, bf16_t* o0, bf16_t* o1, int tv) {
#pragma unroll
    for (int j = 0; j < 16; ++j) { const unsigned w = pack2(v0[j], v1[j]); st[tv + 256 * j] = (bf16_t)(w & 0xffffu); st[SEQ + tv + 256 * j] = (bf16_t)(w >> 16); }
    __syncthreads();
    const int r = tv >> 7, seg = tv & 127; bf16_t* o = r ? o1 : o0;
#pragma unroll
    for (int q = 0; q < 4; ++q) *(u32x4v*)(o + q * 1024 + seg * 8) = *(const u32x4v*)(st + r * SEQ + q * 1024 + seg * 8);
}
__device__ __forceinline__ void ph_mix(const Params& P, int l, float* lds, const int wid_s) {
    const int tid = opaque_tid(), hh = tid >> 8, t = tid & 255;
    f32x4v* buf = (f32x4v*)lds + hh * PBUF; float* gl = (float*)buf;
    const f32x2v* TW = (const f32x2v*)(P.ws + WS_TW); const unsigned char* KF = P.ws + WS_KF; unsigned char* kfl = (unsigned char*)lds + LDS_KF;
    const bf16_t* PT = (const bf16_t*)(P.ws + WS_PT); bf16_t* YT = (bf16_t*)(P.ws + WS_YT);
    const float* sw = P.in[I_SW] + (size_t)l * 3 * 1536; const float* sb = P.in[I_SB] + (size_t)l * 1536;
    if ((int)blockIdx.x * 2 < DH * 8) kf_dma(KF + (size_t)(blockIdx.x >> 2) * 32768, kfl, tid);
    for (int it0 = blockIdx.x * 2; it0 < DH * 8; it0 += gridDim.x * 2) {
        const int it = it0 + hh, c = it >> 3, bp = it & 7, b0 = 2 * bp;
        int tv = t; asm volatile("" : "+v"(tv));
        float zr[16], zi[16];
        __syncthreads();
        stage_sconv(PT, c, b0, sw[c], sw[1536 + c], sw[3072 + c], sb[c], gl, tv);
        __syncthreads();
#pragma unroll
        for (int j = 0; j < 16; ++j) { zr[j] = gl[tv + 256 * j]; zi[j] = gl[SEQ + tv + 256 * j]; }
#pragma unroll 1
        for (int n = 0; n < 2; ++n) {
            f32x2v wt = TW[tv]; asm volatile("" : "+v"(wt.x), "+v"(wt.y));
            f32x2v xr[16], xi[16];
#pragma unroll
            for (int j = 0; j < 16; ++j) { const f32x2v wj = w32(j); const float wx = wt.x * wj.x - wt.y * wj.y, wy = wt.x * wj.y + wt.y * wj.x;
                xr[j] = (f32x2v){zr[j], zr[j] * wx - zi[j] * wy}; xi[j] = (f32x2v){zi[j], zr[j] * wy + zi[j] * wx}; }
            fft4096_pk(xr, xi, buf, tv, TW);
#pragma unroll
            for (int j = 0; j < 16; ++j) asm volatile("" : "+v"(xr[j]), "+v"(xi[j]));
            asm volatile("s_waitcnt vmcnt(0)" ::: "memory"); __syncthreads();
#pragma unroll
            for (int j = 0; j < 16; ++j) { const f16x4v k = *(const f16x4v*)(kfl + (tv + 256 * j) * 8); const f32x2v kr = (f32x2v){(float)k.x, (float)k.y}, ki = (f32x2v){(float)k.z, (float)k.w};
                const f32x2v pr = xr[j] * kr - xi[j] * ki, pi = xr[j] * ki + xi[j] * kr; xr[j] = pr; xi[j] = -pi; }
            __syncthreads();
            { const int cn = (n == 0) ? c : ((it0 + (int)gridDim.x * 2) >> 3);
              if (n == 0 || it0 + (int)gridDim.x * 2 < DH * 8) kf_dma(KF + (size_t)((1 - n) * DH + cn) * 32768, kfl, tid); }
            fft4096_pk(xr, xi, buf, tv, TW);
            const int col = (n + 1) * DH + c;
            __syncthreads();
            stage_sconv(PT, col, b0, sw[col] * (1.0f / 8192.0f), sw[1536 + col] * (1.0f / 8192.0f), sw[3072 + col] * (1.0f / 8192.0f), sb[col] * (1.0f / 8192.0f), gl, tv);
            __syncthreads();
#pragma unroll
            for (int j = 0; j < 16; ++j) { const int m = tv + 256 * j; const f32x2v wj = w32(j); const float wx = wt.x * wj.x - wt.y * wj.y, wy = wt.x * wj.y + wt.y * wj.x;
                const float er = xr[j].x, ei = -xi[j].x, orr = xr[j].y, oi = -xi[j].y;
                const float cr = er + (orr * wx + oi * wy), ci = ei + (oi * wx - orr * wy);
                zr[j] = gl[m] * cr; zi[j] = gl[SEQ + m] * ci; }
        }
        bf16_t* o0 = YT + ((size_t)b0 * DM + c) * SEQ;
        store_rows2(zr, zi, (bf16_t*)(gl + 2 * SEQ), o0, o0 + (size_t)DM * SEQ, tv);
    }
#ifndef REP_FNET
#define REP_FNET 1
#endif
    for (int rep = 0; rep < REP_FNET; ++rep)
    for (int it0 = blockIdx.x * 2; it0 < NB * DH / 2; it0 += gridDim.x * 2) {
        const int s = 2 * (it0 + hh), b = s >> 9, ch = s & 511;
        int tv = t; asm volatile("" : "+v"(tv));
        const bf16_t* ra = PT + ((size_t)b * NPT + 1536 + ch) * SEQ; const bf16_t* rb = PT + ((size_t)b * NPT + 2048 + ch) * SEQ;
        bf16_t* sta = (bf16_t*)gl; bf16_t* stb = sta + 2 * SEQ;
        __syncthreads();
        { u32x4v va[4], vb[4];
#pragma unroll
          for (int q = 0; q < 4; ++q) { va[q] = *(const u32x4v*)(ra + (q * 256 + tv) * 8); vb[q] = *(const u32x4v*)(rb + (q * 256 + tv) * 8); }
#pragma unroll
          for (int q = 0; q < 4; ++q) { *(u32x4v*)(sta + (q * 256 + tv) * 8) = va[q]; *(u32x4v*)(stb + (q * 256 + tv) * 8) = vb[q]; } }
        __syncthreads();
        f32x2v xr[16], xi[16];
#pragma unroll
        for (int j = 0; j < 16; ++j) { const int m = tv + 256 * j; xr[j] = (f32x2v){bf2f(sta[m]), bf2f(sta[SEQ + m])}; xi[j] = (f32x2v){-bf2f(stb[m]), -bf2f(stb[SEQ + m])}; }
        fft4096_pk(xr, xi, buf, tv, TW);
        float o0v[16], o1v[16];
#pragma unroll
        for (int j = 0; j < 16; ++j) { o0v[j] = xr[j].x; o1v[j] = xr[j].y; }
        __syncthreads();
        bf16_t* o = YT + ((size_t)b * DM + 512 + ch) * SEQ;
        store_rows2(o0v, o1v, (bf16_t*)gl, o, o + SEQ, tv);
    }
    __syncthreads();
}
__device__ __forceinline__ void ph_transpose(const Params& P, float* lds, const int wid_s) {
    const int tid = opaque_tid(); bf16_t* tile = (bf16_t*)lds;
    const bf16_t* YT = (const bf16_t*)(P.ws + WS_YT); bf16_t* Y = (bf16_t*)(P.ws + WS_Y);
    for (int it = blockIdx.x; it < NB * 4 * 64; it += gridDim.x) {
        const int b = it >> 8, cq = (it >> 6) & 3, lt = it & 63;
        { const int r = tid >> 3, q = tid & 7; u32x4v v[4];
#pragma unroll
          for (int u = 0; u < 4; ++u) v[u] = *(const u32x4v*)(YT + ((size_t)b * DM + cq * 256 + u * 64 + r) * SEQ + lt * 64 + q * 8);
#pragma unroll
          for (int u = 0; u < 4; ++u) *(u32x4v*)(tile + (u * 64 + r) * 72 + q * 8) = v[u]; }
        __syncthreads();
        { const int lr = tid >> 3, q = tid & 7;
#pragma unroll
          for (int u = 0; u < 4; ++u) { unsigned w[4];
#pragma unroll
            for (int i = 0; i < 4; ++i) w[i] = (unsigned)tile[(u * 64 + q * 8 + 2 * i) * 72 + lr] | ((unsigned)tile[(u * 64 + q * 8 + 2 * i + 1) * 72 + lr] << 16);
            *(u32x4v*)(Y + ((size_t)b * SEQ + lt * 64 + lr) * DM + cq * 256 + u * 64 + q * 8) = (u32x4v){w[0], w[1], w[2], w[3]}; } }
        __syncthreads();
    }
}
__device__ __forceinline__ void unpack8(const u32x4v w, float (&f)[8]) {
    f[0] = __uint_as_float(w.x << 16); f[1] = __uint_as_float(w.x & 0xffff0000u); f[2] = __uint_as_float(w.y << 16); f[3] = __uint_as_float(w.y & 0xffff0000u);
    f[4] = __uint_as_float(w.z << 16); f[5] = __uint_as_float(w.z & 0xffff0000u); f[6] = __uint_as_float(w.w << 16); f[7] = __uint_as_float(w.w & 0xffff0000u);
}
__device__ __forceinline__ void ph_geglu(const Params& P, int l, const int wid_s) {
    const bf16_t* U = (const bf16_t*)(P.ws + WS_U); bf16_t* G = (bf16_t*)(P.ws + WS_G);
    const float* dww = P.in[I_DWW] + (size_t)l * 3 * DUP; const float* dwb = P.in[I_DWB] + (size_t)l * DUP;
    const int tid = opaque_tid();
    if (tid < DFF / 8) {
        const int f0 = tid * 8;
        float wa[3][8], wb[3][8], ba[8], bb[8];
#pragma unroll
        for (int k = 0; k < 3; ++k) { const f32x4v a0 = *(const f32x4v*)(dww + k * DUP + f0), a1 = *(const f32x4v*)(dww + k * DUP + f0 + 4), b0 = *(const f32x4v*)(dww + k * DUP + DFF + f0), b1 = *(const f32x4v*)(dww + k * DUP + DFF + f0 + 4);
            wa[k][0] = a0.x; wa[k][1] = a0.y; wa[k][2] = a0.z; wa[k][3] = a0.w; wa[k][4] = a1.x; wa[k][5] = a1.y; wa[k][6] = a1.z; wa[k][7] = a1.w;
            wb[k][0] = b0.x; wb[k][1] = b0.y; wb[k][2] = b0.z; wb[k][3] = b0.w; wb[k][4] = b1.x; wb[k][5] = b1.y; wb[k][6] = b1.z; wb[k][7] = b1.w; }
        { const f32x4v a0 = *(const f32x4v*)(dwb + f0), a1 = *(const f32x4v*)(dwb + f0 + 4), b0 = *(const f32x4v*)(dwb + DFF + f0), b1 = *(const f32x4v*)(dwb + DFF + f0 + 4);
          ba[0] = a0.x; ba[1] = a0.y; ba[2] = a0.z; ba[3] = a0.w; ba[4] = a1.x; ba[5] = a1.y; ba[6] = a1.z; ba[7] = a1.w; bb[0] = b0.x; bb[1] = b0.y; bb[2] = b0.z; bb[3] = b0.w; bb[4] = b1.x; bb[5] = b1.y; bb[6] = b1.z; bb[7] = b1.w; }
        const u32x4v zero = (u32x4v){0u, 0u, 0u, 0u};
        for (int blk = blockIdx.x; blk < HTOK / 128; blk += gridDim.x) {
            const int rbeg = blk * 128; const bool halo_lo = (rbeg & (SEQ - 1)) != 0, halo_hi = ((rbeg + 128) & (SEQ - 1)) != 0;
            const bf16_t* ua = U + (size_t)rbeg * DUP + f0; const bf16_t* ub = ua + DFF; bf16_t* go = G + (size_t)rbeg * DFF + f0;
            u32x4v ra[4], rb[4];
#pragma unroll
            for (int j = 0; j < 4; ++j) { ra[j] = __builtin_nontemporal_load((const u32x4v*)(ua + (size_t)j * DUP)); rb[j] = __builtin_nontemporal_load((const u32x4v*)(ub + (size_t)j * DUP)); }
            float pa[8], pb[8], ca[8], cb[8], na[8], nb[8];
            { const u32x4v ha = halo_lo ? *(const u32x4v*)(ua - DUP) : zero, hb = halo_lo ? *(const u32x4v*)(ub - DUP) : zero; unpack8(ha, pa); unpack8(hb, pb); }
            unpack8(ra[0], ca); unpack8(rb[0], cb);
            for (int o = 0; o < 32; ++o) {
#pragma unroll
                for (int j = 0; j < 4; ++j) {
                    const int s = o * 4 + j;
                    { const bool last = (o == 31) && (j == 3); const bool ok = !last || halo_hi; unpack8(ok ? ra[(j + 1) & 3] : zero, na); unpack8(ok ? rb[(j + 1) & 3] : zero, nb); }
                    if (o < 31 || j == 0) { const int rr = (s + 4 < HTOK - rbeg) ? s + 4 : s;
                        ra[j] = __builtin_nontemporal_load((const u32x4v*)(ua + (size_t)rr * DUP)); rb[j] = __builtin_nontemporal_load((const u32x4v*)(ub + (size_t)rr * DUP)); }
                    float ov[8];
#pragma unroll
                    for (int e = 0; e < 8; e += 2) {
                        const f32x2v av = (f32x2v){ba[e] + pa[e] * wa[0][e] + ca[e] * wa[1][e] + na[e] * wa[2][e], ba[e + 1] + pa[e + 1] * wa[0][e + 1] + ca[e + 1] * wa[1][e + 1] + na[e + 1] * wa[2][e + 1]};
                        const f32x2v gv = pg8::gelu_pk(av);
                        ov[e] = gv.x * (bb[e] + pb[e] * wb[0][e] + cb[e] * wb[1][e] + nb[e] * wb[2][e]);
                        ov[e + 1] = gv.y * (bb[e + 1] + pb[e + 1] * wb[0][e + 1] + cb[e + 1] * wb[1][e + 1] + nb[e + 1] * wb[2][e + 1]); }
                    *(u32x4v*)(go + (size_t)s * DFF) = (u32x4v){pack2(ov[0], ov[1]), pack2(ov[2], ov[3]), pack2(ov[4], ov[5]), pack2(ov[6], ov[7])};
#pragma unroll
                    for (int e = 0; e < 8; ++e) { pa[e] = ca[e]; pb[e] = cb[e]; ca[e] = na[e]; cb[e] = nb[e]; }
                }
            }
        }
    }
}
constexpr int N_PHASES = 3 + 12 * DEPTH;
#ifndef NT_MODE
#define NT_MODE 1
#endif
#define NT_MASK(ld) ((NT_MODE == 1) ? ((ld) == DUP) : (NT_MODE == 2 ? 1 : 0))
#ifndef REP_PRO
#define REP_PRO 1
#endif
#ifndef REP_MIX
#define REP_MIX 1
#endif
#ifndef REP_GEGLU
#define REP_GEGLU 1
#endif
#ifndef REP_TR
#define REP_TR 1
#endif
#ifndef REP_GEMM
#define REP_GEMM 1
#endif
#ifndef MK_MULTI_LAUNCH
#define MK_MULTI_LAUNCH 0
#endif
__global__ __launch_bounds__(512, 2) void mk_fwd(Params P) {
    extern __shared__ __attribute__((aligned(16))) unsigned char smem[];
    float* lds = (float*)smem;
    cg::grid_group grid = cg::this_grid();
    const int wid_s = __builtin_amdgcn_readfirstlane((int)threadIdx.x >> 6);
    unsigned xst0 = 0u, xst1 = 0u;
    const XcdBarrier xb = xcd_barrier_post((unsigned*)(P.ws + WS_BAR), nullptr);
    bf16_t* H = (bf16_t*)(P.ws + WS_H);
    bf16_t* XB = (bf16_t*)(P.ws + WS_XB);
    for (int ph = P.ph_lo; ph < P.ph_hi; ++ph) {
        if (ph > P.ph_lo) { if (ph == 1) grid.sync(); else {
#ifdef REP_BAR
 xcd_barrier(xb, xst0, xst1, wid_s == 0 && lane_now() == 0); xst0 = __builtin_amdgcn_readfirstlane(xst0); xst1 = __builtin_amdgcn_readfirstlane(xst1);
#endif
 xcd_barrier(xb, xst0, xst1, wid_s == 0 && lane_now() == 0); xst0 = __builtin_amdgcn_readfirstlane(xst0); xst1 = __builtin_amdgcn_readfirstlane(xst1); } }
        bool is_gemm = false; const bf16_t* gA = nullptr; const bf16_t* gB = nullptr; int gM = 0, gN = 0, gK = 0, gld = 0, gsplit = 0; size_t gstride = 0; bf16_t* gO = nullptr;
        if (ph == 0) {
#ifndef NO_PRO
 for (int rep = 0; rep < REP_PRO; ++rep) { ph_tconv(P, lds, wid_s); ph_fold(P, lds, wid_s); ph_mod(P, lds, wid_s); ph_tw(P, wid_s); ph_fh2(P, lds, wid_s); }
#endif
 }
        else if (ph == 1) { ph_h3t(P, 0, lds, wid_s); ph_resnorm<0, 0>(P.in[I_X], nullptr, nullptr, nullptr, nullptr, nullptr, P.in[I_GMPRE], modp(P, 0, 1), modp(P, 0, 0), H, wid_s); }
        else if (ph == 2) {
#ifndef NO_KF
 ph_kf(P, 0, lds, wid_s);
#endif
 }
        else {
            const int l = (ph - 3) / 12, k = (ph - 3) % 12;
            if (k == 0) { is_gemm = true; gA = wbf(P, l, WL_WIN); gB = H; gM = NPT; gN = NTOK; gK = DM; gO = (bf16_t*)(P.ws + WS_PT); gld = SEQ; gsplit = SEQ; gstride = (size_t)NPT * SEQ; }
            else if (k == 1) {
#ifndef NO_MIX
 for (int rep = 0; rep < REP_MIX; ++rep) ph_mix(P, l, lds, wid_s);
#endif
 }
            else if (k == 2) { for (int rep = 0; rep < REP_TR; ++rep) { ph_transpose(P, lds, wid_s); if (l + 1 < DEPTH) ph_h3t(P, l + 1, lds, wid_s); } }
            else if (k == 3) { is_gemm = true; gA = (const bf16_t*)(P.ws + WS_Y); gB = wbf(P, l, WL_WOUT); gM = NTOK; gN = DM; gK = DM; gO = (bf16_t*)(P.ws + WS_YO); gld = DM; }
            else if (k == 4) {
                if (l == 0) ph_resnorm<0, 1>(P.in[I_X], XB, (const bf16_t*)(P.ws + WS_YO), (const bf16_t*)(P.ws + WS_YO) + (size_t)HTOK * DM, P.in[I_GMPOST] + l * DM, modp(P, l, 2), P.in[I_GFPRE] + l * DM, modp(P, l, 4), modp(P, l, 3), H, wid_s);
                else ph_resnorm<1, 1>(XB, XB, (const bf16_t*)(P.ws + WS_YO), (const bf16_t*)(P.ws + WS_YO) + (size_t)HTOK * DM, P.in[I_GMPOST] + l * DM, modp(P, l, 2), P.in[I_GFPRE] + l * DM, modp(P, l, 4), modp(P, l, 3), H, wid_s);

#ifndef NO_KF
 if (l + 1 < DEPTH) ph_kf(P, l + 1, lds, wid_s);
#endif
 }
            else if (k == 5 || k == 8) { const int hf = (k == 8); is_gemm = true; gA = H + (size_t)hf * HTOK * DM; gB = wbf(P, l, WL_WUP); gM = HTOK; gN = DUP; gK = DM; gO = (bf16_t*)(P.ws + WS_U); gld = DUP; }
            else if (k == 6 || k == 9) {
#ifndef NO_GEGLU
 for (int rep = 0; rep < REP_GEGLU; ++rep) ph_geglu(P, l, wid_s);
#endif
 }
            else if (k == 7 || k == 10) { const int hf = (k == 10); is_gemm = true; gA = (const bf16_t*)(P.ws + WS_G); gB = wbf(P, l, WL_WDN); gM = HTOK; gN = DM; gK = DFF; gO = (bf16_t*)(P.ws + (hf ? WS_YD1 : WS_YD0)); gld = DM; }
            else { const bool more = (l + 1 < DEPTH);
                if (more) ph_resnorm<1, 1>(XB, XB, (const bf16_t*)(P.ws + WS_YD0), (const bf16_t*)(P.ws + WS_YD1), P.in[I_GFPOST] + l * DM, modp(P, l, 5), P.in[I_GMPRE] + (l + 1) * DM, modp(P, l + 1, 1), modp(P, l + 1, 0), H, wid_s);
                else ph_resnorm<1, 0>(XB, P.out, (const bf16_t*)(P.ws + WS_YD0), (const bf16_t*)(P.ws + WS_YD1), P.in[I_GFPOST] + l * DM, modp(P, l, 5), nullptr, nullptr, nullptr, nullptr, wid_s); }
        }
        #ifndef NO_GEMM
        if (is_gemm) for (int rep = 0; rep < REP_GEMM; ++rep) {
            __syncthreads();
            pg8::Gemm g{gA, gB, gM, gN, gK}; pg8::StaticOrder S; S.init(gM, gN, (int)gridDim.x, (int)blockIdx.x);
            pg8::EpiBf16<0> E{gO, gld, nullptr, gsplit, gstride, NT_MASK(gld)};
            pg8::gemm_phase<pg8::EpiBf16<0>, pg8::StaticOrder, false>((PG8_LAS unsigned char*)smem, g, S, E, nullptr, wid_s);
            __syncthreads();
        }
#endif
    }
}

extern "C" void kernel_launch(void* const* d_in, const int* in_sizes, int n_in, void* d_out, int out_size, void* d_ws, size_t ws_size, hipStream_t stream) {
    static int grid = 0;
    if (grid == 0) {
        if (n_in != 24 || out_size != NTOK * DM || ws_size < WS_NEED) { fprintf(stderr, "kernel_launch: unexpected shapes (n_in %d out %d ws %zu need %zu)\n", n_in, out_size, ws_size, (size_t)WS_NEED); grid = -1; return; }
        int dev = 0, cus = 0, per_cu = 0;
        hipGetDevice(&dev); hipDeviceGetAttribute(&cus, hipDeviceAttributeMultiprocessorCount, dev);
        if (hipFuncSetAttribute((const void*)mk_fwd, hipFuncAttributeMaxDynamicSharedMemorySize, LDS_BYTES) != hipSuccess) { fprintf(stderr, "kernel_launch: hipFuncSetAttribute failed\n"); grid = -1; return; }
        hipOccupancyMaxActiveBlocksPerMultiprocessor(&per_cu, (const void*)mk_fwd, NTHR, LDS_BYTES);
        (void)hipGetLastError();
        if (per_cu < 1) fprintf(stderr, "kernel_launch: occupancy query says %d blocks per CU\n", per_cu);
        grid = cus > 0 ? cus : 256;
    }
    if (grid < 0) return;
    Params p{};
    for (int i = 0; i < 24; ++i) p.in[i] = (const float*)d_in[i];
    p.out = (float*)d_out; p.ws = (unsigned char*)d_ws;
#if MK_MULTI_LAUNCH
    for (int ph = 0; ph < N_PHASES; ++ph) { p.ph_lo = ph; p.ph_hi = ph + 1; hipLaunchKernelGGL(mk_fwd, dim3(grid), dim3(NTHR), LDS_BYTES, stream, p); }
#else
    p.ph_lo = 0; p.ph_hi = N_PHASES;
    if (hipMemsetAsync((unsigned char*)d_ws + WS_BAR, 0, XCD_BAR_WORDS * 4, stream) != hipSuccess) { fprintf(stderr, "kernel_launch: memset of the barrier words failed\n"); return; }
    void* args[] = {&p};
    hipError_t e = hipLaunchCooperativeKernel((const void*)mk_fwd, dim3(grid), dim3(NTHR), args, LDS_BYTES, stream);
    if (e != hipSuccess) fprintf(stderr, "cooperative launch failed: %s (grid %d)\n", hipGetErrorString(e), grid);
#endif
}
```

```cpp
#include <hip/hip_runtime.h>
#include <hip/hip_cooperative_groups.h>
#include <cstdio>
namespace cg = cooperative_groups;
#define MK_MULTI_LAUNCH 0
namespace pg8 {
#define PG8_LAS __attribute__((address_space(3)))
typedef unsigned short bf16_t;
typedef short bf16x8 __attribute__((ext_vector_type(8)));
typedef float f32x4 __attribute__((ext_vector_type(4)));
typedef unsigned u32x4 __attribute__((ext_vector_type(4)));
constexpr int BM = 256, BK = 64, HALF = 128, HTB = HALF * BK * 2  , STAGE_BYTES = 8 * HTB, NXCD = 8, WGM = 8;

__host__ __device__ __forceinline__ int lds_byte(int r, int c) { const int st = (r >> 4) * 2 + (c >> 5), rr = r & 15, cc = c & 31, ob = rr * 64 + cc * 2; return st * 1024 + (ob ^ (((ob >> 9) & 1) << 5)); }
__host__ __device__ __forceinline__ void stage_rc(int b, int& R, int& C) { const int st = b / 1024, sb = b % 1024, swz = sb ^ (((sb >> 9) & 1) << 5); R = (st >> 1) * 16 + swz / 64; C = (st & 1) * 32 + (swz % 64) / 2; }
__host__ __device__ __forceinline__ int perm32(int rho) { const int n = rho >> 4, i = rho & 15; return 8 * (i >> 2) + 4 * n + (i & 3); }

struct Unit { int pm, pn; };
struct Gemm { const bf16_t* A; const bf16_t* Bt; int M, N, K; };

struct StaticOrder {
    int nM, nN, nwg, G, c;
    __host__ __device__ void init(int M, int N, int G_, int c_) { nM = M / BM; nN = N / BM; nwg = nM * nN; G = G_; c = c_; }
    __host__ __device__ bool next(int i, Unit& u) const {
        const long L = (long)i * G + c; if (L >= nwg) return false;
        int wgid = (int)L; { const int q = nwg / NXCD, r = nwg % NXCD, xcd = wgid % NXCD, off = wgid / NXCD; wgid = (xcd < r ? xcd * (q + 1) : r * (q + 1) + (xcd - r) * q) + off; }
        const int nig = WGM * nN, gid = wgid / nig, fm = gid * WGM, gsz = (nM - fm) < WGM ? (nM - fm) : WGM;
        u.pm = fm + ((wgid % nig) % gsz); u.pn = (wgid % nig) / gsz; return true;
    }
    __device__ __forceinline__ void a_ready(const Unit&) const {}
    __device__ __forceinline__ void done(const Unit&) const {}
};
__device__ __forceinline__ unsigned cvt_pk_bf16(float lo, float hi) { unsigned r; asm volatile("v_cvt_pk_bf16_f32 %0, %1, %2" : "=v"(r) : "v"(lo), "v"(hi)); return r; }
typedef float f32x2 __attribute__((ext_vector_type(2)));
__device__ __forceinline__ f32x2 gelu_pk(f32x2 v) {
    const f32x2 av = __builtin_elementwise_abs(v), d = av * 0.2316418882f + 1.0f;
    f32x2 t; t.x = __builtin_amdgcn_rcpf(d.x); t.y = __builtin_amdgcn_rcpf(d.y);
    f32x2 q = t * 0.5307027145f + (-0.7265760135f); q = q * t + 0.7107068705f; q = q * t + (-0.142248368f); q = q * t + 0.127414796f; q = q * t;
    const f32x2 s = (v * v) * (-0.72134752044f);
    f32x2 e; e.x = __builtin_amdgcn_exp2f(s.x); e.y = __builtin_amdgcn_exp2f(s.y);
    const f32x2 m = v * (q * e), r = v - m;
    f32x2 o; o.x = v.x < 0.f ? m.x : r.x; o.y = v.y < 0.f ? m.y : r.y; return o;
}

struct EpiF32 {
    static constexpr bool PERM = false, AFTER_DRAIN = false;
    float* C; int ldc; const float* bias;
    __device__ __forceinline__ void operator()(const f32x4 (&acc)[2][2][4][2], const Unit& u, int wr, int wc, int fr, int fq) const {
        const int row0 = u.pm * BM + wr * 64 + fr, col0 = u.pn * BM + wc * 32 + 4 * fq;
        f32x4 bv[2][2];
#pragma unroll
        for (int bj = 0; bj < 2; ++bj)
#pragma unroll
            for (int n = 0; n < 2; ++n) bv[bj][n] = bias ? *(const f32x4*)(bias + col0 + bj * HALF + n * 16) : (f32x4){0.f, 0.f, 0.f, 0.f};
#pragma unroll
        for (int ai = 0; ai < 2; ++ai)
#pragma unroll
            for (int m = 0; m < 4; ++m) { float* rowp = C + (size_t)(row0 + ai * HALF + m * 16) * ldc + col0;
#pragma unroll
                for (int bj = 0; bj < 2; ++bj)
#pragma unroll
                    for (int n = 0; n < 2; ++n) *(f32x4*)(rowp + bj * HALF + n * 16) = acc[ai][bj][m][n] + bv[bj][n]; }
    }
};
template <int ACT  > struct EpiBf16 {
    static constexpr bool PERM = true, AFTER_DRAIN = false;
    bf16_t* O; int ldc; const float* bias; int split_cols; size_t split_stride; int nt;
    __device__ __forceinline__ void operator()(const f32x4 (&acc)[2][2][4][2], const Unit& u, int wr, int wc, int fr, int fq) const {
        const int row0 = u.pm * BM + wr * 64 + fr; int colt = u.pn * BM; bf16_t* base = O;
        if (split_cols) { const int t = colt / split_cols; base += (size_t)t * split_stride; colt -= t * split_cols; }
        const int col0 = colt + wc * 32 + 8 * fq, bcol0 = u.pn * BM + wc * 32 + 8 * fq;
        f32x4 bv[2][2];
#pragma unroll
        for (int bj = 0; bj < 2; ++bj)
#pragma unroll
            for (int n = 0; n < 2; ++n) bv[bj][n] = bias ? *(const f32x4*)(bias + bcol0 + bj * HALF + 4 * n) : (f32x4){0.f, 0.f, 0.f, 0.f};
#pragma unroll
        for (int ai = 0; ai < 2; ++ai)
#pragma unroll
            for (int m = 0; m < 4; ++m) { bf16_t* rowp = base + (size_t)(row0 + ai * HALF + m * 16) * ldc + col0;
#pragma unroll
                for (int bj = 0; bj < 2; ++bj) { f32x4 v0 = acc[ai][bj][m][0] + bv[bj][0], v1 = acc[ai][bj][m][1] + bv[bj][1];
                    if (ACT == 1) { f32x2 a = gelu_pk((f32x2){v0[0], v0[1]}), b = gelu_pk((f32x2){v0[2], v0[3]}), c = gelu_pk((f32x2){v1[0], v1[1]}), d = gelu_pk((f32x2){v1[2], v1[3]});
                        v0 = (f32x4){a.x, a.y, b.x, b.y}; v1 = (f32x4){c.x, c.y, d.x, d.y}; }
                    if (ACT == 2) {
#pragma unroll
                        for (int j = 0; j < 4; ++j) { v0[j] = 0.5f * v0[j] * (1.0f + erff(v0[j] * 0.70710678f)); v1[j] = 0.5f * v1[j] * (1.0f + erff(v1[j] * 0.70710678f)); } }
                    u32x4 w; w.x = cvt_pk_bf16(v0[0], v0[1]); w.y = cvt_pk_bf16(v0[2], v0[3]); w.z = cvt_pk_bf16(v1[0], v1[1]); w.w = cvt_pk_bf16(v1[2], v1[3]);
                    if (nt) __builtin_nontemporal_store(w, (u32x4*)(rowp + bj * HALF)); else *(u32x4*)(rowp + bj * HALF) = w; } }
    }
};
template <class Epi, class Sched, bool STAMP = false>
__device__ __forceinline__ void gemm_phase(PG8_LAS unsigned char* lds, const Gemm g, const Sched& S, const Epi& E, unsigned long long* stamps, const int wid_s) {
    int tid_; asm volatile("v_mbcnt_lo_u32_b32 %0, -1, 0\n\tv_mbcnt_hi_u32_b32 %0, -1, %0" : "=v"(tid_)); tid_ += wid_s * 64; const int tid = tid_, wid = __builtin_amdgcn_readfirstlane(tid >> 6), lane = tid & 63, wr = wid >> 2, wc = wid & 3, fr = lane & 15, fq = lane >> 4;
    const int K = g.K, nt = K / BK;
    int ts_lo = 0, ts_hi = 0, nts = 0; const unsigned long long rt_entry = STAMP ? (unsigned long long)wall_clock64() : 0ull;
#define PG8_STAMP() do { if (STAMP && wid == 0 && nts < 64) { const unsigned long long _c = (unsigned long long)clock64(); \
        ts_lo = (lane == nts) ? (int)(unsigned)_c : ts_lo; ts_hi = (lane == nts) ? (int)(unsigned)(_c >> 32) : ts_hi; ++nts; } } while (0)
    PG8_STAMP();
    unsigned voffA[2], voffB[2];
#pragma unroll
    for (int i = 0; i < 2; ++i) { int R, C; stage_rc(tid * 16 + i * 8192, R, C); const int Rb = Epi::PERM ? ((R & ~31) + perm32(R & 31)) : R;
        voffA[i] = (unsigned)(R * K + C) * 2u; voffB[i] = (unsigned)(Rb * K + C) * 2u; }
    const size_t kstep = (size_t)(BK * 2);
    const size_t hstep = (size_t)HALF * K * 2;
    const size_t tstep = 2 * hstep;
    const unsigned ldsw = (unsigned)wid * 1024u;
    const int aoff = lds_byte(wr * 64 + fr, fq * 8), boff = lds_byte(wc * 32 + fr, fq * 8);
#define PG8_SA(b, h) (((b) * 2 + (h)) * HTB)
#define PG8_SB(b, h) ((4 + (b) * 2 + (h)) * HTB)
#define PG8_STAGE(bufoff, gbase, voff) do { _Pragma("unroll") for (int _i = 0; _i < 2; ++_i) \
        __builtin_amdgcn_global_load_lds((const unsigned*)((const char*)(gbase) + (voff)[_i]), (PG8_LAS unsigned*)(lds + (bufoff) + ldsw + _i * 8192), 16, 0, 0); } while (0)
#define PG8_LDA(dst, b, h) do { _Pragma("unroll") for (int m = 0; m < 4; ++m) _Pragma("unroll") for (int k = 0; k < 2; ++k) dst[m][k] = *(const PG8_LAS bf16x8*)(lds + PG8_SA(b, h) + aoff + m * 2048 + k * 1024); } while (0)
#define PG8_LDB(dst, b, h) do { _Pragma("unroll") for (int n = 0; n < 2; ++n) _Pragma("unroll") for (int k = 0; k < 2; ++k) dst[n][k] = *(const PG8_LAS bf16x8*)(lds + PG8_SB(b, h) + boff + n * 2048 + k * 1024); } while (0)
#define PG8_MMA(ai, bj, At, Bt) do { __builtin_amdgcn_s_setprio(1); _Pragma("unroll") for (int m = 0; m < 4; ++m) _Pragma("unroll") for (int n = 0; n < 2; ++n) _Pragma("unroll") for (int k = 0; k < 2; ++k) \
        acc[ai][bj][m][n] = __builtin_amdgcn_mfma_f32_16x16x32_bf16(Bt[n][k], At[m][k], acc[ai][bj][m][n], 0, 0, 0); __builtin_amdgcn_s_setprio(0); } while (0)
#define PG8_WAIT_V(n) asm volatile("s_waitcnt vmcnt(" #n ")" ::: "memory")
#define PG8_WAIT_L(n) asm volatile("s_waitcnt lgkmcnt(" #n ")" ::: "memory")
#define PG8_BAR __builtin_amdgcn_s_barrier()
#define PG8_SCHED __builtin_amdgcn_sched_barrier(0)
    Unit cur, nxt; int ui = 0;
    if (!S.next(0, cur)) return;
    f32x4 acc[2][2][4][2];
#pragma unroll
    for (int a = 0; a < 2; ++a)
#pragma unroll
        for (int b = 0; b < 2; ++b)
#pragma unroll
            for (int m = 0; m < 4; ++m)
#pragma unroll
                for (int n = 0; n < 2; ++n) acc[a][b][m][n] = (f32x4){0.f, 0.f, 0.f, 0.f};
    bf16x8 At[4][2], B0[2][2], B1[2][2];
    const char* cA = (const char*)g.A + (size_t)cur.pm * tstep; const char* cB = (const char*)g.Bt + (size_t)cur.pn * tstep;
    S.a_ready(cur);
    PG8_STAGE(PG8_SB(0, 0), cB, voffB); PG8_STAGE(PG8_SA(0, 0), cA, voffA); PG8_STAGE(PG8_SB(0, 1), cB + hstep, voffB); PG8_STAGE(PG8_SA(0, 1), cA + hstep, voffA);
    if (wr == 1) PG8_BAR;
    PG8_WAIT_V(4); PG8_BAR;
    PG8_STAGE(PG8_SB(1, 0), cB + kstep, voffB); PG8_STAGE(PG8_SA(1, 0), cA + kstep, voffA); PG8_STAGE(PG8_SB(1, 1), cB + hstep + kstep, voffB);
    PG8_WAIT_V(6); PG8_BAR;
    PG8_STAMP();
    for (;;) {
        const bool has_next = S.next(ui + 1, nxt);
        const char* nA = has_next ? (const char*)g.A + (size_t)nxt.pm * tstep : cA; const char* nB = has_next ? (const char*)g.Bt + (size_t)nxt.pn * tstep : cB;
        for (int t = 0; t < nt; t += 2) {
            const bool last = (t == nt - 2);
            const char* a1 = cA + (size_t)(t + 1) * kstep;
            const char* a2 = last ? nA : cA + (size_t)(t + 2) * kstep; const char* b2 = last ? nB : cB + (size_t)(t + 2) * kstep;
            const char* a3 = a2 + kstep; const char* b3 = b2 + kstep;
            if (last && has_next) S.a_ready(nxt);
            PG8_LDB(B0, 0, 0); PG8_SCHED; PG8_LDA(At, 0, 0); PG8_STAGE(PG8_SA(1, 1), a1 + hstep, voffA);
            PG8_WAIT_L(8); PG8_BAR; PG8_WAIT_L(0); PG8_MMA(0, 0, At, B0); PG8_BAR; PG8_SCHED;
            PG8_LDB(B1, 0, 1); PG8_STAGE(PG8_SB(0, 0), b2, voffB);
            PG8_BAR; PG8_WAIT_L(0); PG8_MMA(0, 1, At, B1); PG8_BAR;
            PG8_LDA(At, 0, 1); PG8_STAGE(PG8_SA(0, 0), a2, voffA);
            PG8_BAR; PG8_WAIT_L(0); PG8_MMA(1, 0, At, B0); PG8_BAR; PG8_SCHED;
            PG8_STAGE(PG8_SB(0, 1), b2 + hstep, voffB);
            PG8_WAIT_V(6); PG8_BAR; PG8_MMA(1, 1, At, B1); PG8_BAR;
            PG8_LDB(B0, 1, 0); PG8_SCHED; PG8_LDA(At, 1, 0); PG8_STAGE(PG8_SA(0, 1), a2 + hstep, voffA);
            PG8_WAIT_L(8); PG8_BAR; PG8_WAIT_L(0); PG8_MMA(0, 0, At, B0); PG8_BAR; PG8_SCHED;
            PG8_LDB(B1, 1, 1); PG8_STAGE(PG8_SB(1, 0), b3, voffB);
            PG8_BAR; PG8_WAIT_L(0); PG8_MMA(0, 1, At, B1); PG8_BAR;
            PG8_LDA(At, 1, 1); PG8_STAGE(PG8_SA(1, 0), a3, voffA);
            PG8_BAR; PG8_WAIT_L(0); PG8_MMA(1, 0, At, B0); PG8_BAR; PG8_SCHED;
            PG8_STAGE(PG8_SB(1, 1), b3 + hstep, voffB);
            PG8_WAIT_V(6); PG8_BAR; PG8_MMA(1, 1, At, B1); PG8_BAR;
        }
        PG8_STAMP();
        if constexpr (!Epi::AFTER_DRAIN) { E(acc, cur, wr, wc, fr, fq); S.done(cur); }
        PG8_STAMP();
        if (!has_next) break;
#pragma unroll
        for (int a = 0; a < 2; ++a)
#pragma unroll
            for (int b = 0; b < 2; ++b)
#pragma unroll
                for (int m = 0; m < 4; ++m)
#pragma unroll
                    for (int n = 0; n < 2; ++n) acc[a][b][m][n] = (f32x4){0.f, 0.f, 0.f, 0.f};
        cur = nxt; cA = nA; cB = nB; ++ui;
    }
    PG8_WAIT_V(0);
    if (wr == 0) PG8_BAR;
    PG8_BAR;
    if constexpr (Epi::AFTER_DRAIN) { E.fused(acc, cur, wr, wc, fr, fq, lds, wid, lane); S.done(cur); }
    PG8_STAMP();
    if (STAMP && wid == 0) { stamps[lane] = lane < nts ? (((unsigned long long)(unsigned)ts_hi << 32) | (unsigned)ts_lo) : 0ull;
        if (lane == 62) stamps[62] = rt_entry; if (lane == 63) stamps[63] = (unsigned long long)wall_clock64(); }
#undef PG8_STAMP
#undef PG8_SA
#undef PG8_SB
#undef PG8_STAGE
#undef PG8_LDA
#undef PG8_LDB
#undef PG8_MMA
#undef PG8_WAIT_V
#undef PG8_WAIT_L
#undef PG8_BAR
#undef PG8_SCHED
}
}
#define XB_TMO      128
#define XB_XCNT(j)  (256  + 64 * (j))
#define XB_XSUB(j)  (1280 + 64 * (j))
#define XB_XGEN(j)  (2304 + 64 * (j))
#define XB_TOP      3328
#define XB_TOPGEN   3392
#define XCD_BAR_WORDS 3456
#define XB_SPIN_CAP (1u << 18)
#define LAS __attribute__((address_space(3)))

__device__ __forceinline__ unsigned xb_ld(unsigned* p)              { return __hip_atomic_load(p, __ATOMIC_RELAXED, __HIP_MEMORY_SCOPE_AGENT); }
__device__ __forceinline__ unsigned xb_add(unsigned* p, unsigned v) { return __hip_atomic_fetch_add(p, v, __ATOMIC_RELAXED, __HIP_MEMORY_SCOPE_AGENT); }
__device__ __forceinline__ unsigned xb_xcc_id() { return (unsigned)__builtin_amdgcn_s_getreg((3 << 11) | 20) & 0xFu; }
#define XB_SPIN(cond, bar) do { unsigned _sp = 0; while (cond) { __builtin_amdgcn_s_sleep(1); \
    if ((++_sp & 255u) == 0u) { if (xb_ld(&(bar)[XB_TMO])) break; if (_sp > XB_SPIN_CAP) { atomicAdd(&(bar)[XB_TMO], 1u); break; } } } } while (0)

struct XcdBarrier {
    unsigned* bar; unsigned x;
    volatile LAS unsigned* st;
};

__device__ __forceinline__ XcdBarrier xcd_barrier_post(unsigned* bar, volatile LAS unsigned* st) {
    XcdBarrier b; b.bar = bar; b.x = xb_xcc_id(); b.st = st;
    if (threadIdx.x == 0) (void)xb_add(&bar[XB_XCNT(b.x)], 1u);
    return b;
}
__device__ __forceinline__ void xcd_barrier_complete(unsigned* bar, unsigned x, unsigned& nloc, unsigned& nx) {
    const unsigned G = gridDim.x * gridDim.y * gridDim.z;
    unsigned sum, cnt, mine, sp = 0u;
    for (;;) {
        sum = 0u; cnt = 0u; mine = 0u;
#pragma unroll
        for (unsigned j = 0; j < 16; ++j) { const unsigned c = xb_ld(&bar[XB_XCNT(j)]); sum += c; cnt += (c > 0u) ? 1u : 0u; mine = (j == x) ? c : mine; }
        if (sum == G) break;
        __builtin_amdgcn_s_sleep(1);
        if ((++sp & 255u) == 0u) { if (xb_ld(&bar[XB_TMO])) break; if (sp > XB_SPIN_CAP) { atomicAdd(&bar[XB_TMO], 1u); break; } }
    }
    nloc = mine > 0u ? mine : 1u; nx = cnt > 0u ? cnt : 1u;
}

__device__ __forceinline__ void xcd_barrier(const XcdBarrier& b, unsigned& st0, unsigned& st1, const bool t0  ) {
    asm volatile("s_waitcnt vmcnt(0)" ::: "memory");
    __syncthreads();
    if (t0) {
        unsigned* bar = b.bar;
        __builtin_amdgcn_s_waitcnt(0);
        unsigned nloc = st0, nx = st1;
        if (nloc == 0u) { xcd_barrier_complete(bar, b.x, nloc, nx); st0 = nloc; st1 = nx; }
        const unsigned old = xb_add(&bar[XB_XSUB(b.x)], 1u);
        const unsigned gen = old / nloc;
        if (old + 1u == (gen + 1u) * nloc) {
            __builtin_amdgcn_fence(__ATOMIC_RELEASE, "agent");
            asm volatile("s_waitcnt vmcnt(0)" ::: "memory");
            const unsigned og = xb_add(&bar[XB_TOP], 1u);
            const unsigned tg = og / nx;
            if (og + 1u == (tg + 1u) * nx) xb_add(&bar[XB_TOPGEN], 1u);
            else XB_SPIN(xb_ld(&bar[XB_TOPGEN]) == tg, bar);
            __builtin_amdgcn_fence(__ATOMIC_ACQUIRE, "agent");
            xb_add(&bar[XB_XGEN(b.x)], 1u);
            asm volatile("s_waitcnt vmcnt(0)" ::: "memory");
        } else {
            XB_SPIN(xb_ld(&bar[XB_XGEN(b.x)]) == gen, bar);
            __builtin_amdgcn_fence(__ATOMIC_ACQUIRE, "agent");
            asm volatile("s_waitcnt vmcnt(0)" ::: "memory");
        }
    }
    __syncthreads();
}

using pg8::bf16_t;
typedef float f32x4v __attribute__((ext_vector_type(4)));
typedef float f32x2v __attribute__((ext_vector_type(2)));
typedef unsigned u32x4v __attribute__((ext_vector_type(4)));
typedef unsigned u32x2v __attribute__((ext_vector_type(2)));

constexpr int DM = 1024, NB = 16, SEQ = 4096, DEPTH = 4, NTOK = NB * SEQ;
constexpr int DH = 512, NPT = 2560, DFF = 2816, DUP = 5632, HTOK = NTOK / 2;
constexpr int NTHR = 512;

constexpr size_t WL_WIN = 0, WL_WOUT = WL_WIN + (size_t)NPT * DM, WL_WUP = WL_WOUT + (size_t)DM * DM, WL_WDN = WL_WUP + (size_t)DUP * DM, WL_END = WL_WDN + (size_t)DM * DFF;
constexpr size_t WS_WBF = 0;
constexpr size_t WS_KF = WS_WBF + WL_END * 2 * DEPTH;
constexpr size_t WS_H3T = WS_KF + (size_t)2 * DH * SEQ * 8;
constexpr size_t WS_FH2 = WS_H3T + (size_t)2048 * SEQ * 4;
constexpr size_t WS_MOD = WS_FH2 + (size_t)DEPTH * SEQ * 64 * 4;
constexpr size_t WS_TW = WS_MOD + (size_t)DEPTH * NB * 6144 * 4;
constexpr size_t WS_H = WS_TW + 8192 * 8;
constexpr size_t WS_BIG = WS_H + (size_t)NTOK * DM * 2;
constexpr size_t WS_PT = WS_BIG, WS_YT = WS_PT + (size_t)NB * NPT * SEQ * 2, WS_Y = WS_YT + (size_t)NTOK * DM * 2, WS_MIX_END = WS_Y + (size_t)NTOK * DM * 2;
constexpr size_t WS_YO = WS_PT;
constexpr size_t WS_U = WS_BIG, WS_G = WS_U + (size_t)HTOK * DUP * 2, WS_YD0 = WS_G + (size_t)HTOK * DFF * 2, WS_FFN_END = WS_YD0 + (size_t)HTOK * DM * 2;
constexpr size_t WS_YD1 = WS_U;
constexpr size_t WS_XB = WS_MIX_END > WS_FFN_END ? WS_MIX_END : WS_FFN_END;
constexpr size_t WS_BAR = WS_XB + (size_t)NTOK * DM * 2;
constexpr size_t WS_NEED = WS_BAR + XCD_BAR_WORDS * 4;

static_assert(WS_KF % 256 == 0 && WS_H % 256 == 0 && WS_BIG % 256 == 0 && WS_G % 256 == 0 && WS_YD0 % 256 == 0 && WS_XB % 256 == 0, "align");

enum { I_X = 0, I_C, I_ADAW, I_ADAB, I_GMPRE, I_GMPOST, I_WIN, I_SW, I_SB, I_FW1, I_FB1, I_FW2, I_FB2, I_FFREQ, I_FW3, I_HD, I_FNW, I_WOUT, I_GFPRE, I_GFPOST, I_WUP, I_DWW, I_DWB, I_WDOWN };
struct Params { const float* in[24]; float* out; unsigned char* ws; int ph_lo, ph_hi; };

__device__ __forceinline__ float bf2f(bf16_t v) { return __uint_as_float(((unsigned)v) << 16); }
__device__ __forceinline__ unsigned pack2(float lo, float hi) { unsigned r; asm("v_cvt_pk_bf16_f32 %0, %1, %2" : "=v"(r) : "v"(lo), "v"(hi)); return r; }
__device__ __forceinline__ bf16_t f2bf(float f) { return (bf16_t)(pack2(f, f) & 0xffffu); }
__device__ __forceinline__ int lane_now() { int l; asm volatile("v_mbcnt_lo_u32_b32 %0, -1, 0\n\tv_mbcnt_hi_u32_b32 %0, -1, %0" : "=v"(l)); return l; }
__device__ __forceinline__ int opaque_tid_(int wid_s) { return wid_s * 64 + lane_now(); }
#define opaque_tid() opaque_tid_(wid_s)
__device__ __forceinline__ float wave_sum(float v) {
#pragma unroll
    for (int o = 32; o >= 1; o >>= 1) v += __shfl_xor(v, o);
    return v;
}

template <class T> __device__ __forceinline__ void dft4(T& r0, T& i0, T& r1, T& i1, T& r2, T& i2, T& r3, T& i3) {
    const T s0r = r0 + r2, s0i = i0 + i2, s1r = r0 - r2, s1i = i0 - i2;
    const T s2r = r1 + r3, s2i = i1 + i3, s3r = r1 - r3, s3i = i1 - i3;
    r0 = s0r + s2r; i0 = s0i + s2i; r2 = s0r - s2r; i2 = s0i - s2i;
    r1 = s1r + s3i; i1 = s1i - s3r; r3 = s1r - s3i; i3 = s1i + s3r;
}
template <int K, class T> __device__ __forceinline__ void tw16(T& r, T& i) {
    if constexpr (K == 0) { }
    else if constexpr (K == 4) { const T t = r; r = i; i = -t; }
    else {
        constexpr float C[10] = {1.f, 0.92387953251128674f, 0.70710678118654752f, 0.38268343236508977f, 0.f, -0.38268343236508977f, -0.70710678118654752f, -0.92387953251128674f, -1.f, -0.92387953251128674f};
        constexpr float S[10] = {0.f, -0.38268343236508977f, -0.70710678118654752f, -0.92387953251128674f, -1.f, -0.92387953251128674f, -0.70710678118654752f, -0.38268343236508977f, 0.f, 0.38268343236508977f};
        const float c = C[K], s = S[K]; const T t = r * c - i * s; i = r * s + i * c; r = t;
    }
}
template <class T> __device__ __forceinline__ void dft16(T (&xr)[16], T (&xi)[16]) {
#pragma unroll
    for (int b = 0; b < 4; ++b) dft4(xr[b], xi[b], xr[4 + b], xi[4 + b], xr[8 + b], xi[8 + b], xr[12 + b], xi[12 + b]);
    tw16<1>(xr[5], xi[5]); tw16<2>(xr[6], xi[6]); tw16<3>(xr[7], xi[7]);
    tw16<2>(xr[9], xi[9]); tw16<4>(xr[10], xi[10]); tw16<6>(xr[11], xi[11]);
    tw16<3>(xr[13], xi[13]); tw16<6>(xr[14], xi[14]); tw16<9>(xr[15], xi[15]);
#pragma unroll
    for (int c = 0; c < 4; ++c) dft4(xr[4 * c], xi[4 * c], xr[4 * c + 1], xi[4 * c + 1], xr[4 * c + 2], xi[4 * c + 2], xr[4 * c + 3], xi[4 * c + 3]);
#pragma unroll
    for (int c = 0; c < 4; ++c)
#pragma unroll
        for (int d = c + 1; d < 4; ++d) { T t = xr[4 * c + d]; xr[4 * c + d] = xr[4 * d + c]; xr[4 * d + c] = t; t = xi[4 * c + d]; xi[4 * c + d] = xi[4 * d + c]; xi[4 * d + c] = t; }
}
constexpr int PBUF = 4096;
constexpr int LDS_MAIN = 2 * PBUF * 16;
constexpr int LDS_KF = LDS_MAIN;
__device__ __forceinline__ void fft4096_pk(f32x2v (&xr)[16], f32x2v (&xi)[16], f32x4v* buf, const int t, const f32x2v* __restrict__ TW) {
    dft16(xr, xi);
    __syncthreads();
    {
        f32x2v w1 = TW[2 * t]; asm volatile("" : "+v"(w1.x), "+v"(w1.y));
        float wr = w1.x, wi = w1.y;
        buf[t] = (f32x4v){xr[0].x, xr[0].y, xi[0].x, xi[0].y};
#pragma unroll
        for (int k = 1; k < 16; ++k) {
            const f32x2v r = xr[k], i = xi[k]; const f32x2v nr = r * wr - i * wi, ni = r * wi + i * wr;
            buf[k * 256 + t] = (f32x4v){nr.x, nr.y, ni.x, ni.y};
            if (k < 15) { const float n2 = wr * w1.x - wi * w1.y; wi = wr * w1.y + wi * w1.x; wr = n2; }
        }
    }
    __syncthreads();
    const int k1 = t >> 4, m2 = t & 15;
#pragma unroll
    for (int m = 0; m < 16; ++m) { const f32x4v v = buf[k1 * 256 + 16 * m + m2]; xr[m] = (f32x2v){v.x, v.y}; xi[m] = (f32x2v){v.z, v.w}; }
    __syncthreads();
    dft16(xr, xi);
    {
        f32x2v w1 = TW[32 * m2]; asm volatile("" : "+v"(w1.x), "+v"(w1.y));
        float wr = w1.x, wi = w1.y;
        buf[m2 * 256 + (k1 ^ (m2 & 7))] = (f32x4v){xr[0].x, xr[0].y, xi[0].x, xi[0].y};
#pragma unroll
        for (int j = 1; j < 16; ++j) {
            const f32x2v r = xr[j], i = xi[j]; const f32x2v nr = r * wr - i * wi, ni = r * wi + i * wr;
            buf[m2 * 256 + ((k1 + 16 * j) ^ (m2 & 7))] = (f32x4v){nr.x, nr.y, ni.x, ni.y};
            if (j < 15) { const float n2 = wr * w1.x - wi * w1.y; wi = wr * w1.y + wi * w1.x; wr = n2; }
        }
    }
    __syncthreads();
#pragma unroll
    for (int m = 0; m < 16; ++m) { const f32x4v v = buf[m * 256 + (t ^ (m & 7))]; xr[m] = (f32x2v){v.x, v.y}; xi[m] = (f32x2v){v.z, v.w}; }
    dft16(xr, xi);
}
__device__ __forceinline__ f32x2v w32(int j) {
    constexpr float C[16] = {1.f, 0.98078528040323043f, 0.92387953251128674f, 0.83146961230254524f, 0.70710678118654752f, 0.55557023301960218f, 0.38268343236508977f, 0.19509032201612825f, 0.f, -0.19509032201612825f, -0.38268343236508977f, -0.55557023301960218f, -0.70710678118654752f, -0.83146961230254524f, -0.92387953251128674f, -0.98078528040323043f};
    constexpr float S[16] = {0.f, -0.19509032201612825f, -0.38268343236508977f, -0.55557023301960218f, -0.70710678118654752f, -0.83146961230254524f, -0.92387953251128674f, -0.98078528040323043f, -1.f, -0.98078528040323043f, -0.92387953251128674f, -0.83146961230254524f, -0.70710678118654752f, -0.55557023301960218f, -0.38268343236508977f, -0.19509032201612825f};
    return (f32x2v){C[j], S[j]};
}
constexpr int LDS_BYTES = LDS_MAIN + 32768;
static_assert(LDS_MAIN >= pg8::STAGE_BYTES, "lds");
typedef _Float16 f16x4v __attribute__((ext_vector_type(4)));
__device__ __forceinline__ void kf_dma(const unsigned char* src, unsigned char* kfl, int tid) {
    const int w = __builtin_amdgcn_readfirstlane(tid >> 6), lane = tid & 63;
#pragma unroll
    for (int q = 0; q < 4; ++q)
        __builtin_amdgcn_global_load_lds((const unsigned*)(src + (w * 4 + q) * 1024 + lane * 16), (LAS unsigned*)(kfl + (w * 4 + q) * 1024), 16, 0, 0);
}
__device__ __forceinline__ bf16_t* wbf(const Params& P, int l, size_t off) { return (bf16_t*)(P.ws + WS_WBF) + (size_t)l * WL_END + off; }
__device__ __forceinline__ const float* modp(const Params& P, int l, int which) { return (const float*)(P.ws + WS_MOD) + (size_t)l * NB * 6144 + which * 1024; }

__device__ __forceinline__ void ph_tconv(const Params& P, float* tile, const int wid_s) {
    const int tid = opaque_tid();
    for (int it = blockIdx.x; it < DEPTH * 2752; it += gridDim.x) {
        const int l = it / 2752; int r = it % 2752;
        const float* src; int ldsrc, lddst, tk, tn; bf16_t* dst;
        if (r < 384) { src = P.in[I_WIN] + (size_t)l * DM * 2048; ldsrc = 2048; lddst = DM; tk = r / 24; tn = r % 24; dst = wbf(P, l, WL_WIN); }
        else if (r < 640) { r -= 384; src = P.in[I_WOUT] + (size_t)l * DM * DM; ldsrc = DM; lddst = DM; tk = r / 16; tn = r % 16; dst = wbf(P, l, WL_WOUT); }
        else if (r < 2048) { r -= 640; src = P.in[I_WUP] + (size_t)l * DM * DUP; ldsrc = DUP; lddst = DM; tk = r / 88; tn = r % 88; dst = wbf(P, l, WL_WUP); }
        else { r -= 2048; src = P.in[I_WDOWN] + (size_t)l * DFF * DM; ldsrc = DM; lddst = DFF; tk = r / 16; tn = r % 16; dst = wbf(P, l, WL_WDN); }
        { const int kk = tid >> 3, c8 = (tid & 7) * 8; const float* s = src + (size_t)(tk * 64 + kk) * ldsrc + tn * 64 + c8; const f32x4v v0 = *(const f32x4v*)s, v1 = *(const f32x4v*)(s + 4);
          float* t = tile + kk * 65 + c8; t[0] = v0.x; t[1] = v0.y; t[2] = v0.z; t[3] = v0.w; t[4] = v1.x; t[5] = v1.y; t[6] = v1.z; t[7] = v1.w; }
        __syncthreads();
        { const int nn = tid >> 3, k8 = (tid & 7) * 8; const float* t = tile + k8 * 65 + nn;
          *(u32x4v*)(dst + (size_t)(tn * 64 + nn) * lddst + tk * 64 + k8) = (u32x4v){pack2(t[0], t[65]), pack2(t[130], t[195]), pack2(t[260], t[325]), pack2(t[390], t[455])}; }
        __syncthreads();
    }
}
__device__ __forceinline__ void ph_fold(const Params& P, float* lds, const int wid_s) {
    const int tid = opaque_tid();
    float* CW = lds; float* SWm = lds + 4096; float* ct = lds + 8192; float* st = lds + 8192 + 64;
    for (int it = blockIdx.x; it < DEPTH * 64; it += gridDim.x) {
        const int l = it >> 6, g = (it >> 3) & 7, kc = it & 7;
        const float* Wg = P.in[I_FNW] + ((size_t)l * 8 + g) * 4096;
        if (tid < 64) { float s, c; sincospif((float)tid * (1.0f / 32.0f), &s, &c); ct[tid] = c; st[tid] = s; }
        __syncthreads();
        for (int idx = tid; idx < 4096; idx += NTHR) { const int c = idx >> 6, d = idx & 63; float ac = 0.f, as = 0.f;
            for (int m = 0; m < 64; ++m) { const float w = Wg[m * 64 + d]; const int ph = (c * m) & 63; ac += ct[ph] * w; as += st[ph] * w; }
            CW[idx] = ac * (1.0f / 512.0f); SWm[idx] = as * (1.0f / 512.0f); }
        __syncthreads();
        bf16_t* WinT = wbf(P, l, WL_WIN);
        for (int idx = tid; idx < 2 * 64 * 128; idx += NTHR) { const int which = idx >> 13, d = (idx >> 7) & 63, kk = idx & 127, k = kc * 128 + kk;
            const float* row = P.in[I_WIN] + ((size_t)l * DM + k) * 2048 + 1536 + 64 * g; const float* Mx = which ? SWm : CW; float a = 0.f;
            for (int c = 0; c < 64; ++c) a += row[c] * Mx[c * 64 + d];
            WinT[(size_t)(1536 + which * 512 + g * 64 + d) * DM + k] = f2bf(a); }
        __syncthreads();
    }
}
__device__ __forceinline__ void ph_mod(const Params& P, float* lds, const int wid_s) {
    const int tid = opaque_tid();
    float* cact = lds;
    float* red = lds + 16384;
    if ((int)blockIdx.x >= DEPTH * 96) return;
    for (int idx = tid; idx < NB * DM; idx += NTHR) { const int b = idx >> 10, k = idx & 1023; const float v = P.in[I_C][idx]; cact[k * 16 + b] = v / (1.0f + __expf(-v)); }
    __syncthreads();
    for (int it = blockIdx.x; it < DEPTH * 96; it += gridDim.x) {
        const int l = it / 96, n0 = (it % 96) * 64, ks = tid >> 6, nn = tid & 63;
        float acc[16];
#pragma unroll
        for (int b = 0; b < 16; ++b) acc[b] = 0.f;
        const float* w = P.in[I_ADAW] + ((size_t)l * DM + ks * 128) * 6144 + n0 + nn;
        for (int k = 0; k < 128; ++k) { const float wv = w[(size_t)k * 6144]; const f32x4v* cp = (const f32x4v*)(cact + (ks * 128 + k) * 16);
#pragma unroll
            for (int q = 0; q < 4; ++q) { const f32x4v cv = cp[q]; acc[4 * q] += cv.x * wv; acc[4 * q + 1] += cv.y * wv; acc[4 * q + 2] += cv.z * wv; acc[4 * q + 3] += cv.w * wv; } }
#pragma unroll
        for (int b = 0; b < 16; ++b) red[(ks * 64 + nn) * 16 + b] = acc[b];
        __syncthreads();
        for (int idx = tid; idx < 1024; idx += NTHR) { const int b = idx >> 6, n = idx & 63; float s = P.in[I_ADAB][(size_t)l * 6144 + n0 + n];
#pragma unroll
            for (int q = 0; q < 8; ++q) s += red[(q * 64 + n) * 16 + b];
            ((float*)(P.ws + WS_MOD))[((size_t)l * NB + b) * 6144 + n0 + n] = s; }
        __syncthreads();
    }
}
__device__ __forceinline__ void ph_tw(const Params& P, const int wid_s) {
    f32x2v* TW = (f32x2v*)(P.ws + WS_TW);
    const int tid = opaque_tid();
    for (int j = blockIdx.x * NTHR + tid; j < 8192; j += gridDim.x * NTHR) { float s, c; sincospif((float)j * (1.0f / 4096.0f), &s, &c); TW[j] = (f32x2v){c, -s}; }
}
__device__ __forceinline__ void ph_fh2(const Params& P, float* lds, const int wid_s) {
    const int tid = opaque_tid(), p = tid >> 6, j = tid & 63;
    float* z = lds;
    float* h1 = lds + 8 * 36;
    for (int it = blockIdx.x; it < DEPTH * 512; it += gridDim.x) {
        const int l = it >> 9, pos = (it & 511) * 8 + p;
        if (j < 33) { float v;
            if (j == 0) v = (float)pos / 4095.0f;
            else { const int bi = (j - 1) & 15; const float band = 1e-4f + (float)bi * ((15.0f - 1e-4f) / 15.0f); float s, c; sincospif((float)pos * band * (2.0f / 4096.0f), &s, &c); v = (j <= 16) ? c : -s; }
            z[p * 36 + j] = v; }
        __syncthreads();
        const float fr = P.in[I_FFREQ][l * 64 + j];
        { float a = P.in[I_FB1][l * 64 + j]; const float* w1 = P.in[I_FW1] + (size_t)l * 33 * 64 + j;
          for (int i = 0; i < 33; ++i) a += z[p * 36 + i] * w1[i * 64];
          h1[p * 64 + j] = sinf(fr * a); }
        __syncthreads();
        { float a = P.in[I_FB2][l * 64 + j]; const float* w2 = P.in[I_FW2] + (size_t)l * 64 * 64 + j;
          for (int i = 0; i < 64; ++i) a += h1[p * 64 + i] * w2[i * 64];
          ((float*)(P.ws + WS_FH2))[((size_t)l * SEQ + pos) * 64 + j] = sinf(fr * a); }
        __syncthreads();
    }
}
__device__ __forceinline__ void ph_h3t(const Params& P, int l, float* lds, const int wid_s) {
    const int tid = opaque_tid(), pq = tid & 31, cq = tid >> 5;
    float* AT = lds;
    float* Bs = lds + 64 * 132;
    const float* FH2 = (const float*)(P.ws + WS_FH2) + (size_t)l * SEQ * 64; const float* w3 = P.in[I_FW3] + (size_t)l * 64 * 2048; float* H3T = (float*)(P.ws + WS_H3T);
    for (int it = blockIdx.x; it < 32 * 16; it += gridDim.x) {
        const int p0 = (it & 31) * 128, c0 = (it >> 5) * 128;
#pragma unroll
        for (int i = 0; i < 16; ++i) { const int idx = tid + 512 * i; { const int r = idx >> 6, q = idx & 63; AT[q * 132 + r] = FH2[(size_t)(p0 + r) * 64 + q]; } { const int q = idx >> 7, cc = idx & 127; Bs[q * 128 + cc] = w3[(size_t)q * 2048 + c0 + cc]; } }
        __syncthreads();
        f32x4v acc[8];
#pragma unroll
        for (int j = 0; j < 8; ++j) acc[j] = (f32x4v){0.f, 0.f, 0.f, 0.f};
#pragma unroll 4
        for (int q = 0; q < 64; ++q) { const f32x4v a = *(const f32x4v*)(AT + q * 132 + pq * 4), b0 = *(const f32x4v*)(Bs + q * 128 + cq * 8), b1 = *(const f32x4v*)(Bs + q * 128 + cq * 8 + 4);
            acc[0] += a * b0.x; acc[1] += a * b0.y; acc[2] += a * b0.z; acc[3] += a * b0.w; acc[4] += a * b1.x; acc[5] += a * b1.y; acc[6] += a * b1.z; acc[7] += a * b1.w; }
#pragma unroll
        for (int j = 0; j < 8; ++j) *(f32x4v*)(H3T + (size_t)(c0 + cq * 8 + j) * SEQ + p0 + pq * 4) = acc[j];
        __syncthreads();
    }
}
__device__ __forceinline__ void ph_kf(const Params& P, int l, float* lds, const int wid_s) {
    const int tid = opaque_tid(), hh = tid >> 8, t = tid & 255;
    f32x4v* buf = (f32x4v*)lds + hh * PBUF; float* red = (float*)((f32x4v*)lds + hh * PBUF);
    const f32x2v* TW = (const f32x2v*)(P.ws + WS_TW); const float* H3T = (const float*)(P.ws + WS_H3T); f16x4v* KF = (f16x4v*)(P.ws + WS_KF);
    const float min_decay = -4.605170185988091f / 1.5f, max_decay = -4.605170185988091f / 0.3f;
    for (int it0 = blockIdx.x * 2; it0 < 2 * DH; it0 += gridDim.x * 2) {
        const int it = it0 + hh, n = it >> 9, c = it & 511;
        int tv = t; asm volatile("" : "+v"(tv));
        const float ad = fabsf(min_decay + (float)c * ((max_decay - min_decay) / 511.0f));
        const float* fw = H3T + (size_t)(n * 1024 + c) * SEQ; const float* bw = H3T + (size_t)(n * 1024 + 512 + c) * SEQ;
        float fr[16], br[16]; float l1 = 0.f;
#pragma unroll
        for (int j = 0; j < 16; ++j) { const int m = tv + 256 * j;
            const float f = fw[m] * __expf(-((float)m * (1.0f / 4095.0f)) * ad);
            const float b = (m == 0) ? 0.f : bw[SEQ - m] * __expf(-((float)(SEQ - m) * (1.0f / 4095.0f)) * ad);
            l1 += fabsf(f) + fabsf(b); fr[j] = f; br[j] = b; }
        l1 = wave_sum(l1);
        __syncthreads();
        if ((tid & 63) == 0) red[(tid >> 6) & 3] = l1;
        __syncthreads();
        const float tot = red[0] + red[1] + red[2] + red[3];
        const float sc = 1.0f / (tot + 1e-6f);
        f32x2v wt = TW[tv]; asm volatile("" : "+v"(wt.x), "+v"(wt.y));
        f32x2v xr[16], xi[16];
#pragma unroll
        for (int j = 0; j < 16; ++j) { const f32x2v wj = w32(j); const float wx = wt.x * wj.x - wt.y * wj.y, wy = wt.x * wj.y + wt.y * wj.x; const float s = (fr[j] + br[j]) * sc, d = (fr[j] - br[j]) * sc;
            xr[j] = (f32x2v){s, d * wx}; xi[j] = (f32x2v){0.f, d * wy}; }
        fft4096_pk(xr, xi, buf, tv, TW);
        const float dsk = P.in[I_HD][(size_t)l * 2 * DH + it];
        f16x4v* o = KF + (size_t)it * SEQ;
#pragma unroll
        for (int j = 0; j < 16; ++j) o[tv + 256 * j] = (f16x4v){(_Float16)(xr[j].x + dsk), (_Float16)(xr[j].y + dsk), (_Float16)xi[j].x, (_Float16)xi[j].y};
    }
    __syncthreads();
}
__device__ __forceinline__ void ld8f(const float* p, float (&f)[16], int o) { const f32x4v a = *(const f32x4v*)p, b = *(const f32x4v*)(p + 4); f[o] = a.x; f[o + 1] = a.y; f[o + 2] = a.z; f[o + 3] = a.w; f[o + 4] = b.x; f[o + 5] = b.y; f[o + 6] = b.z; f[o + 7] = b.w; }
__device__ __forceinline__ void un8(const u32x4v w, float (&f)[16], int o) {
    f[o] = __uint_as_float(w.x << 16); f[o + 1] = __uint_as_float(w.x & 0xffff0000u); f[o + 2] = __uint_as_float(w.y << 16); f[o + 3] = __uint_as_float(w.y & 0xffff0000u);
    f[o + 4] = __uint_as_float(w.z << 16); f[o + 5] = __uint_as_float(w.z & 0xffff0000u); f[o + 6] = __uint_as_float(w.w << 16); f[o + 7] = __uint_as_float(w.w & 0xffff0000u);
}
template <int XI, int XO>
__device__ __forceinline__ void ph_resnorm(const void* xin_, void* xout_, const bf16_t* y, const bf16_t* y_hi  , const float* gpost, const float* gate, const float* gnext, const float* scale, const float* shift, bf16_t* hout, const int wid_s) {
    constexpr int RW = 4;
    const int tid = opaque_tid(); const int lane = tid & 63, wv = tid >> 6;
    for (int row0 = (blockIdx.x * 8 + wv) * RW; row0 < NTOK; row0 += gridDim.x * 8 * RW) {
        const int b = row0 >> 12; float x[RW][16]; u32x4v yw[RW][2];
        const bf16_t* ysel = (row0 < HTOK) ? y : y_hi - (size_t)HTOK * DM;
#pragma unroll
        for (int r = 0; r < RW; ++r)
#pragma unroll
            for (int q = 0; q < 2; ++q) { const size_t off = (size_t)(row0 + r) * DM + q * 512 + lane * 8;
                if (XI) un8(__builtin_nontemporal_load((const u32x4v*)((const bf16_t*)xin_ + off)), x[r], q * 8);
                else { const f32x4v a = __builtin_nontemporal_load((const f32x4v*)((const float*)xin_ + off)), c = __builtin_nontemporal_load((const f32x4v*)((const float*)xin_ + off + 4));
                    x[r][q * 8] = a.x; x[r][q * 8 + 1] = a.y; x[r][q * 8 + 2] = a.z; x[r][q * 8 + 3] = a.w; x[r][q * 8 + 4] = c.x; x[r][q * 8 + 5] = c.y; x[r][q * 8 + 6] = c.z; x[r][q * 8 + 7] = c.w; }
                if (y) yw[r][q] = __builtin_nontemporal_load((const u32x4v*)(ysel + off)); }
        if (y) {
            float g[16], gt[16];
#pragma unroll
            for (int q = 0; q < 2; ++q) { ld8f(gpost + q * 512 + lane * 8, g, q * 8); ld8f(gate + (size_t)b * 6144 + q * 512 + lane * 8, gt, q * 8); }
#pragma unroll
            for (int e = 0; e < 16; ++e) g[e] *= gt[e];
#pragma unroll
            for (int r = 0; r < RW; ++r) {
                float yv[16]; un8(yw[r][0], yv, 0); un8(yw[r][1], yv, 8); float ss = 0.f;
#pragma unroll
                for (int e = 0; e < 16; ++e) ss += yv[e] * yv[e];
                ss = wave_sum(ss); const float rinv = rsqrtf(ss * (1.0f / 1024.0f) + 1e-6f);
#pragma unroll
                for (int e = 0; e < 16; ++e) x[r][e] += g[e] * (yv[e] * rinv);
#pragma unroll
                for (int q = 0; q < 2; ++q) { const size_t off = (size_t)(row0 + r) * DM + q * 512 + lane * 8; const float* xs = &x[r][q * 8];
                    if (XO) { const u32x4v w = (u32x4v){pack2(xs[0], xs[1]), pack2(xs[2], xs[3]), pack2(xs[4], xs[5]), pack2(xs[6], xs[7])}; __builtin_nontemporal_store(w, (u32x4v*)((bf16_t*)xout_ + off)); un8(w, x[r], q * 8); }
                    else { __builtin_nontemporal_store((f32x4v){xs[0], xs[1], xs[2], xs[3]}, (f32x4v*)((float*)xout_ + off)); __builtin_nontemporal_store((f32x4v){xs[4], xs[5], xs[6], xs[7]}, (f32x4v*)((float*)xout_ + off + 4)); } }
            }
        }
        if (hout) {
            float g[16], sc[16], sh[16];
#pragma unroll
            for (int q = 0; q < 2; ++q) { ld8f(gnext + q * 512 + lane * 8, g, q * 8); ld8f(scale + (size_t)b * 6144 + q * 512 + lane * 8, sc, q * 8); ld8f(shift + (size_t)b * 6144 + q * 512 + lane * 8, sh, q * 8); }
#pragma unroll
            for (int e = 0; e < 16; ++e) g[e] *= (sc[e] + 1.0f);
#pragma unroll
            for (int r = 0; r < RW; ++r) {
                float ss = 0.f;
#pragma unroll
                for (int e = 0; e < 16; ++e) ss += x[r][e] * x[r][e];
                ss = wave_sum(ss); const float rinv = rsqrtf(ss * (1.0f / 1024.0f) + 1e-6f);
#pragma unroll
                for (int q = 0; q < 2; ++q) { float hv[8];
#pragma unroll
                    for (int e = 0; e < 8; ++e) hv[e] = x[r][q * 8 + e] * rinv * g[q * 8 + e] + sh[q * 8 + e];
                    *(u32x4v*)(hout + (size_t)(row0 + r) * DM + q * 512 + lane * 8) = (u32x4v){pack2(hv[0], hv[1]), pack2(hv[2], hv[3]), pack2(hv[4], hv[5]), pack2(hv[6], hv[7])}; }
            }
        }
    }
}
__device__ __forceinline__ void stage_sconv(const bf16_t* PT, int col, int b0, float w0, float w1, float w2, float bs, float* gl, int t) {
    const int rsel = t >> 7, seg = t & 127;
#pragma unroll
    for (int q = 0; q < 2; ++q) {
        const int e0 = q * 2048 + seg * 16; const bf16_t* row = PT + ((size_t)(b0 + rsel) * NPT + col) * SEQ + e0;
        const u32x4v A = *(const u32x4v*)row, B = *(const u32x4v*)(row + 8);
        float e[18]; e[0] = e0 ? bf2f(row[-1]) : 0.f; e[17] = (e0 + 16 < SEQ) ? bf2f(row[16]) : 0.f;
        e[1] = __uint_as_float(A.x << 16); e[2] = __uint_as_float(A.x & 0xffff0000u); e[3] = __uint_as_float(A.y << 16); e[4] = __uint_as_float(A.y & 0xffff0000u);
        e[5] = __uint_as_float(A.z << 16); e[6] = __uint_as_float(A.z & 0xffff0000u); e[7] = __uint_as_float(A.w << 16); e[8] = __uint_as_float(A.w & 0xffff0000u);
        e[9] = __uint_as_float(B.x << 16); e[10] = __uint_as_float(B.x & 0xffff0000u); e[11] = __uint_as_float(B.y << 16); e[12] = __uint_as_float(B.y & 0xffff0000u);
        e[13] = __uint_as_float(B.z << 16); e[14] = __uint_as_float(B.z & 0xffff0000u); e[15] = __uint_as_float(B.w << 16); e[16] = __uint_as_float(B.w & 0xffff0000u);
        f32x4v* o = (f32x4v*)(gl + rsel * SEQ + e0);
#pragma unroll
        for (int u = 0; u < 4; ++u) { f32x4v v;
            v.x = bs + e[4 * u] * w0 + e[4 * u + 1] * w1 + e[4 * u + 2] * w2; v.y = bs + e[4 * u + 1] * w0 + e[4 * u + 2] * w1 + e[4 * u + 3] * w2;
            v.z = bs + e[4 * u + 2] * w0 + e[4 * u + 3] * w1 + e[4 * u + 4] * w2; v.w = bs + e[4 * u + 3] * w0 + e[4 * u + 4] * w1 + e[4 * u + 5] * w2; o[u] = v; }
    }
}
__device__ __forceinline__ void store_rows2(const float (&v0)[16], const float (&v1)[16], bf16_t* st, bf16_t* o0, bf16_t* o1, int tv) {
#pragma unroll
    for (int j = 0; j < 16; ++j) { const unsigned w = pack2(v0[j], v1[j]); st[tv + 256 * j] = (bf16_t)(w & 0xffffu); st[SEQ + tv + 256 * j] = (bf16_t)(w >> 16); }
    __syncthreads();
    const int r = tv >> 7, seg = tv & 127; bf16_t* o = r ? o1 : o0;
#pragma unroll
    for (int q = 0; q < 4; ++q) *(u32x4v*)(o + q * 1024 + seg * 8) = *(const u32x4v*)(st + r * SEQ + q * 1024 + seg * 8);
}
__device__ __forceinline__ void ph_mix(const Params& P, int l, float* lds, const int wid_s) {
    const int tid = opaque_tid(), hh = tid >> 8, t = tid & 255;
    f32x4v* buf = (f32x4v*)lds + hh * PBUF; float* gl = (float*)buf;
    const f32x2v* TW = (const f32x2v*)(P.ws + WS_TW); const unsigned char* KF = P.ws + WS_KF; unsigned char* kfl = (unsigned char*)lds + LDS_KF;
    const bf16_t* PT = (const bf16_t*)(P.ws + WS_PT); bf16_t* YT = (bf16_t*)(P.ws + WS_YT);
    const float* sw = P.in[I_SW] + (size_t)l * 3 * 1536; const float* sb = P.in[I_SB] + (size_t)l * 1536;
    if ((int)blockIdx.x * 2 < DH * 8) kf_dma(KF + (size_t)(blockIdx.x >> 2) * 32768, kfl, tid);
    for (int it0 = blockIdx.x * 2; it0 < DH * 8; it0 += gridDim.x * 2) {
        const int it = it0 + hh, c = it >> 3, bp = it & 7, b0 = 2 * bp;
        int tv = t; asm volatile("" : "+v"(tv));
        float zr[16], zi[16];
        __syncthreads();
        stage_sconv(PT, c, b0, sw[c], sw[1536 + c], sw[3072 + c], sb[c], gl, tv);
        __syncthreads();
#pragma unroll
        for (int j = 0; j < 16; ++j) { zr[j] = gl[tv + 256 * j]; zi[j] = gl[SEQ + tv + 256 * j]; }
#pragma unroll 1
        for (int n = 0; n < 2; ++n) {
            f32x2v wt = TW[tv]; asm volatile("" : "+v"(wt.x), "+v"(wt.y));
            f32x2v xr[16], xi[16];
#pragma unroll
            for (int j = 0; j < 16; ++j) { const f32x2v wj = w32(j); const float wx = wt.x * wj.x - wt.y * wj.y, wy = wt.x * wj.y + wt.y * wj.x;
                xr[j] = (f32x2v){zr[j], zr[j] * wx - zi[j] * wy}; xi[j] = (f32x2v){zi[j], zr[j] * wy + zi[j] * wx}; }
            fft4096_pk(xr, xi, buf, tv, TW);
#pragma unroll
            for (int j = 0; j < 16; ++j) asm volatile("" : "+v"(xr[j]), "+v"(xi[j]));
            asm volatile("s_waitcnt vmcnt(0)" ::: "memory"); __syncthreads();
#pragma unroll
            for (int j = 0; j < 16; ++j) { const f16x4v k = *(const f16x4v*)(kfl + (tv + 256 * j) * 8); const f32x2v kr = (f32x2v){(float)k.x, (float)k.y}, ki = (f32x2v){(float)k.z, (float)k.w};
                const f32x2v pr = xr[j] * kr - xi[j] * ki, pi = xr[j] * ki + xi[j] * kr; xr[j] = pr; xi[j] = -pi; }
            __syncthreads();
            { const int cn = (n == 0) ? c : ((it0 + (int)gridDim.x * 2) >> 3);
              if (n == 0 || it0 + (int)gridDim.x * 2 < DH * 8) kf_dma(KF + (size_t)((1 - n) * DH + cn) * 32768, kfl, tid); }
            fft4096_pk(xr, xi, buf, tv, TW);
            const int col = (n + 1) * DH + c;
            __syncthreads();
            stage_sconv(PT, col, b0, sw[col] * (1.0f / 8192.0f), sw[1536 + col] * (1.0f / 8192.0f), sw[3072 + col] * (1.0f / 8192.0f), sb[col] * (1.0f / 8192.0f), gl, tv);
            __syncthreads();
#pragma unroll
            for (int j = 0; j < 16; ++j) { const int m = tv + 256 * j; const f32x2v wj = w32(j); const float wx = wt.x * wj.x - wt.y * wj.y, wy = wt.x * wj.y + wt.y * wj.x;
                const float er = xr[j].x, ei = -xi[j].x, orr = xr[j].y, oi = -xi[j].y;
                const float cr = er + (orr * wx + oi * wy), ci = ei + (oi * wx - orr * wy);
                zr[j] = gl[m] * cr; zi[j] = gl[SEQ + m] * ci; }
        }
        bf16_t* o0 = YT + ((size_t)b0 * DM + c) * SEQ;
        store_rows2(zr, zi, (bf16_t*)(gl + 2 * SEQ), o0, o0 + (size_t)DM * SEQ, tv);
    }
#ifndef REP_FNET
#define REP_FNET 1
#endif
    for (int rep = 0; rep < REP_FNET; ++rep)
    for (int it0 = blockIdx.x * 2; it0 < NB * DH / 2; it0 += gridDim.x * 2) {
        const int s = 2 * (it0 + hh), b = s >> 9, ch = s & 511;
        int tv = t; asm volatile("" : "+v"(tv));
        const bf16_t* ra = PT + ((size_t)b * NPT + 1536 + ch) * SEQ; const bf16_t* rb = PT + ((size_t)b * NPT + 2048 + ch) * SEQ;
        bf16_t* sta = (bf16_t*)gl; bf16_t* stb = sta + 2 * SEQ;
        __syncthreads();
        { u32x4v va[4], vb[4];
#pragma unroll
          for (int q = 0; q < 4; ++q) { va[q] = *(const u32x4v*)(ra + (q * 256 + tv) * 8); vb[q] = *(const u32x4v*)(rb + (q * 256 + tv) * 8); }
#pragma unroll
          for (int q = 0; q < 4; ++q) { *(u32x4v*)(sta + (q * 256 + tv) * 8) = va[q]; *(u32x4v*)(stb + (q * 256 + tv) * 8) = vb[q]; } }
        __syncthreads();
        f32x2v xr[16], xi[16];
#pragma unroll
        for (int j = 0; j < 16; ++j) { const int m = tv + 256 * j; xr[j] = (f32x2v){bf2f(sta[m]), bf2f(sta[SEQ + m])}; xi[j] = (f32x2v){-bf2f(stb[m]), -bf2f(stb[SEQ + m])}; }
        fft4096_pk(xr, xi, buf, tv, TW);
        float o0v[16], o1v[16];
#pragma unroll
        for (int j = 0; j < 16; ++j) { o0v[j] = xr[j].x; o1v[j] = xr[j].y; }
        __syncthreads();
        bf16_t* o = YT + ((size_t)b * DM + 512 + ch) * SEQ;
        store_rows2(o0v, o1v, (bf16_t*)gl, o, o + SEQ, tv);
    }
    __syncthreads();
}
__device__ __forceinline__ void ph_transpose(const Params& P, float* lds, const int wid_s) {
    const int tid = opaque_tid(); bf16_t* tile = (bf16_t*)lds;
    const bf16_t* YT = (const bf16_t*)(P.ws + WS_YT); bf16_t* Y = (bf16_t*)(P.ws + WS_Y);
    for (int it = blockIdx.x; it < NB * 4 * 64; it += gridDim.x) {
        const int b = it >> 8, cq = (it >> 6) & 3, lt = it & 63;
        { const int r = tid >> 3, q = tid & 7; u32x4v v[4];
#pragma unroll
          for (int u = 0; u < 4; ++u) v[u] = *(const u32x4v*)(YT + ((size_t)b * DM + cq * 256 + u * 64 + r) * SEQ + lt * 64 + q * 8);
#pragma unroll
          for (int u = 0; u < 4; ++u) *(u32x4v*)(tile + (u * 64 + r) * 72 + q * 8) = v[u]; }
        __syncthreads();
        { const int lr = tid >> 3, q = tid & 7;
#pragma unroll
          for (int u = 0; u < 4; ++u) { unsigned w[4];
#pragma unroll
            for (int i = 0; i < 4; ++i) w[i] = (unsigned)tile[(u * 64 + q * 8 + 2 * i) * 72 + lr] | ((unsigned)tile[(u * 64 + q * 8 + 2 * i + 1) * 72 + lr] << 16);
            *(u32x4v*)(Y + ((size_t)b * SEQ + lt * 64 + lr) * DM + cq * 256 + u * 64 + q * 8) = (u32x4v){w[0], w[1], w[2], w[3]}; } }
        __syncthreads();
    }
}
__device__ __forceinline__ void unpack8(const u32x4v w, float (&f)[8]) {
    f[0] = __uint_as_float(w.x << 16); f[1] = __uint_as_float(w.x & 0xffff0000u); f[2] = __uint_as_float(w.y << 16); f[3] = __uint_as_float(w.y & 0xffff0000u);
    f[4] = __uint_as_float(w.z << 16); f[5] = __uint_as_float(w.z & 0xffff0000u); f[6] = __uint_as_float(w.w << 16); f[7] = __uint_as_float(w.w & 0xffff0000u);
}
__device__ __forceinline__ void ph_geglu(const Params& P, int l, const int wid_s) {
    const bf16_t* U = (const bf16_t*)(P.ws + WS_U); bf16_t* G = (bf16_t*)(P.ws + WS_G);
    const float* dww = P.in[I_DWW] + (size_t)l * 3 * DUP; const float* dwb = P.in[I_DWB] + (size_t)l * DUP;
    const int tid = opaque_tid();
    if (tid < DFF / 8) {
        const int f0 = tid * 8;
        float wa[3][8], wb[3][8], ba[8], bb[8];
#pragma unroll
        for (int k = 0; k < 3; ++k) { const f32x4v a0 = *(const f32x4v*)(dww + k * DUP + f0), a1 = *(const f32x4v*)(dww + k * DUP + f0 + 4), b0 = *(const f32x4v*)(dww + k * DUP + DFF + f0), b1 = *(const f32x4v*)(dww + k * DUP + DFF + f0 + 4);
            wa[k][0] = a0.x; wa[k][1] = a0.y; wa[k][2] = a0.z; wa[k][3] = a0.w; wa[k][4] = a1.x; wa[k][5] = a1.y; wa[k][6] = a1.z; wa[k][7] = a1.w;
            wb[k][0] = b0.x; wb[k][1] = b0.y; wb[k][2] = b0.z; wb[k][3] = b0.w; wb[k][4] = b1.x; wb[k][5] = b1.y; wb[k][6] = b1.z; wb[k][7] = b1.w; }
        { const f32x4v a0 = *(const f32x4v*)(dwb + f0), a1 = *(const f32x4v*)(dwb + f0 + 4), b0 = *(const f32x4v*)(dwb + DFF + f0), b1 = *(const f32x4v*)(dwb + DFF + f0 + 4);
          ba[0] = a0.x; ba[1] = a0.y; ba[2] = a0.z; ba[3] = a0.w; ba[4] = a1.x; ba[5] = a1.y; ba[6] = a1.z; ba[7] = a1.w; bb[0] = b0.x; bb[1] = b0.y; bb[2] = b0.z; bb[3] = b0.w; bb[4] = b1.x; bb[5] = b1.y; bb[6] = b1.z; bb[7] = b1.w; }
        const u32x4v zero = (u32x4v){0u, 0u, 0u, 0u};
        for (int blk = blockIdx.x; blk < HTOK / 128; blk += gridDim.x) {
            const int rbeg = blk * 128; const bool halo_lo = (rbeg & (SEQ - 1)) != 0, halo_hi = ((rbeg + 128) & (SEQ - 1)) != 0;
            const bf16_t* ua = U + (size_t)rbeg * DUP + f0; const bf16_t* ub = ua + DFF; bf16_t* go = G + (size_t)rbeg * DFF + f0;
            u32x4v ra[4], rb[4];
#pragma unroll
            for (int j = 0; j < 4; ++j) { ra[j] = __builtin_nontemporal_load((const u32x4v*)(ua + (size_t)j * DUP)); rb[j] = __builtin_nontemporal_load((const u32x4v*)(ub + (size_t)j * DUP)); }
            float pa[8], pb[8], ca[8], cb[8], na[8], nb[8];
            { const u32x4v ha = halo_lo ? *(const u32x4v*)(ua - DUP) : zero, hb = halo_lo ? *(const u32x4v*)(ub - DUP) : zero; unpack8(ha, pa); unpack8(hb, pb); }
            unpack8(ra[0], ca); unpack8(rb[0], cb);
            for (int o = 0; o < 32; ++o) {
#pragma unroll
                for (int j = 0; j < 4; ++j) {
                    const int s = o * 4 + j;
                    { const bool last = (o == 31) && (j == 3); const bool ok = !last || halo_hi; unpack8(ok ? ra[(j + 1) & 3] : zero, na); unpack8(ok ? rb[(j + 1) & 3] : zero, nb); }
                    if (o < 31 || j == 0) { const int rr = (s + 4 < HTOK - rbeg) ? s + 4 : s;
                        ra[j] = __builtin_nontemporal_load((const u32x4v*)(ua + (size_t)rr * DUP)); rb[j] = __builtin_nontemporal_load((const u32x4v*)(ub + (size_t)rr * DUP)); }
                    float ov[8];
#pragma unroll
                    for (int e = 0; e < 8; e += 2) {
                        const f32x2v av = (f32x2v){ba[e] + pa[e] * wa[0][e] + ca[e] * wa[1][e] + na[e] * wa[2][e], ba[e + 1] + pa[e + 1] * wa[0][e + 1] + ca[e + 1] * wa[1][e + 1] + na[e + 1] * wa[2][e + 1]};
                        const f32x2v gv = pg8::gelu_pk(av);
                        ov[e] = gv.x * (bb[e] + pb[e] * wb[0][e] + cb[e] * wb[1][e] + nb[e] * wb[2][e]);
                        ov[e + 1] = gv.y * (bb[e + 1] + pb[e + 1] * wb[0][e + 1] + cb[e + 1] * wb[1][e + 1] + nb[e + 1] * wb[2][e + 1]); }
                    *(u32x4v*)(go + (size_t)s * DFF) = (u32x4v){pack2(ov[0], ov[1]), pack2(ov[2], ov[3]), pack2(ov[4], ov[5]), pack2(ov[6], ov[7])};
#pragma unroll
                    for (int e = 0; e < 8; ++e) { pa[e] = ca[e]; pb[e] = cb[e]; ca[e] = na[e]; cb[e] = nb[e]; }
                }
            }
        }
    }
}
constexpr int N_PHASES = 3 + 12 * DEPTH;
#ifndef NT_MODE
#define NT_MODE 1
#endif
#define NT_MASK(ld) ((NT_MODE == 1) ? ((ld) == DUP) : (NT_MODE == 2 ? 1 : 0))
#ifndef REP_PRO
#define REP_PRO 1
#endif
#ifndef REP_MIX
#define REP_MIX 1
#endif
#ifndef REP_GEGLU
#define REP_GEGLU 1
#endif
#ifndef REP_TR
#define REP_TR 1
#endif
#ifndef REP_GEMM
#define REP_GEMM 1
#endif
#ifndef MK_MULTI_LAUNCH
#define MK_MULTI_LAUNCH 0
#endif
__global__ __launch_bounds__(512, 2) void mk_fwd(Params P) {
    extern __shared__ __attribute__((aligned(16))) unsigned char smem[];
    float* lds = (float*)smem;
    cg::grid_group grid = cg::this_grid();
    const int wid_s = __builtin_amdgcn_readfirstlane((int)threadIdx.x >> 6);
    unsigned xst0 = 0u, xst1 = 0u;
    const XcdBarrier xb = xcd_barrier_post((unsigned*)(P.ws + WS_BAR), nullptr);
    bf16_t* H = (bf16_t*)(P.ws + WS_H);
    bf16_t* XB = (bf16_t*)(P.ws + WS_XB);
    for (int ph = P.ph_lo; ph < P.ph_hi; ++ph) {
        if (ph > P.ph_lo) { if (ph == 1) grid.sync(); else {
#ifdef REP_BAR
 xcd_barrier(xb, xst0, xst1, wid_s == 0 && lane_now() == 0); xst0 = __builtin_amdgcn_readfirstlane(xst0); xst1 = __builtin_amdgcn_readfirstlane(xst1);
#endif
 xcd_barrier(xb, xst0, xst1, wid_s == 0 && lane_now() == 0); xst0 = __builtin_amdgcn_readfirstlane(xst0); xst1 = __builtin_amdgcn_readfirstlane(xst1); } }
        bool is_gemm = false; const bf16_t* gA = nullptr; const bf16_t* gB = nullptr; int gM = 0, gN = 0, gK = 0, gld = 0, gsplit = 0; size_t gstride = 0; bf16_t* gO = nullptr;
        if (ph == 0) {
#ifndef NO_PRO
 for (int rep = 0; rep < REP_PRO; ++rep) { ph_tconv(P, lds, wid_s); ph_fold(P, lds, wid_s); ph_mod(P, lds, wid_s); ph_tw(P, wid_s); ph_fh2(P, lds, wid_s); }
#endif
 }
        else if (ph == 1) { ph_h3t(P, 0, lds, wid_s); ph_resnorm<0, 0>(P.in[I_X], nullptr, nullptr, nullptr, nullptr, nullptr, P.in[I_GMPRE], modp(P, 0, 1), modp(P, 0, 0), H, wid_s); }
        else if (ph == 2) {
#ifndef NO_KF
 ph_kf(P, 0, lds, wid_s);
#endif
 }
        else {
            const int l = (ph - 3) / 12, k = (ph - 3) % 12;
            if (k == 0) { is_gemm = true; gA = wbf(P, l, WL_WIN); gB = H; gM = NPT; gN = NTOK; gK = DM; gO = (bf16_t*)(P.ws + WS_PT); gld = SEQ; gsplit = SEQ; gstride = (size_t)NPT * SEQ; }
            else if (k == 1) {
#ifndef NO_MIX
 for (int rep = 0; rep < REP_MIX; ++rep) ph_mix(P, l, lds, wid_s);
#endif
 }
            else if (k == 2) { for (int rep = 0; rep < REP_TR; ++rep) { ph_transpose(P, lds, wid_s); if (l + 1 < DEPTH) ph_h3t(P, l + 1, lds, wid_s); } }
            else if (k == 3) { is_gemm = true; gA = (const bf16_t*)(P.ws + WS_Y); gB = wbf(P, l, WL_WOUT); gM = NTOK; gN = DM; gK = DM; gO = (bf16_t*)(P.ws + WS_YO); gld = DM; }
            else if (k == 4) {
                if (l == 0) ph_resnorm<0, 1>(P.in[I_X], XB, (const bf16_t*)(P.ws + WS_YO), (const bf16_t*)(P.ws + WS_YO) + (size_t)HTOK * DM, P.in[I_GMPOST] + l * DM, modp(P, l, 2), P.in[I_GFPRE] + l * DM, modp(P, l, 4), modp(P, l, 3), H, wid_s);
                else ph_resnorm<1, 1>(XB, XB, (const bf16_t*)(P.ws + WS_YO), (const bf16_t*)(P.ws + WS_YO) + (size_t)HTOK * DM, P.in[I_GMPOST] + l * DM, modp(P, l, 2), P.in[I_GFPRE] + l * DM, modp(P, l, 4), modp(P, l, 3), H, wid_s);

#ifndef NO_KF
 if (l + 1 < DEPTH) ph_kf(P, l + 1, lds, wid_s);
#endif
 }
            else if (k == 5 || k == 8) { const int hf = (k == 8); is_gemm = true; gA = H + (size_t)hf * HTOK * DM; gB = wbf(P, l, WL_WUP); gM = HTOK; gN = DUP; gK = DM; gO = (bf16_t*)(P.ws + WS_U); gld = DUP; }
            else if (k == 6 || k == 9) {
#ifndef NO_GEGLU
 for (int rep = 0; rep < REP_GEGLU; ++rep) ph_geglu(P, l, wid_s);
#endif
 }
            else if (k == 7 || k == 10) { const int hf = (k == 10); is_gemm = true; gA = (const bf16_t*)(P.ws + WS_G); gB = wbf(P, l, WL_WDN); gM = HTOK; gN = DM; gK = DFF; gO = (bf16_t*)(P.ws + (hf ? WS_YD1 : WS_YD0)); gld = DM; }
            else { const bool more = (l + 1 < DEPTH);
                if (more) ph_resnorm<1, 1>(XB, XB, (const bf16_t*)(P.ws + WS_YD0), (const bf16_t*)(P.ws + WS_YD1), P.in[I_GFPOST] + l * DM, modp(P, l, 5), P.in[I_GMPRE] + (l + 1) * DM, modp(P, l + 1, 1), modp(P, l + 1, 0), H, wid_s);
                else ph_resnorm<1, 0>(XB, P.out, (const bf16_t*)(P.ws + WS_YD0), (const bf16_t*)(P.ws + WS_YD1), P.in[I_GFPOST] + l * DM, modp(P, l, 5), nullptr, nullptr, nullptr, nullptr, wid_s); }
        }
        #ifndef NO_GEMM
        if (is_gemm) for (int rep = 0; rep < REP_GEMM; ++rep) {
            __syncthreads();
            pg8::Gemm g{gA, gB, gM, gN, gK}; pg8::StaticOrder S; S.init(gM, gN, (int)gridDim.x, (int)blockIdx.x);
            pg8::EpiBf16<0> E{gO, gld, nullptr, gsplit, gstride, NT_MASK(gld)};
            pg8::gemm_phase<pg8::EpiBf16<0>, pg8::StaticOrder, false>((PG8_LAS unsigned char*)smem, g, S, E, nullptr, wid_s);
            __syncthreads();
        }
#endif
    }
}

extern "C" void kernel_launch(void* const* d_in, const int* in_sizes, int n_in, void* d_out, int out_size, void* d_ws, size_t ws_size, hipStream_t stream) {
    static int grid = 0;
    if (grid == 0) {
        if (n_in != 24 || out_size != NTOK * DM || ws_size < WS_NEED) { fprintf(stderr, "kernel_launch: unexpected shapes (n_in %d out %d ws %zu need %zu)\n", n_in, out_size, ws_size, (size_t)WS_NEED); grid = -1; return; }
        int dev = 0, cus = 0, per_cu = 0;
        hipGetDevice(&dev); hipDeviceGetAttribute(&cus, hipDeviceAttributeMultiprocessorCount, dev);
        if (hipFuncSetAttribute((const void*)mk_fwd, hipFuncAttributeMaxDynamicSharedMemorySize, LDS_BYTES) != hipSuccess) { fprintf(stderr, "kernel_launch: hipFuncSetAttribute failed\n"); grid = -1; return; }
        hipOccupancyMaxActiveBlocksPerMultiprocessor(&per_cu, (const void*)mk_fwd, NTHR, LDS_BYTES);
        (void)hipGetLastError();
        if (per_cu < 1) fprintf(stderr, "kernel_launch: occupancy query says %d blocks per CU\n", per_cu);
        grid = cus > 0 ? cus : 256;
    }
    if (grid < 0) return;
    Params p{};
    for (int i = 0; i < 24; ++i) p.in[i] = (const float*)d_in[i];
    p.out = (float*)d_out; p.ws = (unsigned char*)d_ws;
#if MK_MULTI_LAUNCH
    for (int ph = 0; ph < N_PHASES; ++ph) { p.ph_lo = ph; p.ph_hi = ph + 1; hipLaunchKernelGGL(mk_fwd, dim3(grid), dim3(NTHR), LDS_BYTES, stream, p); }
#else
    p.ph_lo = 0; p.ph_hi = N_PHASES;
    if (hipMemsetAsync((unsigned char*)d_ws + WS_BAR, 0, XCD_BAR_WORDS * 4, stream) != hipSuccess) { fprintf(stderr, "kernel_launch: memset of the barrier words failed\n"); return; }
    void* args[] = {&p};
    hipError_t e = hipLaunchCooperativeKernel((const void*)mk_fwd, dim3(grid), dim3(NTHR), args, LDS_BYTES, stream);
    if (e != hipSuccess) fprintf(stderr, "cooperative launch failed: %s (grid %d)\n", hipGetErrorString(e), grid);
#endif
}
```

```cpp
#include <hip/hip_runtime.h>
#include <hip/hip_cooperative_groups.h>
#include <cstdio>
namespace cg = cooperative_groups;
#define MK_MULTI_LAUNCH 0
namespace pg8 {
#define PG8_LAS __attribute__((address_space(3)))
typedef unsigned short bf16_t;
typedef short bf16x8 __attribute__((ext_vector_type(8)));
typedef float f32x4 __attribute__((ext_vector_type(4)));
typedef unsigned u32x4 __attribute__((ext_vector_type(4)));
constexpr int BM = 256, BK = 64, HALF = 128, HTB = HALF * BK * 2  , STAGE_BYTES = 8 * HTB, NXCD = 8, WGM = 8;

__host__ __device__ __forceinline__ int lds_byte(int r, int c) { const int st = (r >> 4) * 2 + (c >> 5), rr = r & 15, cc = c & 31, ob = rr * 64 + cc * 2; return st * 1024 + (ob ^ (((ob >> 9) & 1) << 5)); }
__host__ __device__ __forceinline__ void stage_rc(int b, int& R, int& C) { const int st = b / 1024, sb = b % 1024, swz = sb ^ (((sb >> 9) & 1) << 5); R = (st >> 1) * 16 + swz / 64; C = (st & 1) * 32 + (swz % 64) / 2; }
__host__ __device__ __forceinline__ int perm32(int rho) { const int n = rho >> 4, i = rho & 15; return 8 * (i >> 2) + 4 * n + (i & 3); }

struct Unit { int pm, pn; };
struct Gemm { const bf16_t* A; const bf16_t* Bt; int M, N, K; };

struct StaticOrder {
    int nM, nN, nwg, G, c;
    __host__ __device__ void init(int M, int N, int G_, int c_) { nM = M / BM; nN = N / BM; nwg = nM * nN; G = G_; c = c_; }
    __host__ __device__ bool next(int i, Unit& u) const {
        const long L = (long)i * G + c; if (L >= nwg) return false;
        int wgid = (int)L; { const int q = nwg / NXCD, r = nwg % NXCD, xcd = wgid % NXCD, off = wgid / NXCD; wgid = (xcd < r ? xcd * (q + 1) : r * (q + 1) + (xcd - r) * q) + off; }
        const int nig = WGM * nN, gid = wgid / nig, fm = gid * WGM, gsz = (nM - fm) < WGM ? (nM - fm) : WGM;
        u.pm = fm + ((wgid % nig) % gsz); u.pn = (wgid % nig) / gsz; return true;
    }
    __device__ __forceinline__ void a_ready(const Unit&) const {}
    __device__ __forceinline__ void done(const Unit&) const {}
};
__device__ __forceinline__ unsigned cvt_pk_bf16(float lo, float hi) { unsigned r; asm volatile("v_cvt_pk_bf16_f32 %0, %1, %2" : "=v"(r) : "v"(lo), "v"(hi)); return r; }
typedef float f32x2 __attribute__((ext_vector_type(2)));
__device__ __forceinline__ f32x2 gelu_pk(f32x2 v) {
    const f32x2 av = __builtin_elementwise_abs(v), d = av * 0.2316418882f + 1.0f;
    f32x2 t; t.x = __builtin_amdgcn_rcpf(d.x); t.y = __builtin_amdgcn_rcpf(d.y);
    f32x2 q = t * 0.5307027145f + (-0.7265760135f); q = q * t + 0.7107068705f; q = q * t + (-0.142248368f); q = q * t + 0.127414796f; q = q * t;
    const f32x2 s = (v * v) * (-0.72134752044f);
    f32x2 e; e.x = __builtin_amdgcn_exp2f(s.x); e.y = __builtin_amdgcn_exp2f(s.y);
    const f32x2 m = v * (q * e), r = v - m;
    f32x2 o; o.x = v.x < 0.f ? m.x : r.x; o.y = v.y < 0.f ? m.y : r.y; return o;
}

struct EpiF32 {
    static constexpr bool PERM = false, AFTER_DRAIN = false;
    float* C; int ldc; const float* bias;
    __device__ __forceinline__ void operator()(const f32x4 (&acc)[2][2][4][2], const Unit& u, int wr, int wc, int fr, int fq) const {
        const int row0 = u.pm * BM + wr * 64 + fr, col0 = u.pn * BM + wc * 32 + 4 * fq;
        f32x4 bv[2][2];
#pragma unroll
        for (int bj = 0; bj < 2; ++bj)
#pragma unroll
            for (int n = 0; n < 2; ++n) bv[bj][n] = bias ? *(const f32x4*)(bias + col0 + bj * HALF + n * 16) : (f32x4){0.f, 0.f, 0.f, 0.f};
#pragma unroll
        for (int ai = 0; ai < 2; ++ai)
#pragma unroll
            for (int m = 0; m < 4; ++m) { float* rowp = C + (size_t)(row0 + ai * HALF + m * 16) * ldc + col0;
#pragma unroll
                for (int bj = 0; bj < 2; ++bj)
#pragma unroll
                    for (int n = 0; n < 2; ++n) *(f32x4*)(rowp + bj * HALF + n * 16) = acc[ai][bj][m][n] + bv[bj][n]; }
    }
};
template <int ACT  > struct EpiBf16 {
    static constexpr bool PERM = true, AFTER_DRAIN = false;
    bf16_t* O; int ldc; const float* bias; int split_cols; size_t split_stride; int nt;
    __device__ __forceinline__ void operator()(const f32x4 (&acc)[2][2][4][2], const Unit& u, int wr, int wc, int fr, int fq) const {
        const int row0 = u.pm * BM + wr * 64 + fr; int colt = u.pn * BM; bf16_t* base = O;
        if (split_cols) { const int t = colt / split_cols; base += (size_t)t * split_stride; colt -= t * split_cols; }
        const int col0 = colt + wc * 32 + 8 * fq, bcol0 = u.pn * BM + wc * 32 + 8 * fq;
        f32x4 bv[2][2];
#pragma unroll
        for (int bj = 0; bj < 2; ++bj)
#pragma unroll
            for (int n = 0; n < 2; ++n) bv[bj][n] = bias ? *(const f32x4*)(bias + bcol0 + bj * HALF + 4 * n) : (f32x4){0.f, 0.f, 0.f, 0.f};
#pragma unroll
        for (int ai = 0; ai < 2; ++ai)
#pragma unroll
            for (int m = 0; m < 4; ++m) { bf16_t* rowp = base + (size_t)(row0 + ai * HALF + m * 16) * ldc + col0;
#pragma unroll
                for (int bj = 0; bj < 2; ++bj) { f32x4 v0 = acc[ai][bj][m][0] + bv[bj][0], v1 = acc[ai][bj][m][1] + bv[bj][1];
                    if (ACT == 1) { f32x2 a = gelu_pk((f32x2){v0[0], v0[1]}), b = gelu_pk((f32x2){v0[2], v0[3]}), c = gelu_pk((f32x2){v1[0], v1[1]}), d = gelu_pk((f32x2){v1[2], v1[3]});
                        v0 = (f32x4){a.x, a.y, b.x, b.y}; v1 = (f32x4){c.x, c.y, d.x, d.y}; }
                    if (ACT == 2) {
#pragma unroll
                        for (int j = 0; j < 4; ++j) { v0[j] = 0.5f * v0[j] * (1.0f + erff(v0[j] * 0.70710678f)); v1[j] = 0.5f * v1[j] * (1.0f + erff(v1[j] * 0.70710678f)); } }
                    u32x4 w; w.x = cvt_pk_bf16(v0[0], v0[1]); w.y = cvt_pk_bf16(v0[2], v0[3]); w.z = cvt_pk_bf16(v1[0], v1[1]); w.w = cvt_pk_bf16(v1[2], v1[3]);
                    if (nt) __builtin_nontemporal_store(w, (u32x4*)(rowp + bj * HALF)); else *(u32x4*)(rowp + bj * HALF) = w; } }
    }
};
template <class Epi, class Sched, bool STAMP = false>
__device__ __forceinline__ void gemm_phase(PG8_LAS unsigned char* lds, const Gemm g, const Sched& S, const Epi& E, unsigned long long* stamps, const int wid_s) {
    int tid_; asm volatile("v_mbcnt_lo_u32_b32 %0, -1, 0\n\tv_mbcnt_hi_u32_b32 %0, -1, %0" : "=v"(tid_)); tid_ += wid_s * 64; const int tid = tid_, wid = __builtin_amdgcn_readfirstlane(tid >> 6), lane = tid & 63, wr = wid >> 2, wc = wid & 3, fr = lane & 15, fq = lane >> 4;
    const int K = g.K, nt = K / BK;
    int ts_lo = 0, ts_hi = 0, nts = 0; const unsigned long long rt_entry = STAMP ? (unsigned long long)wall_clock64() : 0ull;
#define PG8_STAMP() do { if (STAMP && wid == 0 && nts < 64) { const unsigned long long _c = (unsigned long long)clock64(); \
        ts_lo = (lane == nts) ? (int)(unsigned)_c : ts_lo; ts_hi = (lane == nts) ? (int)(unsigned)(_c >> 32) : ts_hi; ++nts; } } while (0)
    PG8_STAMP();
    unsigned voffA[2], voffB[2];
#pragma unroll
    for (int i = 0; i < 2; ++i) { int R, C; stage_rc(tid * 16 + i * 8192, R, C); const int Rb = Epi::PERM ? ((R & ~31) + perm32(R & 31)) : R;
        voffA[i] = (unsigned)(R * K + C) * 2u; voffB[i] = (unsigned)(Rb * K + C) * 2u; }
    const size_t kstep = (size_t)(BK * 2);
    const size_t hstep = (size_t)HALF * K * 2;
    const size_t tstep = 2 * hstep;
    const unsigned ldsw = (unsigned)wid * 1024u;
    const int aoff = lds_byte(wr * 64 + fr, fq * 8), boff = lds_byte(wc * 32 + fr, fq * 8);
#define PG8_SA(b, h) (((b) * 2 + (h)) * HTB)
#define PG8_SB(b, h) ((4 + (b) * 2 + (h)) * HTB)
#define PG8_STAGE(bufoff, gbase, voff) do { _Pragma("unroll") for (int _i = 0; _i < 2; ++_i) \
        __builtin_amdgcn_global_load_lds((const unsigned*)((const char*)(gbase) + (voff)[_i]), (PG8_LAS unsigned*)(lds + (bufoff) + ldsw + _i * 8192), 16, 0, 0); } while (0)
#define PG8_LDA(dst, b, h) do { _Pragma("unroll") for (int m = 0; m < 4; ++m) _Pragma("unroll") for (int k = 0; k < 2; ++k) dst[m][k] = *(const PG8_LAS bf16x8*)(lds + PG8_SA(b, h) + aoff + m * 2048 + k * 1024); } while (0)
#define PG8_LDB(dst, b, h) do { _Pragma("unroll") for (int n = 0; n < 2; ++n) _Pragma("unroll") for (int k = 0; k < 2; ++k) dst[n][k] = *(const PG8_LAS bf16x8*)(lds + PG8_SB(b, h) + boff + n * 2048 + k * 1024); } while (0)
#define PG8_MMA(ai, bj, At, Bt) do { __builtin_amdgcn_s_setprio(1); _Pragma("unroll") for (int m = 0; m < 4; ++m) _Pragma("unroll") for (int n = 0; n < 2; ++n) _Pragma("unroll") for (int k = 0; k < 2; ++k) \
        acc[ai][bj][m][n] = __builtin_amdgcn_mfma_f32_16x16x32_bf16(Bt[n][k], At[m][k], acc[ai][bj][m][n], 0, 0, 0); __builtin_amdgcn_s_setprio(0); } while (0)
#define PG8_WAIT_V(n) asm volatile("s_waitcnt vmcnt(" #n ")" ::: "memory")
#define PG8_WAIT_L(n) asm volatile("s_waitcnt lgkmcnt(" #n ")" ::: "memory")
#define PG8_BAR __builtin_amdgcn_s_barrier()
#define PG8_SCHED __builtin_amdgcn_sched_barrier(0)
    Unit cur, nxt; int ui = 0;
    if (!S.next(0, cur)) return;
    f32x4 acc[2][2][4][2];
#pragma unroll
    for (int a = 0; a < 2; ++a)
#pragma unroll
        for (int b = 0; b < 2; ++b)
#pragma unroll
            for (int m = 0; m < 4; ++m)
#pragma unroll
                for (int n = 0; n < 2; ++n) acc[a][b][m][n] = (f32x4){0.f, 0.f, 0.f, 0.f};
    bf16x8 At[4][2], B0[2][2], B1[2][2];
    const char* cA = (const char*)g.A + (size_t)cur.pm * tstep; const char* cB = (const char*)g.Bt + (size_t)cur.pn * tstep;
    S.a_ready(cur);
    PG8_STAGE(PG8_SB(0, 0), cB, voffB); PG8_STAGE(PG8_SA(0, 0), cA, voffA); PG8_STAGE(PG8_SB(0, 1), cB + hstep, voffB); PG8_STAGE(PG8_SA(0, 1), cA + hstep, voffA);
    if (wr == 1) PG8_BAR;
    PG8_WAIT_V(4); PG8_BAR;
    PG8_STAGE(PG8_SB(1, 0), cB + kstep, voffB); PG8_STAGE(PG8_SA(1, 0), cA + kstep, voffA); PG8_STAGE(PG8_SB(1, 1), cB + hstep + kstep, voffB);
    PG8_WAIT_V(6); PG8_BAR;
    PG8_STAMP();
    for (;;) {
        const bool has_next = S.next(ui + 1, nxt);
        const char* nA = has_next ? (const char*)g.A + (size_t)nxt.pm * tstep : cA; const char* nB = has_next ? (const char*)g.Bt + (size_t)nxt.pn * tstep : cB;
        for (int t = 0; t < nt; t += 2) {
            const bool last = (t == nt - 2);
            const char* a1 = cA + (size_t)(t + 1) * kstep;
            const char* a2 = last ? nA : cA + (size_t)(t + 2) * kstep; const char* b2 = last ? nB : cB + (size_t)(t + 2) * kstep;
            const char* a3 = a2 + kstep; const char* b3 = b2 + kstep;
            if (last && has_next) S.a_ready(nxt);
            PG8_LDB(B0, 0, 0); PG8_SCHED; PG8_LDA(At, 0, 0); PG8_STAGE(PG8_SA(1, 1), a1 + hstep, voffA);
            PG8_WAIT_L(8); PG8_BAR; PG8_WAIT_L(0); PG8_MMA(0, 0, At, B0); PG8_BAR; PG8_SCHED;
            PG8_LDB(B1, 0, 1); PG8_STAGE(PG8_SB(0, 0), b2, voffB);
            PG8_BAR; PG8_WAIT_L(0); PG8_MMA(0, 1, At, B1); PG8_BAR;
            PG8_LDA(At, 0, 1); PG8_STAGE(PG8_SA(0, 0), a2, voffA);
            PG8_BAR; PG8_WAIT_L(0); PG8_MMA(1, 0, At, B0); PG8_BAR; PG8_SCHED;
            PG8_STAGE(PG8_SB(0, 1), b2 + hstep, voffB);
            PG8_WAIT_V(6); PG8_BAR; PG8_MMA(1, 1, At, B1); PG8_BAR;
            PG8_LDB(B0, 1, 0); PG8_SCHED; PG8_LDA(At, 1, 0); PG8_STAGE(PG8_SA(0, 1), a2 + hstep, voffA);
            PG8_WAIT_L(8); PG8_BAR; PG8_WAIT_L(0); PG8_MMA(0, 0, At, B0); PG8_BAR; PG8_SCHED;
            PG8_LDB(B1, 1, 1); PG8_STAGE(PG8_SB(1, 0), b3, voffB);
            PG8_BAR; PG8_WAIT_L(0); PG8_MMA(0, 1, At, B1); PG8_BAR;
            PG8_LDA(At, 1, 1); PG8_STAGE(PG8_SA(1, 0), a3, voffA);
            PG8_BAR; PG8_WAIT_L(0); PG8_MMA(1, 0, At, B0); PG8_BAR; PG8_SCHED;
            PG8_STAGE(PG8_SB(1, 1), b3 + hstep, voffB);
            PG8_WAIT_V(6); PG8_BAR; PG8_MMA(1, 1, At, B1); PG8_BAR;
        }
        PG8_STAMP();
        if constexpr (!Epi::AFTER_DRAIN) { E(acc, cur, wr, wc, fr, fq); S.done(cur); }
        PG8_STAMP();
        if (!has_next) break;
#pragma unroll
        for (int a = 0; a < 2; ++a)
#pragma unroll
            for (int b = 0; b < 2; ++b)
#pragma unroll
                for (int m = 0; m < 4; ++m)
#pragma unroll
                    for (int n = 0; n < 2; ++n) acc[a][b][m][n] = (f32x4){0.f, 0.f, 0.f, 0.f};
        cur = nxt; cA = nA; cB = nB; ++ui;
    }
    PG8_WAIT_V(0);
    if (wr == 0) PG8_BAR;
    PG8_BAR;
    if constexpr (Epi::AFTER_DRAIN) { E.fused(acc, cur, wr, wc, fr, fq, lds, wid, lane); S.done(cur); }
    PG8_STAMP();
    if (STAMP && wid == 0) { stamps[lane] = lane < nts ? (((unsigned long long)(unsigned)ts_hi << 32) | (unsigned)ts_lo) : 0ull;
        if (lane == 62) stamps[62] = rt_entry; if (lane == 63) stamps[63] = (unsigned long long)wall_clock64(); }
#undef PG8_STAMP
#undef PG8_SA
#undef PG8_SB
#undef PG8_STAGE
#undef PG8_LDA
#undef PG8_LDB
#undef PG8_MMA
#undef PG8_WAIT_V
#undef PG8_WAIT_L
#undef PG8_BAR
#undef PG8_SCHED
}
}
#define XB_TMO      128
#define XB_XCNT(j)  (256  + 64 * (j))
#define XB_XSUB(j)  (1280 + 64 * (j))
#define XB_XGEN(j)  (2304 + 64 * (j))
#define XB_TOP      3328
#define XB_TOPGEN   3392
#define XCD_BAR_WORDS 3456
#define XB_SPIN_CAP (1u << 18)
#define LAS __attribute__((address_space(3)))

__device__ __forceinline__ unsigned xb_ld(unsigned* p)              { return __hip_atomic_load(p, __ATOMIC_RELAXED, __HIP_MEMORY_SCOPE_AGENT); }
__device__ __forceinline__ unsigned xb_add(unsigned* p, unsigned v) { return __hip_atomic_fetch_add(p, v, __ATOMIC_RELAXED, __HIP_MEMORY_SCOPE_AGENT); }
__device__ __forceinline__ unsigned xb_xcc_id() { return (unsigned)__builtin_amdgcn_s_getreg((3 << 11) | 20) & 0xFu; }
#define XB_SPIN(cond, bar) do { unsigned _sp = 0; while (cond) { __builtin_amdgcn_s_sleep(1); \
    if ((++_sp & 255u) == 0u) { if (xb_ld(&(bar)[XB_TMO])) break; if (_sp > XB_SPIN_CAP) { atomicAdd(&(bar)[XB_TMO], 1u); break; } } } } while (0)

struct XcdBarrier {
    unsigned* bar; unsigned x;
    volatile LAS unsigned* st;
};

__device__ __forceinline__ XcdBarrier xcd_barrier_post(unsigned* bar, volatile LAS unsigned* st) {
    XcdBarrier b; b.bar = bar; b.x = xb_xcc_id(); b.st = st;
    if (threadIdx.x == 0) (void)xb_add(&bar[XB_XCNT(b.x)], 1u);
    return b;
}
__device__ __forceinline__ void xcd_barrier_complete(unsigned* bar, unsigned x, unsigned& nloc, unsigned& nx) {
    const unsigned G = gridDim.x * gridDim.y * gridDim.z;
    unsigned sum, cnt, mine, sp = 0u;
    for (;;) {
        sum = 0u; cnt = 0u; mine = 0u;
#pragma unroll
        for (unsigned j = 0; j < 16; ++j) { const unsigned c = xb_ld(&bar[XB_XCNT(j)]); sum += c; cnt += (c > 0u) ? 1u : 0u; mine = (j == x) ? c : mine; }
        if (sum == G) break;
        __builtin_amdgcn_s_sleep(1);
        if ((++sp & 255u) == 0u) { if (xb_ld(&bar[XB_TMO])) break; if (sp > XB_SPIN_CAP) { atomicAdd(&bar[XB_TMO], 1u); break; } }
    }
    nloc = mine > 0u ? mine : 1u; nx = cnt > 0u ? cnt : 1u;
}

__device__ __forceinline__ void xcd_barrier(const XcdBarrier& b, unsigned& st0, unsigned& st1, const bool t0  ) {
    asm volatile("s_waitcnt vmcnt(0)" ::: "memory");
    __syncthreads();
    if (t0) {
        unsigned* bar = b.bar;
        __builtin_amdgcn_s_waitcnt(0);
        unsigned nloc = st0, nx = st1;
        if (nloc == 0u) { xcd_barrier_complete(bar, b.x, nloc, nx); st0 = nloc; st1 = nx; }
        const unsigned old = xb_add(&bar[XB_XSUB(b.x)], 1u);
        const unsigned gen = old / nloc;
        if (old + 1u == (gen + 1u) * nloc) {
            __builtin_amdgcn_fence(__ATOMIC_RELEASE, "agent");
            asm volatile("s_waitcnt vmcnt(0)" ::: "memory");
            const unsigned og = xb_add(&bar[XB_TOP], 1u);
            const unsigned tg = og / nx;
            if (og + 1u == (tg + 1u) * nx) xb_add(&bar[XB_TOPGEN], 1u);
            else XB_SPIN(xb_ld(&bar[XB_TOPGEN]) == tg, bar);
            __builtin_amdgcn_fence(__ATOMIC_ACQUIRE, "agent");
            xb_add(&bar[XB_XGEN(b.x)], 1u);
            asm volatile("s_waitcnt vmcnt(0)" ::: "memory");
        } else {
            XB_SPIN(xb_ld(&bar[XB_XGEN(b.x)]) == gen, bar);
            __builtin_amdgcn_fence(__ATOMIC_ACQUIRE, "agent");
            asm volatile("s_waitcnt vmcnt(0)" ::: "memory");
        }
    }
    __syncthreads();
}

using pg8::bf16_t;
typedef float f32x4v __attribute__((ext_vector_type(4)));
typedef float f32x2v __attribute__((ext_vector_type(2)));
typedef unsigned u32x4v __attribute__((ext_vector_type(4)));
typedef unsigned u32x2v __attribute__((ext_vector_type(2)));

constexpr int DM = 1024, NB = 16, SEQ = 4096, DEPTH = 4, NTOK = NB * SEQ;
constexpr int DH = 512, NPT = 2560, DFF = 2816, DUP = 5632, HTOK = NTOK / 2;
constexpr int NTHR = 512;

constexpr size_t WL_WIN = 0, WL_WOUT = WL_WIN + (size_t)NPT * DM, WL_WUP = WL_WOUT + (size_t)DM * DM, WL_WDN = WL_WUP + (size_t)DUP * DM, WL_END = WL_WDN + (size_t)DM * DFF;
constexpr size_t WS_WBF = 0;
constexpr size_t WS_KF = WS_WBF + WL_END * 2 * DEPTH;
constexpr size_t WS_H3T = WS_KF + (size_t)2 * DH * SEQ * 8;
constexpr size_t WS_FH2 = WS_H3T + (size_t)2048 * SEQ * 4;
constexpr size_t WS_MOD = WS_FH2 + (size_t)DEPTH * SEQ * 64 * 4;
constexpr size_t WS_TW = WS_MOD + (size_t)DEPTH * NB * 6144 * 4;
constexpr size_t WS_H = WS_TW + 8192 * 8;
constexpr size_t WS_BIG = WS_H + (size_t)NTOK * DM * 2;
constexpr size_t WS_PT = WS_BIG, WS_YT = WS_PT + (size_t)NB * NPT * SEQ * 2, WS_Y = WS_YT + (size_t)NTOK * DM * 2, WS_MIX_END = WS_Y + (size_t)NTOK * DM * 2;
constexpr size_t WS_YO = WS_PT;
constexpr size_t WS_U = WS_BIG, WS_G = WS_U + (size_t)HTOK * DUP * 2, WS_YD0 = WS_G + (size_t)HTOK * DFF * 2, WS_FFN_END = WS_YD0 + (size_t)HTOK * DM * 2;
constexpr size_t WS_YD1 = WS_U;
constexpr size_t WS_XB = WS_MIX_END > WS_FFN_END ? WS_MIX_END : WS_FFN_END;
constexpr size_t WS_BAR = WS_XB + (size_t)NTOK * DM * 2;
constexpr size_t WS_NEED = WS_BAR + XCD_BAR_WORDS * 4;

static_assert(WS_KF % 256 == 0 && WS_H % 256 == 0 && WS_BIG % 256 == 0 && WS_G % 256 == 0 && WS_YD0 % 256 == 0 && WS_XB % 256 == 0, "align");

enum { I_X = 0, I_C, I_ADAW, I_ADAB, I_GMPRE, I_GMPOST, I_WIN, I_SW, I_SB, I_FW1, I_FB1, I_FW2, I_FB2, I_FFREQ, I_FW3, I_HD, I_FNW, I_WOUT, I_GFPRE, I_GFPOST, I_WUP, I_DWW, I_DWB, I_WDOWN };
struct Params { const float* in[24]; float* out; unsigned char* ws; int ph_lo, ph_hi; };

__device__ __forceinline__ float bf2f(bf16_t v) { return __uint_as_float(((unsigned)v) << 16); }
__device__ __forceinline__ unsigned pack2(float lo, float hi) { unsigned r; asm("v_cvt_pk_bf16_f32 %0, %1, %2" : "=v"(r) : "v"(lo), "v"(hi)); return r; }
__device__ __forceinline__ bf16_t f2bf(float f) { return (bf16_t)(pack2(f, f) & 0xffffu); }
__device__ __forceinline__ int lane_now() { int l; asm volatile("v_mbcnt_lo_u32_b32 %0, -1, 0\n\tv_mbcnt_hi_u32_b32 %0, -1, %0" : "=v"(l)); return l; }
__device__ __forceinline__ int opaque_tid_(int wid_s) { return wid_s * 64 + lane_now(); }
#define opaque_tid() opaque_tid_(wid_s)
__device__ __forceinline__ float wave_sum(float v) {
#pragma unroll
    for (int o = 32; o >= 1; o >>= 1) v += __shfl_xor(v, o);
    return v;
}

template <class T> __device__ __forceinline__ void dft4(T& r0, T& i0, T& r1, T& i1, T& r2, T& i2, T& r3, T& i3) {
    const T s0r = r0 + r2, s0i = i0 + i2, s1r = r0 - r2, s1i = i0 - i2;
    const T s2r = r1 + r3, s2i = i1 + i3, s3r = r1 - r3, s3i = i1 - i3;
    r0 = s0r + s2r; i0 = s0i + s2i; r2 = s0r - s2r; i2 = s0i - s2i;
    r1 = s1r + s3i; i1 = s1i - s3r; r3 = s1r - s3i; i3 = s1i + s3r;
}
template <int K, class T> __device__ __forceinline__ void tw16(T& r, T& i) {
    if constexpr (K == 0) { }
    else if constexpr (K == 4) { const T t = r; r = i; i = -t; }
    else {
        constexpr float C[10] = {1.f, 0.92387953251128674f, 0.70710678118654752f, 0.38268343236508977f, 0.f, -0.38268343236508977f, -0.70710678118654752f, -0.92387953251128674f, -1.f, -0.92387953251128674f};
        constexpr float S[10] = {0.f, -0.38268343236508977f, -0.70710678118654752f, -0.92387953251128674f, -1.f, -0.92387953251128674f, -0.70710678118654752f, -0.38268343236508977f, 0.f, 0.38268343236508977f};
        const float c = C[K], s = S[K]; const T t = r * c - i * s; i = r * s + i * c; r = t;
    }
}
template <class T> __device__ __forceinline__ void dft16(T (&xr)[16], T (&xi)[16]) {
#pragma unroll
    for (int b = 0; b < 4; ++b) dft4(xr[b], xi[b], xr[4 + b], xi[4 + b], xr[8 + b], xi[8 + b], xr[12 + b], xi[12 + b]);
    tw16<1>(xr[5], xi[5]); tw16<2>(xr[6], xi[6]); tw16<3>(xr[7], xi[7]);
    tw16<2>(xr[9], xi[9]); tw16<4>(xr[10], xi[10]); tw16<6>(xr[11], xi[11]);
    tw16<3>(xr[13], xi[13]); tw16<6>(xr[14], xi[14]); tw16<9>(xr[15], xi[15]);
#pragma unroll
    for (int c = 0; c < 4; ++c) dft4(xr[4 * c], xi[4 * c], xr[4 * c + 1], xi[4 * c + 1], xr[4 * c + 2], xi[4 * c + 2], xr[4 * c + 3], xi[4 * c + 3]);
#pragma unroll
    for (int c = 0; c < 4; ++c)
#pragma unroll
        for (int d = c + 1; d < 4; ++d) { T t = xr[4 * c + d]; xr[4 * c + d] = xr[4 * d + c]; xr[4 * d + c] = t; t = xi[4 * c + d]; xi[4 * c + d] = xi[4 * d + c]; xi[4 * d + c] = t; }
}
constexpr int PBUF = 4096;
constexpr int LDS_MAIN = 2 * PBUF * 16;
constexpr int LDS_KF = LDS_MAIN;
__device__ __forceinline__ void fft4096_pk(f32x2v (&xr)[16], f32x2v (&xi)[16], f32x4v* buf, const int t, const f32x2v* __restrict__ TW) {
    dft16(xr, xi);
    __syncthreads();
    {
        f32x2v w1 = TW[2 * t]; asm volatile("" : "+v"(w1.x), "+v"(w1.y));
        float wr = w1.x, wi = w1.y;
        buf[t] = (f32x4v){xr[0].x, xr[0].y, xi[0].x, xi[0].y};
#pragma unroll
        for (int k = 1; k < 16; ++k) {
            const f32x2v r = xr[k], i = xi[k]; const f32x2v nr = r * wr - i * wi, ni = r * wi + i * wr;
            buf[k * 256 + t] = (f32x4v){nr.x, nr.y, ni.x, ni.y};
            if (k < 15) { const float n2 = wr * w1.x - wi * w1.y; wi = wr * w1.y + wi * w1.x; wr = n2; }
        }
    }
    __syncthreads();
    const int k1 = t >> 4, m2 = t & 15;
#pragma unroll
    for (int m = 0; m < 16; ++m) { const f32x4v v = buf[k1 * 256 + 16 * m + m2]; xr[m] = (f32x2v){v.x, v.y}; xi[m] = (f32x2v){v.z, v.w}; }
    __syncthreads();
    dft16(xr, xi);
    {
        f32x2v w1 = TW[32 * m2]; asm volatile("" : "+v"(w1.x), "+v"(w1.y));
        float wr = w1.x, wi = w1.y;
        buf[m2 * 256 + (k1 ^ (m2 & 7))] = (f32x4v){xr[0].x, xr[0].y, xi[0].x, xi[0].y};
#pragma unroll
        for (int j = 1; j < 16; ++j) {
            const f32x2v r = xr[j], i = xi[j]; const f32x2v nr = r * wr - i * wi, ni = r * wi + i * wr;
            buf[m2 * 256 + ((k1 + 16 * j) ^ (m2 & 7))] = (f32x4v){nr.x, nr.y, ni.x, ni.y};
            if (j < 15) { const float n2 = wr * w1.x - wi * w1.y; wi = wr * w1.y + wi * w1.x; wr = n2; }
        }
    }
    __syncthreads();
#pragma unroll
    for (int m = 0; m < 16; ++m) { const f32x4v v = buf[m * 256 + (t ^ (m & 7))]; xr[m] = (f32x2v){v.x, v.y}; xi[m] = (f32x2v){v.z, v.w}; }
    dft16(xr, xi);
}
__device__ __forceinline__ f32x2v w32(int j) {
    constexpr float C[16] = {1.f, 0.98078528040323043f, 0.92387953251128674f, 0.83146961230254524f, 0.70710678118654752f, 0.55557023301960218f, 0.38268343236508977f, 0.19509032201612825f, 0.f, -0.19509032201612825f, -0.38268343236508977f, -0.55557023301960218f, -0.70710678118654752f, -0.83146961230254524f, -0.92387953251128674f, -0.98078528040323043f};
    constexpr float S[16] = {0.f, -0.19509032201612825f, -0.38268343236508977f, -0.55557023301960218f, -0.70710678118654752f, -0.83146961230254524f, -0.92387953251128674f, -0.98078528040323043f, -1.f, -0.98078528040323043f, -0.92387953251128674f, -0.83146961230254524f, -0.70710678118654752f, -0.55557023301960218f, -0.38268343236508977f, -0.19509032201612825f};
    return (f32x2v){C[j], S[j]};
}
constexpr int LDS_BYTES = LDS_MAIN + 32768;
static_assert(LDS_MAIN >= pg8::STAGE_BYTES, "lds");
typedef _Float16 f16x4v __attribute__((ext_vector_type(4)));
__device__ __forceinline__ void kf_dma(const unsigned char* src, unsigned char* kfl, int tid) {
    const int w = __builtin_amdgcn_readfirstlane(tid >> 6), lane = tid & 63;
#pragma unroll
    for (int q = 0; q < 4; ++q)
        __builtin_amdgcn_global_load_lds((const unsigned*)(src + (w * 4 + q) * 1024 + lane * 16), (LAS unsigned*)(kfl + (w * 4 + q) * 1024), 16, 0, 0);
}
__device__ __forceinline__ bf16_t* wbf(const Params& P, int l, size_t off) { return (bf16_t*)(P.ws + WS_WBF) + (size_t)l * WL_END + off; }
__device__ __forceinline__ const float* modp(const Params& P, int l, int which) { return (const float*)(P.ws + WS_MOD) + (size_t)l * NB * 6144 + which * 1024; }

__device__ __forceinline__ void ph_tconv(const Params& P, float* tile, const int wid_s) {
    const int tid = opaque_tid();
    for (int it = blockIdx.x; it < DEPTH * 2752; it += gridDim.x) {
        const int l = it / 2752; int r = it % 2752;
        const float* src; int ldsrc, lddst, tk, tn; bf16_t* dst;
        if (r < 384) { src = P.in[I_WIN] + (size_t)l * DM * 2048; ldsrc = 2048; lddst = DM; tk = r / 24; tn = r % 24; dst = wbf(P, l, WL_WIN); }
        else if (r < 640) { r -= 384; src = P.in[I_WOUT] + (size_t)l * DM * DM; ldsrc = DM; lddst = DM; tk = r / 16; tn = r % 16; dst = wbf(P, l, WL_WOUT); }
        else if (r < 2048) { r -= 640; src = P.in[I_WUP] + (size_t)l * DM * DUP; ldsrc = DUP; lddst = DM; tk = r / 88; tn = r % 88; dst = wbf(P, l, WL_WUP); }
        else { r -= 2048; src = P.in[I_WDOWN] + (size_t)l * DFF * DM; ldsrc = DM; lddst = DFF; tk = r / 16; tn = r % 16; dst = wbf(P, l, WL_WDN); }
        { const int kk = tid >> 3, c8 = (tid & 7) * 8; const float* s = src + (size_t)(tk * 64 + kk) * ldsrc + tn * 64 + c8; const f32x4v v0 = *(const f32x4v*)s, v1 = *(const f32x4v*)(s + 4);
          float* t = tile + kk * 65 + c8; t[0] = v0.x; t[1] = v0.y; t[2] = v0.z; t[3] = v0.w; t[4] = v1.x; t[5] = v1.y; t[6] = v1.z; t[7] = v1.w; }
        __syncthreads();
        { const int nn = tid >> 3, k8 = (tid & 7) * 8; const float* t = tile + k8 * 65 + nn;
          *(u32x4v*)(dst + (size_t)(tn * 64 + nn) * lddst + tk * 64 + k8) = (u32x4v){pack2(t[0], t[65]), pack2(t[130], t[195]), pack2(t[260], t[325]), pack2(t[390], t[455])}; }
        __syncthreads();
    }
}
__device__ __forceinline__ void ph_fold(const Params& P, float* lds, const int wid_s) {
    const int tid = opaque_tid();
    float* CW = lds; float* SWm = lds + 4096; float* ct = lds + 8192; float* st = lds + 8192 + 64;
    float* Wl = lds + 8192 + 128;
    bf16_t* ot = (bf16_t*)(Wl + 128 * 65);
    for (int it = blockIdx.x; it < DEPTH * 64; it += gridDim.x) {
        const int l = it >> 6, g = (it >> 3) & 7, kc = it & 7;
        const float* Wg = P.in[I_FNW] + ((size_t)l * 8 + g) * 4096;
        if (tid < 64) { float s, c; sincospif((float)tid * (1.0f / 32.0f), &s, &c); ct[tid] = c; st[tid] = s; }
#pragma unroll
        for (int i = 0; i < 16; ++i) { const int idx = tid + 512 * i, kk = idx >> 6, c = idx & 63; Wl[kk * 65 + c] = P.in[I_WIN][((size_t)l * DM + kc * 128 + kk) * 2048 + 1536 + 64 * g + c]; }
        __syncthreads();
        for (int idx = tid; idx < 4096; idx += NTHR) { const int c = idx >> 6, d = idx & 63; float ac = 0.f, as = 0.f;
            for (int m = 0; m < 64; ++m) { const float w = Wg[m * 64 + d]; const int ph = (c * m) & 63; ac += ct[ph] * w; as += st[ph] * w; }
            CW[idx] = ac * (1.0f / 512.0f); SWm[idx] = as * (1.0f / 512.0f); }
        __syncthreads();
        { const int kk = tid & 127, dg = tid >> 7;
          f32x4v ac[4], as[4];
#pragma unroll
          for (int u = 0; u < 4; ++u) { ac[u] = (f32x4v){0.f, 0.f, 0.f, 0.f}; as[u] = (f32x4v){0.f, 0.f, 0.f, 0.f}; }
          for (int c = 0; c < 64; ++c) { const float w = Wl[kk * 65 + c];
#pragma unroll
              for (int u = 0; u < 4; ++u) { ac[u] += *(const f32x4v*)(CW + c * 64 + dg * 16 + u * 4) * w; as[u] += *(const f32x4v*)(SWm + c * 64 + dg * 16 + u * 4) * w; } }
#pragma unroll
          for (int u = 0; u < 4; ++u) { const int d = dg * 16 + u * 4;
              ot[(d + 0) * 136 + kk] = f2bf(ac[u].x); ot[(d + 1) * 136 + kk] = f2bf(ac[u].y); ot[(d + 2) * 136 + kk] = f2bf(ac[u].z); ot[(d + 3) * 136 + kk] = f2bf(ac[u].w);
              ot[(64 + d + 0) * 136 + kk] = f2bf(as[u].x); ot[(64 + d + 1) * 136 + kk] = f2bf(as[u].y); ot[(64 + d + 2) * 136 + kk] = f2bf(as[u].z); ot[(64 + d + 3) * 136 + kk] = f2bf(as[u].w); } }
        __syncthreads();
        bf16_t* WinT = wbf(P, l, WL_WIN);
#pragma unroll
        for (int i = 0; i < 4; ++i) { const int idx = tid + 512 * i, r = idx >> 4, q = idx & 15, which = r >> 6, d = r & 63;
            *(u32x4v*)(WinT + (size_t)(1536 + which * 512 + g * 64 + d) * DM + kc * 128 + q * 8) = *(const u32x4v*)(ot + r * 136 + q * 8); }
        __syncthreads();
    }
}
__device__ __forceinline__ void ph_mod(const Params& P, float* lds, const int wid_s) {
    const int tid = opaque_tid();
    float* cact = lds;
    float* red = lds + 16384;
    if ((int)blockIdx.x >= DEPTH * 96) return;
    for (int idx = tid; idx < NB * DM; idx += NTHR) { const int b = idx >> 10, k = idx & 1023; const float v = P.in[I_C][idx]; cact[k * 16 + b] = v / (1.0f + __expf(-v)); }
    __syncthreads();
    for (int it = blockIdx.x; it < DEPTH * 96; it += gridDim.x) {
        const int l = it / 96, n0 = (it % 96) * 64, ks = tid >> 6, nn = tid & 63;
        float acc[16];
#pragma unroll
        for (int b = 0; b < 16; ++b) acc[b] = 0.f;
        const float* w = P.in[I_ADAW] + ((size_t)l * DM + ks * 128) * 6144 + n0 + nn;
        for (int k = 0; k < 128; ++k) { const float wv = w[(size_t)k * 6144]; const f32x4v* cp = (const f32x4v*)(cact + (ks * 128 + k) * 16);
#pragma unroll
            for (int q = 0; q < 4; ++q) { const f32x4v cv = cp[q]; acc[4 * q] += cv.x * wv; acc[4 * q + 1] += cv.y * wv; acc[4 * q + 2] += cv.z * wv; acc[4 * q + 3] += cv.w * wv; } }
#pragma unroll
        for (int b = 0; b < 16; ++b) red[(ks * 64 + nn) * 16 + b] = acc[b];
        __syncthreads();
        for (int idx = tid; idx < 1024; idx += NTHR) { const int b = idx >> 6, n = idx & 63; float s = P.in[I_ADAB][(size_t)l * 6144 + n0 + n];
#pragma unroll
            for (int q = 0; q < 8; ++q) s += red[(q * 64 + n) * 16 + b];
            ((float*)(P.ws + WS_MOD))[((size_t)l * NB + b) * 6144 + n0 + n] = s; }
        __syncthreads();
    }
}
__device__ __forceinline__ void ph_tw(const Params& P, const int wid_s) {
    f32x2v* TW = (f32x2v*)(P.ws + WS_TW);
    const int tid = opaque_tid();
    for (int j = blockIdx.x * NTHR + tid; j < 8192; j += gridDim.x * NTHR) { float s, c; sincospif((float)j * (1.0f / 4096.0f), &s, &c); TW[j] = (f32x2v){c, -s}; }
}
__device__ __forceinline__ void ph_fh2(const Params& P, float* lds, const int wid_s) {
    const int tid = opaque_tid(), p = tid >> 6, j = tid & 63;
    float* z = lds;
    float* h1 = lds + 8 * 36;
    for (int it = blockIdx.x; it < DEPTH * 512; it += gridDim.x) {
        const int l = it >> 9, pos = (it & 511) * 8 + p;
        if (j < 33) { float v;
            if (j == 0) v = (float)pos / 4095.0f;
            else { const int bi = (j - 1) & 15; const float band = 1e-4f + (float)bi * ((15.0f - 1e-4f) / 15.0f); float s, c; sincospif((float)pos * band * (2.0f / 4096.0f), &s, &c); v = (j <= 16) ? c : -s; }
            z[p * 36 + j] = v; }
        __syncthreads();
        const float fr = P.in[I_FFREQ][l * 64 + j];
        { float a = P.in[I_FB1][l * 64 + j]; const float* w1 = P.in[I_FW1] + (size_t)l * 33 * 64 + j;
          for (int i = 0; i < 33; ++i) a += z[p * 36 + i] * w1[i * 64];
          h1[p * 64 + j] = sinf(fr * a); }
        __syncthreads();
        { float a = P.in[I_FB2][l * 64 + j]; const float* w2 = P.in[I_FW2] + (size_t)l * 64 * 64 + j;
          for (int i = 0; i < 64; ++i) a += h1[p * 64 + i] * w2[i * 64];
          ((float*)(P.ws + WS_FH2))[((size_t)l * SEQ + pos) * 64 + j] = sinf(fr * a); }
        __syncthreads();
    }
}
__device__ __forceinline__ void ph_h3t(const Params& P, int l, float* lds, const int wid_s) {
    const int tid = opaque_tid(), pq = tid & 31, cq = tid >> 5;
    float* AT = lds;
    float* Bs = lds + 64 * 132;
    const float* FH2 = (const float*)(P.ws + WS_FH2) + (size_t)l * SEQ * 64; const float* w3 = P.in[I_FW3] + (size_t)l * 64 * 2048; float* H3T = (float*)(P.ws + WS_H3T);
    for (int it = blockIdx.x; it < 32 * 16; it += gridDim.x) {
        const int p0 = (it & 31) * 128, c0 = (it >> 5) * 128;
#pragma unroll
        for (int i = 0; i < 16; ++i) { const int idx = tid + 512 * i; { const int r = idx >> 6, q = idx & 63; AT[q * 132 + r] = FH2[(size_t)(p0 + r) * 64 + q]; } { const int q = idx >> 7, cc = idx & 127; Bs[q * 128 + cc] = w3[(size_t)q * 2048 + c0 + cc]; } }
        __syncthreads();
        f32x4v acc[8];
#pragma unroll
        for (int j = 0; j < 8; ++j) acc[j] = (f32x4v){0.f, 0.f, 0.f, 0.f};
#pragma unroll 4
        for (int q = 0; q < 64; ++q) { const f32x4v a = *(const f32x4v*)(AT + q * 132 + pq * 4), b0 = *(const f32x4v*)(Bs + q * 128 + cq * 8), b1 = *(const f32x4v*)(Bs + q * 128 + cq * 8 + 4);
            acc[0] += a * b0.x; acc[1] += a * b0.y; acc[2] += a * b0.z; acc[3] += a * b0.w; acc[4] += a * b1.x; acc[5] += a * b1.y; acc[6] += a * b1.z; acc[7] += a * b1.w; }
#pragma unroll
        for (int j = 0; j < 8; ++j) *(f32x4v*)(H3T + (size_t)(c0 + cq * 8 + j) * SEQ + p0 + pq * 4) = acc[j];
        __syncthreads();
    }
}
__device__ __forceinline__ void ph_kf(const Params& P, int l, float* lds, const int wid_s) {
    const int tid = opaque_tid(), hh = tid >> 8, t = tid & 255;
    f32x4v* buf = (f32x4v*)lds + hh * PBUF; float* red = (float*)((f32x4v*)lds + hh * PBUF);
    const f32x2v* TW = (const f32x2v*)(P.ws + WS_TW); const float* H3T = (const float*)(P.ws + WS_H3T); f16x4v* KF = (f16x4v*)(P.ws + WS_KF);
    const float min_decay = -4.605170185988091f / 1.5f, max_decay = -4.605170185988091f / 0.3f;
    for (int it0 = blockIdx.x * 2; it0 < 2 * DH; it0 += gridDim.x * 2) {
        const int it = it0 + hh, n = it >> 9, c = it & 511;
        int tv = t; asm volatile("" : "+v"(tv));
        const float ad = fabsf(min_decay + (float)c * ((max_decay - min_decay) / 511.0f));
        const float* fw = H3T + (size_t)(n * 1024 + c) * SEQ; const float* bw = H3T + (size_t)(n * 1024 + 512 + c) * SEQ;
        float fr[16], br[16]; float l1 = 0.f;
#pragma unroll
        for (int j = 0; j < 16; ++j) { const int m = tv + 256 * j;
            const float f = fw[m] * __expf(-((float)m * (1.0f / 4095.0f)) * ad);
            const float b = (m == 0) ? 0.f : bw[SEQ - m] * __expf(-((float)(SEQ - m) * (1.0f / 4095.0f)) * ad);
            l1 += fabsf(f) + fabsf(b); fr[j] = f; br[j] = b; }
        l1 = wave_sum(l1);
        __syncthreads();
        if ((tid & 63) == 0) red[(tid >> 6) & 3] = l1;
        __syncthreads();
        const float tot = red[0] + red[1] + red[2] + red[3];
        const float sc = 1.0f / (tot + 1e-6f);
        f32x2v wt = TW[tv]; asm volatile("" : "+v"(wt.x), "+v"(wt.y));
        f32x2v xr[16], xi[16];
#pragma unroll
        for (int j = 0; j < 16; ++j) { const f32x2v wj = w32(j); const float wx = wt.x * wj.x - wt.y * wj.y, wy = wt.x * wj.y + wt.y * wj.x; const float s = (fr[j] + br[j]) * sc, d = (fr[j] - br[j]) * sc;
            xr[j] = (f32x2v){s, d * wx}; xi[j] = (f32x2v){0.f, d * wy}; }
        fft4096_pk(xr, xi, buf, tv, TW);
        const float dsk = P.in[I_HD][(size_t)l * 2 * DH + it];
        f16x4v* o = KF + (size_t)it * SEQ;
#pragma unroll
        for (int j = 0; j < 16; ++j) o[tv + 256 * j] = (f16x4v){(_Float16)(xr[j].x + dsk), (_Float16)(xr[j].y + dsk), (_Float16)xi[j].x, (_Float16)xi[j].y};
    }
    __syncthreads();
}
__device__ __forceinline__ void ld8f(const float* p, float (&f)[16], int o) { const f32x4v a = *(const f32x4v*)p, b = *(const f32x4v*)(p + 4); f[o] = a.x; f[o + 1] = a.y; f[o + 2] = a.z; f[o + 3] = a.w; f[o + 4] = b.x; f[o + 5] = b.y; f[o + 6] = b.z; f[o + 7] = b.w; }
__device__ __forceinline__ void un8(const u32x4v w, float (&f)[16], int o) {
    f[o] = __uint_as_float(w.x << 16); f[o + 1] = __uint_as_float(w.x & 0xffff0000u); f[o + 2] = __uint_as_float(w.y << 16); f[o + 3] = __uint_as_float(w.y & 0xffff0000u);
    f[o + 4] = __uint_as_float(w.z << 16); f[o + 5] = __uint_as_float(w.z & 0xffff0000u); f[o + 6] = __uint_as_float(w.w << 16); f[o + 7] = __uint_as_float(w.w & 0xffff0000u);
}
template <int XI, int XO>
__device__ __forceinline__ void ph_resnorm(const void* xin_, void* xout_, const bf16_t* y, const bf16_t* y_hi  , const float* gpost, const float* gate, const float* gnext, const float* scale, const float* shift, bf16_t* hout, const int wid_s) {
    constexpr int RW = 4;
    const int tid = opaque_tid(); const int lane = tid & 63, wv = tid >> 6;
    for (int row0 = (blockIdx.x * 8 + wv) * RW; row0 < NTOK; row0 += gridDim.x * 8 * RW) {
        const int b = row0 >> 12; float x[RW][16]; u32x4v yw[RW][2];
        const bf16_t* ysel = (row0 < HTOK) ? y : y_hi - (size_t)HTOK * DM;
#pragma unroll
        for (int r = 0; r < RW; ++r)
#pragma unroll
            for (int q = 0; q < 2; ++q) { const size_t off = (size_t)(row0 + r) * DM + q * 512 + lane * 8;
                if (XI) un8(__builtin_nontemporal_load((const u32x4v*)((const bf16_t*)xin_ + off)), x[r], q * 8);
                else { const f32x4v a = __builtin_nontemporal_load((const f32x4v*)((const float*)xin_ + off)), c = __builtin_nontemporal_load((const f32x4v*)((const float*)xin_ + off + 4));
                    x[r][q * 8] = a.x; x[r][q * 8 + 1] = a.y; x[r][q * 8 + 2] = a.z; x[r][q * 8 + 3] = a.w; x[r][q * 8 + 4] = c.x; x[r][q * 8 + 5] = c.y; x[r][q * 8 + 6] = c.z; x[r][q * 8 + 7] = c.w; }
                if (y) yw[r][q] = __builtin_nontemporal_load((const u32x4v*)(ysel + off)); }
        if (y) {
            float g[16], gt[16];
#pragma unroll
            for (int q = 0; q < 2; ++q) { ld8f(gpost + q * 512 + lane * 8, g, q * 8); ld8f(gate + (size_t)b * 6144 + q * 512 + lane * 8, gt, q * 8); }
#pragma unroll
            for (int e = 0; e < 16; ++e) g[e] *= gt[e];
#pragma unroll
            for (int r = 0; r < RW; ++r) {
                float yv[16]; un8(yw[r][0], yv, 0); un8(yw[r][1], yv, 8); float ss = 0.f;
#pragma unroll
                for (int e = 0; e < 16; ++e) ss += yv[e] * yv[e];
                ss = wave_sum(ss); const float rinv = rsqrtf(ss * (1.0f / 1024.0f) + 1e-6f);
#pragma unroll
                for (int e = 0; e < 16; ++e) x[r][e] += g[e] * (yv[e] * rinv);
#pragma unroll
                for (int q = 0; q < 2; ++q) { const size_t off = (size_t)(row0 + r) * DM + q * 512 + lane * 8; const float* xs = &x[r][q * 8];
                    if (XO) { const u32x4v w = (u32x4v){pack2(xs[0], xs[1]), pack2(xs[2], xs[3]), pack2(xs[4], xs[5]), pack2(xs[6], xs[7])}; __builtin_nontemporal_store(w, (u32x4v*)((bf16_t*)xout_ + off)); un8(w, x[r], q * 8); }
                    else { __builtin_nontemporal_store((f32x4v){xs[0], xs[1], xs[2], xs[3]}, (f32x4v*)((float*)xout_ + off)); __builtin_nontemporal_store((f32x4v){xs[4], xs[5], xs[6], xs[7]}, (f32x4v*)((float*)xout_ + off + 4)); } }
            }
        }
        if (hout) {
            float g[16], sc[16], sh[16];
#pragma unroll
            for (int q = 0; q < 2; ++q) { ld8f(gnext + q * 512 + lane * 8, g, q * 8); ld8f(scale + (size_t)b * 6144 + q * 512 + lane * 8, sc, q * 8); ld8f(shift + (size_t)b * 6144 + q * 512 + lane * 8, sh, q * 8); }
#pragma unroll
            for (int e = 0; e < 16; ++e) g[e] *= (sc[e] + 1.0f);
#pragma unroll
            for (int r = 0; r < RW; ++r) {
                float ss = 0.f;
#pragma unroll
                for (int e = 0; e < 16; ++e) ss += x[r][e] * x[r][e];
                ss = wave_sum(ss); const float rinv = rsqrtf(ss * (1.0f / 1024.0f) + 1e-6f);
#pragma unroll
                for (int q = 0; q < 2; ++q) { float hv[8];
#pragma unroll
                    for (int e = 0; e < 8; ++e) hv[e] = x[r][q * 8 + e] * rinv * g[q * 8 + e] + sh[q * 8 + e];
                    *(u32x4v*)(hout + (size_t)(row0 + r) * DM + q * 512 + lane * 8) = (u32x4v){pack2(hv[0], hv[1]), pack2(hv[2], hv[3]), pack2(hv[4], hv[5]), pack2(hv[6], hv[7])}; }
            }
        }
    }
}
__device__ __forceinline__ void stage_sconv(const bf16_t* PT, int col, int b0, float w0, float w1, float w2, float bs, float* gl, int t) {
    const int rsel = t >> 7, seg = t & 127;
#pragma unroll
    for (int q = 0; q < 2; ++q) {
        const int e0 = q * 2048 + seg * 16; const bf16_t* row = PT + ((size_t)(b0 + rsel) * NPT + col) * SEQ + e0;
        const u32x4v A = *(const u32x4v*)row, B = *(const u32x4v*)(row + 8);
        float e[18]; e[0] = e0 ? bf2f(row[-1]) : 0.f; e[17] = (e0 + 16 < SEQ) ? bf2f(row[16]) : 0.f;
        e[1] = __uint_as_float(A.x << 16); e[2] = __uint_as_float(A.x & 0xffff0000u); e[3] = __uint_as_float(A.y << 16); e[4] = __uint_as_float(A.y & 0xffff0000u);
        e[5] = __uint_as_float(A.z << 16); e[6] = __uint_as_float(A.z & 0xffff0000u); e[7] = __uint_as_float(A.w << 16); e[8] = __uint_as_float(A.w & 0xffff0000u);
        e[9] = __uint_as_float(B.x << 16); e[10] = __uint_as_float(B.x & 0xffff0000u); e[11] = __uint_as_float(B.y << 16); e[12] = __uint_as_float(B.y & 0xffff0000u);
        e[13] = __uint_as_float(B.z << 16); e[14] = __uint_as_float(B.z & 0xffff0000u); e[15] = __uint_as_float(B.w << 16); e[16] = __uint_as_float(B.w & 0xffff0000u);
        f32x4v* o = (f32x4v*)(gl + rsel * SEQ + e0);
#pragma unroll
        for (int u = 0; u < 4; ++u) { f32x4v v;
            v.x = bs + e[4 * u] * w0 + e[4 * u + 1] * w1 + e[4 * u + 2] * w2; v.y = bs + e[4 * u + 1] * w0 + e[4 * u + 2] * w1 + e[4 * u + 3] * w2;
            v.z = bs + e[4 * u + 2] * w0 + e[4 * u + 3] * w1 + e[4 * u + 4] * w2; v.w = bs + e[4 * u + 3] * w0 + e[4 * u + 4] * w1 + e[4 * u + 5] * w2; o[u] = v; }
    }
}
__device__ __forceinline__ void store_rows2(const float (&v0)[16], const float (&v1)[16], bf16_t* st, bf16_t* o0, bf16_t* o1, int tv) {
#pragma unroll
    for (int j = 0; j < 16; ++j) { const unsigned w = pack2(v0[j], v1[j]); st[tv + 256 * j] = (bf16_t)(w & 0xffffu); st[SEQ + tv + 256 * j] = (bf16_t)(w >> 16); }
    __syncthreads();
    const int r = tv >> 7, seg = tv & 127; bf16_t* o = r ? o1 : o0;
#pragma unroll
    for (int q = 0; q < 4; ++q) *(u32x4v*)(o + q * 1024 + seg * 8) = *(const u32x4v*)(st + r * SEQ + q * 1024 + seg * 8);
}
__device__ __forceinline__ void ph_mix(const Params& P, int l, float* lds, const int wid_s) {
    const int tid = opaque_tid(), hh = tid >> 8, t = tid & 255;
    f32x4v* buf = (f32x4v*)lds + hh * PBUF; float* gl = (float*)buf;
    const f32x2v* TW = (const f32x2v*)(P.ws + WS_TW); const unsigned char* KF = P.ws + WS_KF; unsigned char* kfl = (unsigned char*)lds + LDS_KF;
    const bf16_t* PT = (const bf16_t*)(P.ws + WS_PT); bf16_t* YT = (bf16_t*)(P.ws + WS_YT);
    const float* sw = P.in[I_SW] + (size_t)l * 3 * 1536; const float* sb = P.in[I_SB] + (size_t)l * 1536;
    if ((int)blockIdx.x * 2 < DH * 8) kf_dma(KF + (size_t)(blockIdx.x >> 2) * 32768, kfl, tid);
    for (int it0 = blockIdx.x * 2; it0 < DH * 8; it0 += gridDim.x * 2) {
        const int it = it0 + hh, c = it >> 3, bp = it & 7, b0 = 2 * bp;
        int tv = t; asm volatile("" : "+v"(tv));
        float zr[16], zi[16];
        __syncthreads();
        stage_sconv(PT, c, b0, sw[c], sw[1536 + c], sw[3072 + c], sb[c], gl, tv);
        __syncthreads();
#pragma unroll
        for (int j = 0; j < 16; ++j) { zr[j] = gl[tv + 256 * j]; zi[j] = gl[SEQ + tv + 256 * j]; }
#pragma unroll 1
        for (int n = 0; n < 2; ++n) {
            f32x2v wt = TW[tv]; asm volatile("" : "+v"(wt.x), "+v"(wt.y));
            f32x2v xr[16], xi[16];
#pragma unroll
            for (int j = 0; j < 16; ++j) { const f32x2v wj = w32(j); const float wx = wt.x * wj.x - wt.y * wj.y, wy = wt.x * wj.y + wt.y * wj.x;
                xr[j] = (f32x2v){zr[j], zr[j] * wx - zi[j] * wy}; xi[j] = (f32x2v){zi[j], zr[j] * wy + zi[j] * wx}; }
            fft4096_pk(xr, xi, buf, tv, TW);
#pragma unroll
            for (int j = 0; j < 16; ++j) asm volatile("" : "+v"(xr[j]), "+v"(xi[j]));
            asm volatile("s_waitcnt vmcnt(0)" ::: "memory"); __syncthreads();
#pragma unroll
            for (int j = 0; j < 16; ++j) { const f16x4v k = *(const f16x4v*)(kfl + (tv + 256 * j) * 8); const f32x2v kr = (f32x2v){(float)k.x, (float)k.y}, ki = (f32x2v){(float)k.z, (float)k.w};
                const f32x2v pr = xr[j] * kr - xi[j] * ki, pi = xr[j] * ki + xi[j] * kr; xr[j] = pr; xi[j] = -pi; }
            __syncthreads();
            { const int cn = (n == 0) ? c : ((it0 + (int)gridDim.x * 2) >> 3);
              if (n == 0 || it0 + (int)gridDim.x * 2 < DH * 8) kf_dma(KF + (size_t)((1 - n) * DH + cn) * 32768, kfl, tid); }
            fft4096_pk(xr, xi, buf, tv, TW);
            const int col = (n + 1) * DH + c;
            __syncthreads();
            stage_sconv(PT, col, b0, sw[col] * (1.0f / 8192.0f), sw[1536 + col] * (1.0f / 8192.0f), sw[3072 + col] * (1.0f / 8192.0f), sb[col] * (1.0f / 8192.0f), gl, tv);
            __syncthreads();
#pragma unroll
            for (int j = 0; j < 16; ++j) { const int m = tv + 256 * j; const f32x2v wj = w32(j); const float wx = wt.x * wj.x - wt.y * wj.y, wy = wt.x * wj.y + wt.y * wj.x;
                const float er = xr[j].x, ei = -xi[j].x, orr = xr[j].y, oi = -xi[j].y;
                const float cr = er + (orr * wx + oi * wy), ci = ei + (oi * wx - orr * wy);
                zr[j] = gl[m] * cr; zi[j] = gl[SEQ + m] * ci; }
        }
        bf16_t* o0 = YT + ((size_t)b0 * DM + c) * SEQ;
        store_rows2(zr, zi, (bf16_t*)(gl + 2 * SEQ), o0, o0 + (size_t)DM * SEQ, tv);
    }
#ifndef REP_FNET
#define REP_FNET 1
#endif
    for (int rep = 0; rep < REP_FNET; ++rep)
    for (int it0 = blockIdx.x * 2; it0 < NB * DH / 2; it0 += gridDim.x * 2) {
        const int s = 2 * (it0 + hh), b = s >> 9, ch = s & 511;
        int tv = t; asm volatile("" : "+v"(tv));
        const bf16_t* ra = PT + ((size_t)b * NPT + 1536 + ch) * SEQ; const bf16_t* rb = PT + ((size_t)b * NPT + 2048 + ch) * SEQ;
        bf16_t* sta = (bf16_t*)gl; bf16_t* stb = sta + 2 * SEQ;
        __syncthreads();
        { u32x4v va[4], vb[4];
#pragma unroll
          for (int q = 0; q < 4; ++q) { va[q] = *(const u32x4v*)(ra + (q * 256 + tv) * 8); vb[q] = *(const u32x4v*)(rb + (q * 256 + tv) * 8); }
#pragma unroll
          for (int q = 0; q < 4; ++q) { *(u32x4v*)(sta + (q * 256 + tv) * 8) = va[q]; *(u32x4v*)(stb + (q * 256 + tv) * 8) = vb[q]; } }
        __syncthreads();
        f32x2v xr[16], xi[16];
#pragma unroll
        for (int j = 0; j < 16; ++j) { const int m = tv + 256 * j; xr[j] = (f32x2v){bf2f(sta[m]), bf2f(sta[SEQ + m])}; xi[j] = (f32x2v){-bf2f(stb[m]), -bf2f(stb[SEQ + m])}; }
        fft4096_pk(xr, xi, buf, tv, TW);
        float o0v[16], o1v[16];
#pragma unroll
        for (int j = 0; j < 16; ++j) { o0v[j] = xr[j].x; o1v[j] = xr[j].y; }
        __syncthreads();
        bf16_t* o = YT + ((size_t)b * DM + 512 + ch) * SEQ;
        store_rows2(o0v, o1v, (bf16_t*)gl, o, o + SEQ, tv);
    }
    __syncthreads();
}
__device__ __forceinline__ void ph_transpose(const Params& P, float* lds, const int wid_s) {
    const int tid = opaque_tid(); bf16_t* tile = (bf16_t*)lds;
    const bf16_t* YT = (const bf16_t*)(P.ws + WS_YT); bf16_t* Y = (bf16_t*)(P.ws + WS_Y);
    for (int it = blockIdx.x; it < NB * 4 * 64; it += gridDim.x) {
        const int b = it >> 8, cq = (it >> 6) & 3, lt = it & 63;
        { const int r = tid >> 3, q = tid & 7; u32x4v v[4];
#pragma unroll
          for (int u = 0; u < 4; ++u) v[u] = *(const u32x4v*)(YT + ((size_t)b * DM + cq * 256 + u * 64 + r) * SEQ + lt * 64 + q * 8);
#pragma unroll
          for (int u = 0; u < 4; ++u) *(u32x4v*)(tile + (u * 64 + r) * 72 + q * 8) = v[u]; }
        __syncthreads();
        { const int lr = tid >> 3, q = tid & 7;
#pragma unroll
          for (int u = 0; u < 4; ++u) { unsigned w[4];
#pragma unroll
            for (int i = 0; i < 4; ++i) w[i] = (unsigned)tile[(u * 64 + q * 8 + 2 * i) * 72 + lr] | ((unsigned)tile[(u * 64 + q * 8 + 2 * i + 1) * 72 + lr] << 16);
            *(u32x4v*)(Y + ((size_t)b * SEQ + lt * 64 + lr) * DM + cq * 256 + u * 64 + q * 8) = (u32x4v){w[0], w[1], w[2], w[3]}; } }
        __syncthreads();
    }
}
__device__ __forceinline__ void unpack8(const u32x4v w, float (&f)[8]) {
    f[0] = __uint_as_float(w.x << 16); f[1] = __uint_as_float(w.x & 0xffff0000u); f[2] = __uint_as_float(w.y << 16); f[3] = __uint_as_float(w.y & 0xffff0000u);
    f[4] = __uint_as_float(w.z << 16); f[5] = __uint_as_float(w.z & 0xffff0000u); f[6] = __uint_as_float(w.w << 16); f[7] = __uint_as_float(w.w & 0xffff0000u);
}
__device__ __forceinline__ void ph_geglu(const Params& P, int l, const int wid_s) {
    const bf16_t* U = (const bf16_t*)(P.ws + WS_U); bf16_t* G = (bf16_t*)(P.ws + WS_G);
    const float* dww = P.in[I_DWW] + (size_t)l * 3 * DUP; const float* dwb = P.in[I_DWB] + (size_t)l * DUP;
    const int tid = opaque_tid();
    if (tid < DFF / 8) {
        const int f0 = tid * 8;
        float wa[3][8], wb[3][8], ba[8], bb[8];
#pragma unroll
        for (int k = 0; k < 3; ++k) { const f32x4v a0 = *(const f32x4v*)(dww + k * DUP + f0), a1 = *(const f32x4v*)(dww + k * DUP + f0 + 4), b0 = *(const f32x4v*)(dww + k * DUP + DFF + f0), b1 = *(const f32x4v*)(dww + k * DUP + DFF + f0 + 4);
            wa[k][0] = a0.x; wa[k][1] = a0.y; wa[k][2] = a0.z; wa[k][3] = a0.w; wa[k][4] = a1.x; wa[k][5] = a1.y; wa[k][6] = a1.z; wa[k][7] = a1.w;
            wb[k][0] = b0.x; wb[k][1] = b0.y; wb[k][2] = b0.z; wb[k][3] = b0.w; wb[k][4] = b1.x; wb[k][5] = b1.y; wb[k][6] = b1.z; wb[k][7] = b1.w; }
        { const f32x4v a0 = *(const f32x4v*)(dwb + f0), a1 = *(const f32x4v*)(dwb + f0 + 4), b0 = *(const f32x4v*)(dwb + DFF + f0), b1 = *(const f32x4v*)(dwb + DFF + f0 + 4);
          ba[0] = a0.x; ba[1] = a0.y; ba[2] = a0.z; ba[3] = a0.w; ba[4] = a1.x; ba[5] = a1.y; ba[6] = a1.z; ba[7] = a1.w; bb[0] = b0.x; bb[1] = b0.y; bb[2] = b0.z; bb[3] = b0.w; bb[4] = b1.x; bb[5] = b1.y; bb[6] = b1.z; bb[7] = b1.w; }
        const u32x4v zero = (u32x4v){0u, 0u, 0u, 0u};
        for (int blk = blockIdx.x; blk < HTOK / 128; blk += gridDim.x) {
            const int rbeg = blk * 128; const bool halo_lo = (rbeg & (SEQ - 1)) != 0, halo_hi = ((rbeg + 128) & (SEQ - 1)) != 0;
            const bf16_t* ua = U + (size_t)rbeg * DUP + f0; const bf16_t* ub = ua + DFF; bf16_t* go = G + (size_t)rbeg * DFF + f0;
            u32x4v ra[4], rb[4];
#pragma unroll
            for (int j = 0; j < 4; ++j) { ra[j] = __builtin_nontemporal_load((const u32x4v*)(ua + (size_t)j * DUP)); rb[j] = __builtin_nontemporal_load((const u32x4v*)(ub + (size_t)j * DUP)); }
            float pa[8], pb[8], ca[8], cb[8], na[8], nb[8];
            { const u32x4v ha = halo_lo ? *(const u32x4v*)(ua - DUP) : zero, hb = halo_lo ? *(const u32x4v*)(ub - DUP) : zero; unpack8(ha, pa); unpack8(hb, pb); }
            unpack8(ra[0], ca); unpack8(rb[0], cb);
            for (int o = 0; o < 32; ++o) {
#pragma unroll
                for (int j = 0; j < 4; ++j) {
                    const int s = o * 4 + j;
                    { const bool last = (o == 31) && (j == 3); const bool ok = !last || halo_hi; unpack8(ok ? ra[(j + 1) & 3] : zero, na); unpack8(ok ? rb[(j + 1) & 3] : zero, nb); }
                    if (o < 31 || j == 0) { const int rr = (s + 4 < HTOK - rbeg) ? s + 4 : s;
                        ra[j] = __builtin_nontemporal_load((const u32x4v*)(ua + (size_t)rr * DUP)); rb[j] = __builtin_nontemporal_load((const u32x4v*)(ub + (size_t)rr * DUP)); }
                    float ov[8];
#pragma unroll
                    for (int e = 0; e < 8; e += 2) {
                        const f32x2v av = (f32x2v){ba[e] + pa[e] * wa[0][e] + ca[e] * wa[1][e] + na[e] * wa[2][e], ba[e + 1] + pa[e + 1] * wa[0][e + 1] + ca[e + 1] * wa[1][e + 1] + na[e + 1] * wa[2][e + 1]};
                        const f32x2v gv = pg8::gelu_pk(av);
                        ov[e] = gv.x * (bb[e] + pb[e] * wb[0][e] + cb[e] * wb[1][e] + nb[e] * wb[2][e]);
                        ov[e + 1] = gv.y * (bb[e + 1] + pb[e + 1] * wb[0][e + 1] + cb[e + 1] * wb[1][e + 1] + nb[e + 1] * wb[2][e + 1]); }
                    *(u32x4v*)(go + (size_t)s * DFF) = (u32x4v){pack2(ov[0], ov[1]), pack2(ov[2], ov[3]), pack2(ov[4], ov[5]), pack2(ov[6], ov[7])};
#pragma unroll
                    for (int e = 0; e < 8; ++e) { pa[e] = ca[e]; pb[e] = cb[e]; ca[e] = na[e]; cb[e] = nb[e]; }
                }
            }
        }
    }
}
constexpr int N_PHASES = 3 + 12 * DEPTH;
#ifndef NT_MODE
#define NT_MODE 1
#endif
#define NT_MASK(ld) ((NT_MODE == 1) ? ((ld) == DUP) : (NT_MODE == 2 ? 1 : 0))
#ifndef REP_PRO
#define REP_PRO 1
#endif
#ifndef REP_MIX
#define REP_MIX 1
#endif
#ifndef REP_GEGLU
#define REP_GEGLU 1
#endif
#ifndef REP_TR
#define REP_TR 1
#endif
#ifndef REP_GEMM
#define REP_GEMM 1
#endif
#ifndef MK_MULTI_LAUNCH
#define MK_MULTI_LAUNCH 0
#endif
__global__ __launch_bounds__(512, 2) void mk_fwd(Params P) {
    extern __shared__ __attribute__((aligned(16))) unsigned char smem[];
    float* lds = (float*)smem;
    cg::grid_group grid = cg::this_grid();
    const int wid_s = __builtin_amdgcn_readfirstlane((int)threadIdx.x >> 6);
    unsigned xst0 = 0u, xst1 = 0u;
    const XcdBarrier xb = xcd_barrier_post((unsigned*)(P.ws + WS_BAR), nullptr);
    bf16_t* H = (bf16_t*)(P.ws + WS_H);
    bf16_t* XB = (bf16_t*)(P.ws + WS_XB);
    for (int ph = P.ph_lo; ph < P.ph_hi; ++ph) {
        if (ph > P.ph_lo) { if (ph == 1) grid.sync(); else {
#ifdef REP_BAR
 xcd_barrier(xb, xst0, xst1, wid_s == 0 && lane_now() == 0); xst0 = __builtin_amdgcn_readfirstlane(xst0); xst1 = __builtin_amdgcn_readfirstlane(xst1);
#endif
 xcd_barrier(xb, xst0, xst1, wid_s == 0 && lane_now() == 0); xst0 = __builtin_amdgcn_readfirstlane(xst0); xst1 = __builtin_amdgcn_readfirstlane(xst1); } }
        bool is_gemm = false; const bf16_t* gA = nullptr; const bf16_t* gB = nullptr; int gM = 0, gN = 0, gK = 0, gld = 0, gsplit = 0; size_t gstride = 0; bf16_t* gO = nullptr;
        if (ph == 0) {
#ifndef NO_PRO
 for (int rep = 0; rep < REP_PRO; ++rep) { ph_tconv(P, lds, wid_s); ph_fold(P, lds, wid_s); ph_mod(P, lds, wid_s); ph_tw(P, wid_s); ph_fh2(P, lds, wid_s); }
#endif
 }
        else if (ph == 1) { ph_h3t(P, 0, lds, wid_s); ph_resnorm<0, 0>(P.in[I_X], nullptr, nullptr, nullptr, nullptr, nullptr, P.in[I_GMPRE], modp(P, 0, 1), modp(P, 0, 0), H, wid_s); }
        else if (ph == 2) {
#ifndef NO_KF
 ph_kf(P, 0, lds, wid_s);
#endif
 }
        else {
            const int l = (ph - 3) / 12, k = (ph - 3) % 12;
            if (k == 0) { is_gemm = true; gA = wbf(P, l, WL_WIN); gB = H; gM = NPT; gN = NTOK; gK = DM; gO = (bf16_t*)(P.ws + WS_PT); gld = SEQ; gsplit = SEQ; gstride = (size_t)NPT * SEQ; }
            else if (k == 1) {
#ifndef NO_MIX
 for (int rep = 0; rep < REP_MIX; ++rep) ph_mix(P, l, lds, wid_s);
#endif
 }
            else if (k == 2) { for (int rep = 0; rep < REP_TR; ++rep) { ph_transpose(P, lds, wid_s); if (l + 1 < DEPTH) ph_h3t(P, l + 1, lds, wid_s); } }
            else if (k == 3) { is_gemm = true; gA = (const bf16_t*)(P.ws + WS_Y); gB = wbf(P, l, WL_WOUT); gM = NTOK; gN = DM; gK = DM; gO = (bf16_t*)(P.ws + WS_YO); gld = DM; }
            else if (k == 4) {
                if (l == 0) ph_resnorm<0, 1>(P.in[I_X], XB, (const bf16_t*)(P.ws + WS_YO), (const bf16_t*)(P.ws + WS_YO) + (size_t)HTOK * DM, P.in[I_GMPOST] + l * DM, modp(P, l, 2), P.in[I_GFPRE] + l * DM, modp(P, l, 4), modp(P, l, 3), H, wid_s);
                else ph_resnorm<1, 1>(XB, XB, (const bf16_t*)(P.ws + WS_YO), (const bf16_t*)(P.ws + WS_YO) + (size_t)HTOK * DM, P.in[I_GMPOST] + l * DM, modp(P, l, 2), P.in[I_GFPRE] + l * DM, modp(P, l, 4), modp(P, l, 3), H, wid_s);

#ifndef NO_KF
 if (l + 1 < DEPTH) ph_kf(P, l + 1, lds, wid_s);
#endif
 }
            else if (k == 5 || k == 8) { const int hf = (k == 8); is_gemm = true; gA = H + (size_t)hf * HTOK * DM; gB = wbf(P, l, WL_WUP); gM = HTOK; gN = DUP; gK = DM; gO = (bf16_t*)(P.ws + WS_U); gld = DUP; }
            else if (k == 6 || k == 9) {
#ifndef NO_GEGLU
 for (int rep = 0; rep < REP_GEGLU; ++rep) ph_geglu(P, l, wid_s);
#endif
 }
            else if (k == 7 || k == 10) { const int hf = (k == 10); is_gemm = true; gA = (const bf16_t*)(P.ws + WS_G); gB = wbf(P, l, WL_WDN); gM = HTOK; gN = DM; gK = DFF; gO = (bf16_t*)(P.ws + (hf ? WS_YD1 : WS_YD0)); gld = DM; }
            else { const bool more = (l + 1 < DEPTH);
                if (more) ph_resnorm<1, 1>(XB, XB, (const bf16_t*)(P.ws + WS_YD0), (const bf16_t*)(P.ws + WS_YD1), P.in[I_GFPOST] + l * DM, modp(P, l, 5), P.in[I_GMPRE] + (l + 1) * DM, modp(P, l + 1, 1), modp(P, l + 1, 0), H, wid_s);
                else ph_resnorm<1, 0>(XB, P.out, (const bf16_t*)(P.ws + WS_YD0), (const bf16_t*)(P.ws + WS_YD1), P.in[I_GFPOST] + l * DM, modp(P, l, 5), nullptr, nullptr, nullptr, nullptr, wid_s); }
        }
        #ifndef NO_GEMM
        if (is_gemm) for (int rep = 0; rep < REP_GEMM; ++rep) {
            __syncthreads();
            pg8::Gemm g{gA, gB, gM, gN, gK}; pg8::StaticOrder S; S.init(gM, gN, (int)gridDim.x, (int)blockIdx.x);
            pg8::EpiBf16<0> E{gO, gld, nullptr, gsplit, gstride, NT_MASK(gld)};
            pg8::gemm_phase<pg8::EpiBf16<0>, pg8::StaticOrder, false>((PG8_LAS unsigned char*)smem, g, S, E, nullptr, wid_s);
            __syncthreads();
        }
#endif
    }
}

extern "C" void kernel_launch(void* const* d_in, const int* in_sizes, int n_in, void* d_out, int out_size, void* d_ws, size_t ws_size, hipStream_t stream) {
    static int grid = 0;
    if (grid == 0) {
        if (n_in != 24 || out_size != NTOK * DM || ws_size < WS_NEED) { fprintf(stderr, "kernel_launch: unexpected shapes (n_in %d out %d ws %zu need %zu)\n", n_in, out_size, ws_size, (size_t)WS_NEED); grid = -1; return; }
        int dev = 0, cus = 0, per_cu = 0;
        hipGetDevice(&dev); hipDeviceGetAttribute(&cus, hipDeviceAttributeMultiprocessorCount, dev);
        if (hipFuncSetAttribute((const void*)mk_fwd, hipFuncAttributeMaxDynamicSharedMemorySize, LDS_BYTES) != hipSuccess) { fprintf(stderr, "kernel_launch: hipFuncSetAttribute failed\n"); grid = -1; return; }
        hipOccupancyMaxActiveBlocksPerMultiprocessor(&per_cu, (const void*)mk_fwd, NTHR, LDS_BYTES);
        (void)hipGetLastError();
        if (per_cu < 1) fprintf(stderr, "kernel_launch: occupancy query says %d blocks per CU\n", per_cu);
        grid = cus > 0 ? cus : 256;
    }
    if (grid < 0) return;
    Params p{};
    for (int i = 0; i < 24; ++i) p.in[i] = (const float*)d_in[i];
    p.out = (float*)d_out; p.ws = (unsigned char*)d_ws;
#if MK_MULTI_LAUNCH
    for (int ph = 0; ph < N_PHASES; ++ph) { p.ph_lo = ph; p.ph_hi = ph + 1; hipLaunchKernelGGL(mk_fwd, dim3(grid), dim3(NTHR), LDS_BYTES, stream, p); }
#else
    p.ph_lo = 0; p.ph_hi = N_PHASES;
    if (hipMemsetAsync((unsigned char*)d_ws + WS_BAR, 0, XCD_BAR_WORDS * 4, stream) != hipSuccess) { fprintf(stderr, "kernel_launch: memset of the barrier words failed\n"); return; }
    void* args[] = {&p};
    hipError_t e = hipLaunchCooperativeKernel((const void*)mk_fwd, dim3(grid), dim3(NTHR), args, LDS_BYTES, stream);
    if (e != hipSuccess) fprintf(stderr, "cooperative launch failed: %s (grid %d)\n", hipGetErrorString(e), grid);
#endif
}
```

```cpp
#include <hip/hip_runtime.h>
#include <hip/hip_cooperative_groups.h>
#include <cstdio>
namespace cg = cooperative_groups;
#define MK_MULTI_LAUNCH 0
namespace pg8 {
#define PG8_LAS __attribute__((address_space(3)))
typedef unsigned short bf16_t;
typedef short bf16x8 __attribute__((ext_vector_type(8)));
typedef float f32x4 __attribute__((ext_vector_type(4)));
typedef unsigned u32x4 __attribute__((ext_vector_type(4)));
constexpr int BM = 256, BK = 64, HALF = 128, HTB = HALF * BK * 2  , STAGE_BYTES = 8 * HTB, NXCD = 8, WGM = 8;

__host__ __device__ __forceinline__ int lds_byte(int r, int c) { const int st = (r >> 4) * 2 + (c >> 5), rr = r & 15, cc = c & 31, ob = rr * 64 + cc * 2; return st * 1024 + (ob ^ (((ob >> 9) & 1) << 5)); }
__host__ __device__ __forceinline__ void stage_rc(int b, int& R, int& C) { const int st = b / 1024, sb = b % 1024, swz = sb ^ (((sb >> 9) & 1) << 5); R = (st >> 1) * 16 + swz / 64; C = (st & 1) * 32 + (swz % 64) / 2; }
__host__ __device__ __forceinline__ int perm32(int rho) { const int n = rho >> 4, i = rho & 15; return 8 * (i >> 2) + 4 * n + (i & 3); }

struct Unit { int pm, pn; };
struct Gemm { const bf16_t* A; const bf16_t* Bt; int M, N, K; };

struct StaticOrder {
    int nM, nN, nwg, G, c;
    __host__ __device__ void init(int M, int N, int G_, int c_) { nM = M / BM; nN = N / BM; nwg = nM * nN; G = G_; c = c_; }
    __host__ __device__ bool next(int i, Unit& u) const {
        const long L = (long)i * G + c; if (L >= nwg) return false;
        int wgid = (int)L; { const int q = nwg / NXCD, r = nwg % NXCD, xcd = wgid % NXCD, off = wgid / NXCD; wgid = (xcd < r ? xcd * (q + 1) : r * (q + 1) + (xcd - r) * q) + off; }
        const int nig = WGM * nN, gid = wgid / nig, fm = gid * WGM, gsz = (nM - fm) < WGM ? (nM - fm) : WGM;
        u.pm = fm + ((wgid % nig) % gsz); u.pn = (wgid % nig) / gsz; return true;
    }
    __device__ __forceinline__ void a_ready(const Unit&) const {}
    __device__ __forceinline__ void done(const Unit&) const {}
};
__device__ __forceinline__ unsigned cvt_pk_bf16(float lo, float hi) { unsigned r; asm volatile("v_cvt_pk_bf16_f32 %0, %1, %2" : "=v"(r) : "v"(lo), "v"(hi)); return r; }
typedef float f32x2 __attribute__((ext_vector_type(2)));
__device__ __forceinline__ f32x2 gelu_pk(f32x2 v) {
    const f32x2 av = __builtin_elementwise_abs(v), d = av * 0.2316418882f + 1.0f;
    f32x2 t; t.x = __builtin_amdgcn_rcpf(d.x); t.y = __builtin_amdgcn_rcpf(d.y);
    f32x2 q = t * 0.5307027145f + (-0.7265760135f); q = q * t + 0.7107068705f; q = q * t + (-0.142248368f); q = q * t + 0.127414796f; q = q * t;
    const f32x2 s = (v * v) * (-0.72134752044f);
    f32x2 e; e.x = __builtin_amdgcn_exp2f(s.x); e.y = __builtin_amdgcn_exp2f(s.y);
    const f32x2 m = v * (q * e), r = v - m;
    f32x2 o; o.x = v.x < 0.f ? m.x : r.x; o.y = v.y < 0.f ? m.y : r.y; return o;
}

struct EpiF32 {
    static constexpr bool PERM = false, AFTER_DRAIN = false;
    float* C; int ldc; const float* bias;
    __device__ __forceinline__ void operator()(const f32x4 (&acc)[2][2][4][2], const Unit& u, int wr, int wc, int fr, int fq) const {
        const int row0 = u.pm * BM + wr * 64 + fr, col0 = u.pn * BM + wc * 32 + 4 * fq;
        f32x4 bv[2][2];
#pragma unroll
        for (int bj = 0; bj < 2; ++bj)
#pragma unroll
            for (int n = 0; n < 2; ++n) bv[bj][n] = bias ? *(const f32x4*)(bias + col0 + bj * HALF + n * 16) : (f32x4){0.f, 0.f, 0.f, 0.f};
#pragma unroll
        for (int ai = 0; ai < 2; ++ai)
#pragma unroll
            for (int m = 0; m < 4; ++m) { float* rowp = C + (size_t)(row0 + ai * HALF + m * 16) * ldc + col0;
#pragma unroll
                for (int bj = 0; bj < 2; ++bj)
#pragma unroll
                    for (int n = 0; n < 2; ++n) *(f32x4*)(rowp + bj * HALF + n * 16) = acc[ai][bj][m][n] + bv[bj][n]; }
    }
};
template <int ACT  > struct EpiBf16 {
    static constexpr bool PERM = true, AFTER_DRAIN = false;
    bf16_t* O; int ldc; const float* bias; int split_cols; size_t split_stride; int nt;
    __device__ __forceinline__ void operator()(const f32x4 (&acc)[2][2][4][2], const Unit& u, int wr, int wc, int fr, int fq) const {
        const int row0 = u.pm * BM + wr * 64 + fr; int colt = u.pn * BM; bf16_t* base = O;
        if (split_cols) { const int t = colt / split_cols; base += (size_t)t * split_stride; colt -= t * split_cols; }
        const int col0 = colt + wc * 32 + 8 * fq, bcol0 = u.pn * BM + wc * 32 + 8 * fq;
        f32x4 bv[2][2];
#pragma unroll
        for (int bj = 0; bj < 2; ++bj)
#pragma unroll
            for (int n = 0; n < 2; ++n) bv[bj][n] = bias ? *(const f32x4*)(bias + bcol0 + bj * HALF + 4 * n) : (f32x4){0.f, 0.f, 0.f, 0.f};
#pragma unroll
        for (int ai = 0; ai < 2; ++ai)
#pragma unroll
            for (int m = 0; m < 4; ++m) { bf16_t* rowp = base + (size_t)(row0 + ai * HALF + m * 16) * ldc + col0;
#pragma unroll
                for (int bj = 0; bj < 2; ++bj) { f32x4 v0 = acc[ai][bj][m][0] + bv[bj][0], v1 = acc[ai][bj][m][1] + bv[bj][1];
                    if (ACT == 1) { f32x2 a = gelu_pk((f32x2){v0[0], v0[1]}), b = gelu_pk((f32x2){v0[2], v0[3]}), c = gelu_pk((f32x2){v1[0], v1[1]}), d = gelu_pk((f32x2){v1[2], v1[3]});
                        v0 = (f32x4){a.x, a.y, b.x, b.y}; v1 = (f32x4){c.x, c.y, d.x, d.y}; }
                    if (ACT == 2) {
#pragma unroll
                        for (int j = 0; j < 4; ++j) { v0[j] = 0.5f * v0[j] * (1.0f + erff(v0[j] * 0.70710678f)); v1[j] = 0.5f * v1[j] * (1.0f + erff(v1[j] * 0.70710678f)); } }
                    u32x4 w; w.x = cvt_pk_bf16(v0[0], v0[1]); w.y = cvt_pk_bf16(v0[2], v0[3]); w.z = cvt_pk_bf16(v1[0], v1[1]); w.w = cvt_pk_bf16(v1[2], v1[3]);
                    if (nt) __builtin_nontemporal_store(w, (u32x4*)(rowp + bj * HALF)); else *(u32x4*)(rowp + bj * HALF) = w; } }
    }
};
template <class Epi, class Sched, bool STAMP = false>
__device__ __forceinline__ void gemm_phase(PG8_LAS unsigned char* lds, const Gemm g, const Sched& S, const Epi& E, unsigned long long* stamps, const int wid_s) {
    int tid_; asm volatile("v_mbcnt_lo_u32_b32 %0, -1, 0\n\tv_mbcnt_hi_u32_b32 %0, -1, %0" : "=v"(tid_)); tid_ += wid_s * 64; const int tid = tid_, wid = __builtin_amdgcn_readfirstlane(tid >> 6), lane = tid & 63, wr = wid >> 2, wc = wid & 3, fr = lane & 15, fq = lane >> 4;
    const int K = g.K, nt = K / BK;
    int ts_lo = 0, ts_hi = 0, nts = 0; const unsigned long long rt_entry = STAMP ? (unsigned long long)wall_clock64() : 0ull;
#define PG8_STAMP() do { if (STAMP && wid == 0 && nts < 64) { const unsigned long long _c = (unsigned long long)clock64(); \
        ts_lo = (lane == nts) ? (int)(unsigned)_c : ts_lo; ts_hi = (lane == nts) ? (int)(unsigned)(_c >> 32) : ts_hi; ++nts; } } while (0)
    PG8_STAMP();
    unsigned voffA[2], voffB[2];
#pragma unroll
    for (int i = 0; i < 2; ++i) { int R, C; stage_rc(tid * 16 + i * 8192, R, C); const int Rb = Epi::PERM ? ((R & ~31) + perm32(R & 31)) : R;
        voffA[i] = (unsigned)(R * K + C) * 2u; voffB[i] = (unsigned)(Rb * K + C) * 2u; }
    const size_t kstep = (size_t)(BK * 2);
    const size_t hstep = (size_t)HALF * K * 2;
    const size_t tstep = 2 * hstep;
    const unsigned ldsw = (unsigned)wid * 1024u;
    const int aoff = lds_byte(wr * 64 + fr, fq * 8), boff = lds_byte(wc * 32 + fr, fq * 8);
#define PG8_SA(b, h) (((b) * 2 + (h)) * HTB)
#define PG8_SB(b, h) ((4 + (b) * 2 + (h)) * HTB)
#define PG8_STAGE(bufoff, gbase, voff) do { _Pragma("unroll") for (int _i = 0; _i < 2; ++_i) \
        __builtin_amdgcn_global_load_lds((const unsigned*)((const char*)(gbase) + (voff)[_i]), (PG8_LAS unsigned*)(lds + (bufoff) + ldsw + _i * 8192), 16, 0, 0); } while (0)
#define PG8_LDA(dst, b, h) do { _Pragma("unroll") for (int m = 0; m < 4; ++m) _Pragma("unroll") for (int k = 0; k < 2; ++k) dst[m][k] = *(const PG8_LAS bf16x8*)(lds + PG8_SA(b, h) + aoff + m * 2048 + k * 1024); } while (0)
#define PG8_LDB(dst, b, h) do { _Pragma("unroll") for (int n = 0; n < 2; ++n) _Pragma("unroll") for (int k = 0; k < 2; ++k) dst[n][k] = *(const PG8_LAS bf16x8*)(lds + PG8_SB(b, h) + boff + n * 2048 + k * 1024); } while (0)
#define PG8_MMA(ai, bj, At, Bt) do { __builtin_amdgcn_s_setprio(1); _Pragma("unroll") for (int m = 0; m < 4; ++m) _Pragma("unroll") for (int n = 0; n < 2; ++n) _Pragma("unroll") for (int k = 0; k < 2; ++k) \
        acc[ai][bj][m][n] = __builtin_amdgcn_mfma_f32_16x16x32_bf16(Bt[n][k], At[m][k], acc[ai][bj][m][n], 0, 0, 0); __builtin_amdgcn_s_setprio(0); } while (0)
#define PG8_WAIT_V(n) asm volatile("s_waitcnt vmcnt(" #n ")" ::: "memory")
#define PG8_WAIT_L(n) asm volatile("s_waitcnt lgkmcnt(" #n ")" ::: "memory")
#define PG8_BAR __builtin_amdgcn_s_barrier()
#define PG8_SCHED __builtin_amdgcn_sched_barrier(0)
    Unit cur, nxt; int ui = 0;
    if (!S.next(0, cur)) return;
    f32x4 acc[2][2][4][2];
#pragma unroll
    for (int a = 0; a < 2; ++a)
#pragma unroll
        for (int b = 0; b < 2; ++b)
#pragma unroll
            for (int m = 0; m < 4; ++m)
#pragma unroll
                for (int n = 0; n < 2; ++n) acc[a][b][m][n] = (f32x4){0.f, 0.f, 0.f, 0.f};
    bf16x8 At[4][2], B0[2][2], B1[2][2];
    const char* cA = (const char*)g.A + (size_t)cur.pm * tstep; const char* cB = (const char*)g.Bt + (size_t)cur.pn * tstep;
    S.a_ready(cur);
    PG8_STAGE(PG8_SB(0, 0), cB, voffB); PG8_STAGE(PG8_SA(0, 0), cA, voffA); PG8_STAGE(PG8_SB(0, 1), cB + hstep, voffB); PG8_STAGE(PG8_SA(0, 1), cA + hstep, voffA);
    if (wr == 1) PG8_BAR;
    PG8_WAIT_V(4); PG8_BAR;
    PG8_STAGE(PG8_SB(1, 0), cB + kstep, voffB); PG8_STAGE(PG8_SA(1, 0), cA + kstep, voffA); PG8_STAGE(PG8_SB(1, 1), cB + hstep + kstep, voffB);
    PG8_WAIT_V(6); PG8_BAR;
    PG8_STAMP();
    for (;;) {
        const bool has_next = S.next(ui + 1, nxt);
        const char* nA = has_next ? (const char*)g.A + (size_t)nxt.pm * tstep : cA; const char* nB = has_next ? (const char*)g.Bt + (size_t)nxt.pn * tstep : cB;
        for (int t = 0; t < nt; t += 2) {
            const bool last = (t == nt - 2);
            const char* a1 = cA + (size_t)(t + 1) * kstep;
            const char* a2 = last ? nA : cA + (size_t)(t + 2) * kstep; const char* b2 = last ? nB : cB + (size_t)(t + 2) * kstep;
            const char* a3 = a2 + kstep; const char* b3 = b2 + kstep;
            if (last && has_next) S.a_ready(nxt);
            PG8_LDB(B0, 0, 0); PG8_SCHED; PG8_LDA(At, 0, 0); PG8_STAGE(PG8_SA(1, 1), a1 + hstep, voffA);
            PG8_WAIT_L(8); PG8_BAR; PG8_WAIT_L(0); PG8_MMA(0, 0, At, B0); PG8_BAR; PG8_SCHED;
            PG8_LDB(B1, 0, 1); PG8_STAGE(PG8_SB(0, 0), b2, voffB);
            PG8_BAR; PG8_WAIT_L(0); PG8_MMA(0, 1, At, B1); PG8_BAR;
            PG8_LDA(At, 0, 1); PG8_STAGE(PG8_SA(0, 0), a2, voffA);
            PG8_BAR; PG8_WAIT_L(0); PG8_MMA(1, 0, At, B0); PG8_BAR; PG8_SCHED;
            PG8_STAGE(PG8_SB(0, 1), b2 + hstep, voffB);
            PG8_WAIT_V(6); PG8_BAR; PG8_MMA(1, 1, At, B1); PG8_BAR;
            PG8_LDB(B0, 1, 0); PG8_SCHED; PG8_LDA(At, 1, 0); PG8_STAGE(PG8_SA(0, 1), a2 + hstep, voffA);
            PG8_WAIT_L(8); PG8_BAR; PG8_WAIT_L(0); PG8_MMA(0, 0, At, B0); PG8_BAR; PG8_SCHED;
            PG8_LDB(B1, 1, 1); PG8_STAGE(PG8_SB(1, 0), b3, voffB);
            PG8_BAR; PG8_WAIT_L(0); PG8_MMA(0, 1, At, B1); PG8_BAR;
            PG8_LDA(At, 1, 1); PG8_STAGE(PG8_SA(1, 0), a3, voffA);
            PG8_BAR; PG8_WAIT_L(0); PG8_MMA(1, 0, At, B0); PG8_BAR; PG8_SCHED;
            PG8_STAGE(PG8_SB(1, 1), b3 + hstep, voffB);
            PG8_WAIT_V(6); PG8_BAR; PG8_MMA(1, 1, At, B1); PG8_BAR;
        }
        PG8_STAMP();
        if constexpr (!Epi::AFTER_DRAIN) { E(acc, cur, wr, wc, fr, fq); S.done(cur); }
        PG8_STAMP();
        if (!has_next) break;
#pragma unroll
        for (int a = 0; a < 2; ++a)
#pragma unroll
            for (int b = 0; b < 2; ++b)
#pragma unroll
                for (int m = 0; m < 4; ++m)
#pragma unroll
                    for (int n = 0; n < 2; ++n) acc[a][b][m][n] = (f32x4){0.f, 0.f, 0.f, 0.f};
        cur = nxt; cA = nA; cB = nB; ++ui;
    }
    PG8_WAIT_V(0);
    if (wr == 0) PG8_BAR;
    PG8_BAR;
    if constexpr (Epi::AFTER_DRAIN) { E.fused(acc, cur, wr, wc, fr, fq, lds, wid, lane); S.done(cur); }
    PG8_STAMP();
    if (STAMP && wid == 0) { stamps[lane] = lane < nts ? (((unsigned long long)(unsigned)ts_hi << 32) | (unsigned)ts_lo) : 0ull;
        if (lane == 62) stamps[62] = rt_entry; if (lane == 63) stamps[63] = (unsigned long long)wall_clock64(); }
#undef PG8_STAMP
#undef PG8_SA
#undef PG8_SB
#undef PG8_STAGE
#undef PG8_LDA
#undef PG8_LDB
#undef PG8_MMA
#undef PG8_WAIT_V
#undef PG8_WAIT_L
#undef PG8_BAR
#undef PG8_SCHED
}
}
#define XB_TMO      128
#define XB_XCNT(j)  (256  + 64 * (j))
#define XB_XSUB(j)  (1280 + 64 * (j))
#define XB_XGEN(j)  (2304 + 64 * (j))
#define XB_TOP      3328
#define XB_TOPGEN   3392
#define XCD_BAR_WORDS 3456
#define XB_SPIN_CAP (1u << 18)
#define LAS __attribute__((address_space(3)))

__device__ __forceinline__ unsigned xb_ld(unsigned* p)              { return __hip_atomic_load(p, __ATOMIC_RELAXED, __HIP_MEMORY_SCOPE_AGENT); }
__device__ __forceinline__ unsigned xb_add(unsigned* p, unsigned v) { return __hip_atomic_fetch_add(p, v, __ATOMIC_RELAXED, __HIP_MEMORY_SCOPE_AGENT); }
__device__ __forceinline__ unsigned xb_xcc_id() { return (unsigned)__builtin_amdgcn_s_getreg((3 << 11) | 20) & 0xFu; }
#define XB_SPIN(cond, bar) do { unsigned _sp = 0; while (cond) { __builtin_amdgcn_s_sleep(1); \
    if ((++_sp & 255u) == 0u) { if (xb_ld(&(bar)[XB_TMO])) break; if (_sp > XB_SPIN_CAP) { atomicAdd(&(bar)[XB_TMO], 1u); break; } } } } while (0)

struct XcdBarrier {
    unsigned* bar; unsigned x;
    volatile LAS unsigned* st;
};

__device__ __forceinline__ XcdBarrier xcd_barrier_post(unsigned* bar, volatile LAS unsigned* st) {
    XcdBarrier b; b.bar = bar; b.x = xb_xcc_id(); b.st = st;
    if (threadIdx.x == 0) (void)xb_add(&bar[XB_XCNT(b.x)], 1u);
    return b;
}
__device__ __forceinline__ void xcd_barrier_complete(unsigned* bar, unsigned x, unsigned& nloc, unsigned& nx) {
    const unsigned G = gridDim.x * gridDim.y * gridDim.z;
    unsigned sum, cnt, mine, sp = 0u;
    for (;;) {
        sum = 0u; cnt = 0u; mine = 0u;
#pragma unroll
        for (unsigned j = 0; j < 16; ++j) { const unsigned c = xb_ld(&bar[XB_XCNT(j)]); sum += c; cnt += (c > 0u) ? 1u : 0u; mine = (j == x) ? c : mine; }
        if (sum == G) break;
        __builtin_amdgcn_s_sleep(1);
        if ((++sp & 255u) == 0u) { if (xb_ld(&bar[XB_TMO])) break; if (sp > XB_SPIN_CAP) { atomicAdd(&bar[XB_TMO], 1u); break; } }
    }
    nloc = mine > 0u ? mine : 1u; nx = cnt > 0u ? cnt : 1u;
}

__device__ __forceinline__ void xcd_barrier(const XcdBarrier& b, unsigned& st0, unsigned& st1, const bool t0  ) {
    asm volatile("s_waitcnt vmcnt(0)" ::: "memory");
    __syncthreads();
    if (t0) {
        unsigned* bar = b.bar;
        __builtin_amdgcn_s_waitcnt(0);
        unsigned nloc = st0, nx = st1;
        if (nloc == 0u) { xcd_barrier_complete(bar, b.x, nloc, nx); st0 = nloc; st1 = nx; }
        const unsigned old = xb_add(&bar[XB_XSUB(b.x)], 1u);
        const unsigned gen = old / nloc;
        if (old + 1u == (gen + 1u) * nloc) {
            __builtin_amdgcn_fence(__ATOMIC_RELEASE, "agent");
            asm volatile("s_waitcnt vmcnt(0)" ::: "memory");
            const unsigned og = xb_add(&bar[XB_TOP], 1u);
            const unsigned tg = og / nx;
            if (og + 1u == (tg + 1u) * nx) xb_add(&bar[XB_TOPGEN], 1u);
            else XB_SPIN(xb_ld(&bar[XB_TOPGEN]) == tg, bar);
            __builtin_amdgcn_fence(__ATOMIC_ACQUIRE, "agent");
            xb_add(&bar[XB_XGEN(b.x)], 1u);
            asm volatile("s_waitcnt vmcnt(0)" ::: "memory");
        } else {
            XB_SPIN(xb_ld(&bar[XB_XGEN(b.x)]) == gen, bar);
            __builtin_amdgcn_fence(__ATOMIC_ACQUIRE, "agent");
            asm volatile("s_waitcnt vmcnt(0)" ::: "memory");
        }
    }
    __syncthreads();
}

using pg8::bf16_t;
typedef float f32x4v __attribute__((ext_vector_type(4)));
typedef float f32x2v __attribute__((ext_vector_type(2)));
typedef unsigned u32x4v __attribute__((ext_vector_type(4)));
typedef unsigned u32x2v __attribute__((ext_vector_type(2)));

constexpr int DM = 1024, NB = 16, SEQ = 4096, DEPTH = 4, NTOK = NB * SEQ;
constexpr int DH = 512, NPT = 2560, DFF = 2816, DUP = 5632, HTOK = NTOK / 2;
constexpr int NTHR = 512;

constexpr size_t WL_WIN = 0, WL_WOUT = WL_WIN + (size_t)NPT * DM, WL_WUP = WL_WOUT + (size_t)DM * DM, WL_WDN = WL_WUP + (size_t)DUP * DM, WL_END = WL_WDN + (size_t)DM * DFF;
constexpr size_t WS_WBF = 0;
constexpr size_t WS_KF = WS_WBF + WL_END * 2 * DEPTH;
constexpr size_t WS_H3T = WS_KF + (size_t)2 * DH * SEQ * 8;
constexpr size_t WS_FH2 = WS_H3T + (size_t)2048 * SEQ * 4;
constexpr size_t WS_MOD = WS_FH2 + (size_t)DEPTH * SEQ * 64 * 4;
constexpr size_t WS_TW = WS_MOD + (size_t)DEPTH * NB * 6144 * 4;
constexpr size_t WS_H = WS_TW + 8192 * 8;
constexpr size_t WS_BIG = WS_H + (size_t)NTOK * DM * 2;
constexpr size_t WS_PT = WS_BIG, WS_YT = WS_PT + (size_t)NB * NPT * SEQ * 2, WS_Y = WS_YT + (size_t)NTOK * DM * 2, WS_MIX_END = WS_Y + (size_t)NTOK * DM * 2;
constexpr size_t WS_YO = WS_PT;
constexpr size_t WS_U = WS_BIG, WS_G = WS_U + (size_t)HTOK * DUP * 2, WS_YD0 = WS_G + (size_t)HTOK * DFF * 2, WS_FFN_END = WS_YD0 + (size_t)HTOK * DM * 2;
constexpr size_t WS_YD1 = WS_U;
constexpr size_t WS_XB = WS_MIX_END > WS_FFN_END ? WS_MIX_END : WS_FFN_END;
constexpr size_t WS_BAR = WS_XB + (size_t)NTOK * DM * 2;
constexpr size_t WS_NEED = WS_BAR + XCD_BAR_WORDS * 4;

static_assert(WS_KF % 256 == 0 && WS_H % 256 == 0 && WS_BIG % 256 == 0 && WS_G % 256 == 0 && WS_YD0 % 256 == 0 && WS_XB % 256 == 0, "align");

enum { I_X = 0, I_C, I_ADAW, I_ADAB, I_GMPRE, I_GMPOST, I_WIN, I_SW, I_SB, I_FW1, I_FB1, I_FW2, I_FB2, I_FFREQ, I_FW3, I_HD, I_FNW, I_WOUT, I_GFPRE, I_GFPOST, I_WUP, I_DWW, I_DWB, I_WDOWN };
struct Params { const float* in[24]; float* out; unsigned char* ws; int ph_lo, ph_hi; };

__device__ __forceinline__ float bf2f(bf16_t v) { return __uint_as_float(((unsigned)v) << 16); }
__device__ __forceinline__ unsigned pack2(float lo, float hi) { unsigned r; asm("v_cvt_pk_bf16_f32 %0, %1, %2" : "=v"(r) : "v"(lo), "v"(hi)); return r; }
__device__ __forceinline__ bf16_t f2bf(float f) { return (bf16_t)(pack2(f, f) & 0xffffu); }
__device__ __forceinline__ int lane_now() { int l; asm volatile("v_mbcnt_lo_u32_b32 %0, -1, 0\n\tv_mbcnt_hi_u32_b32 %0, -1, %0" : "=v"(l)); return l; }
__device__ __forceinline__ int opaque_tid_(int wid_s) { return wid_s * 64 + lane_now(); }
#define opaque_tid() opaque_tid_(wid_s)
__device__ __forceinline__ float wave_sum(float v) {
#pragma unroll
    for (int o = 32; o >= 1; o >>= 1) v += __shfl_xor(v, o);
    return v;
}

template <class T> __device__ __forceinline__ void dft4(T& r0, T& i0, T& r1, T& i1, T& r2, T& i2, T& r3, T& i3) {
    const T s0r = r0 + r2, s0i = i0 + i2, s1r = r0 - r2, s1i = i0 - i2;
    const T s2r = r1 + r3, s2i = i1 + i3, s3r = r1 - r3, s3i = i1 - i3;
    r0 = s0r + s2r; i0 = s0i + s2i; r2 = s0r - s2r; i2 = s0i - s2i;
    r1 = s1r + s3i; i1 = s1i - s3r; r3 = s1r - s3i; i3 = s1i + s3r;
}
template <int K, class T> __device__ __forceinline__ void tw16(T& r, T& i) {
    if constexpr (K == 0) { }
    else if constexpr (K == 4) { const T t = r; r = i; i = -t; }
    else {
        constexpr float C[10] = {1.f, 0.92387953251128674f, 0.70710678118654752f, 0.38268343236508977f, 0.f, -0.38268343236508977f, -0.70710678118654752f, -0.92387953251128674f, -1.f, -0.92387953251128674f};
        constexpr float S[10] = {0.f, -0.38268343236508977f, -0.70710678118654752f, -0.92387953251128674f, -1.f, -0.92387953251128674f, -0.70710678118654752f, -0.38268343236508977f, 0.f, 0.38268343236508977f};
        const float c = C[K], s = S[K]; const T t = r * c - i * s; i = r * s + i * c; r = t;
    }
}
template <class T> __device__ __forceinline__ void dft16(T (&xr)[16], T (&xi)[16]) {
#pragma unroll
    for (int b = 0; b < 4; ++b) dft4(xr[b], xi[b], xr[4 + b], xi[4 + b], xr[8 + b], xi[8 + b], xr[12 + b], xi[12 + b]);
    tw16<1>(xr[5], xi[5]); tw16<2>(xr[6], xi[6]); tw16<3>(xr[7], xi[7]);
    tw16<2>(xr[9], xi[9]); tw16<4>(xr[10], xi[10]); tw16<6>(xr[11], xi[11]);
    tw16<3>(xr[13], xi[13]); tw16<6>(xr[14], xi[14]); tw16<9>(xr[15], xi[15]);
#pragma unroll
    for (int c = 0; c < 4; ++c) dft4(xr[4 * c], xi[4 * c], xr[4 * c + 1], xi[4 * c + 1], xr[4 * c + 2], xi[4 * c + 2], xr[4 * c + 3], xi[4 * c + 3]);
#pragma unroll
    for (int c = 0; c < 4; ++c)
#pragma unroll
        for (int d = c + 1; d < 4; ++d) { T t = xr[4 * c + d]; xr[4 * c + d] = xr[4 * d + c]; xr[4 * d + c] = t; t = xi[4 * c + d]; xi[4 * c + d] = xi[4 * d + c]; xi[4 * d + c] = t; }
}
constexpr int PBUF = 4096;
constexpr int LDS_MAIN = 2 * PBUF * 16;
constexpr int LDS_KF = LDS_MAIN;
__device__ __forceinline__ void fft4096_pk(f32x2v (&xr)[16], f32x2v (&xi)[16], f32x4v* buf, const int t, const f32x2v* __restrict__ TW) {
    dft16(xr, xi);
    __syncthreads();
    {
        f32x2v w1 = TW[2 * t]; asm volatile("" : "+v"(w1.x), "+v"(w1.y));
        float wr = w1.x, wi = w1.y;
        buf[t] = (f32x4v){xr[0].x, xr[0].y, xi[0].x, xi[0].y};
#pragma unroll
        for (int k = 1; k < 16; ++k) {
            const f32x2v r = xr[k], i = xi[k]; const f32x2v nr = r * wr - i * wi, ni = r * wi + i * wr;
            buf[k * 256 + t] = (f32x4v){nr.x, nr.y, ni.x, ni.y};
            if (k < 15) { const float n2 = wr * w1.x - wi * w1.y; wi = wr * w1.y + wi * w1.x; wr = n2; }
        }
    }
    __syncthreads();
    const int k1 = t >> 4, m2 = t & 15;
#pragma unroll
    for (int m = 0; m < 16; ++m) { const f32x4v v = buf[k1 * 256 + 16 * m + m2]; xr[m] = (f32x2v){v.x, v.y}; xi[m] = (f32x2v){v.z, v.w}; }
    __syncthreads();
    dft16(xr, xi);
    {
        f32x2v w1 = TW[32 * m2]; asm volatile("" : "+v"(w1.x), "+v"(w1.y));
        float wr = w1.x, wi = w1.y;
        buf[m2 * 256 + (k1 ^ (m2 & 7))] = (f32x4v){xr[0].x, xr[0].y, xi[0].x, xi[0].y};
#pragma unroll
        for (int j = 1; j < 16; ++j) {
            const f32x2v r = xr[j], i = xi[j]; const f32x2v nr = r * wr - i * wi, ni = r * wi + i * wr;
            buf[m2 * 256 + ((k1 + 16 * j) ^ (m2 & 7))] = (f32x4v){nr.x, nr.y, ni.x, ni.y};
            if (j < 15) { const float n2 = wr * w1.x - wi * w1.y; wi = wr * w1.y + wi * w1.x; wr = n2; }
        }
    }
    __syncthreads();
#pragma unroll
    for (int m = 0; m < 16; ++m) { const f32x4v v = buf[m * 256 + (t ^ (m & 7))]; xr[m] = (f32x2v){v.x, v.y}; xi[m] = (f32x2v){v.z, v.w}; }
    dft16(xr, xi);
}
__device__ __forceinline__ f32x2v w32(int j) {
    constexpr float C[16] = {1.f, 0.98078528040323043f, 0.92387953251128674f, 0.83146961230254524f, 0.70710678118654752f, 0.55557023301960218f, 0.38268343236508977f, 0.19509032201612825f, 0.f, -0.19509032201612825f, -0.38268343236508977f, -0.55557023301960218f, -0.70710678118654752f, -0.83146961230254524f, -0.92387953251128674f, -0.98078528040323043f};
    constexpr float S[16] = {0.f, -0.19509032201612825f, -0.38268343236508977f, -0.55557023301960218f, -0.70710678118654752f, -0.83146961230254524f, -0.92387953251128674f, -0.98078528040323043f, -1.f, -0.98078528040323043f, -0.92387953251128674f, -0.83146961230254524f, -0.70710678118654752f, -0.55557023301960218f, -0.38268343236508977f, -0.19509032201612825f};
    return (f32x2v){C[j], S[j]};
}
constexpr int LDS_BYTES = LDS_MAIN + 32768;
static_assert(LDS_MAIN >= pg8::STAGE_BYTES, "lds");
typedef _Float16 f16x4v __attribute__((ext_vector_type(4)));
__device__ __forceinline__ void kf_dma(const unsigned char* src, unsigned char* kfl, int tid) {
    const int w = __builtin_amdgcn_readfirstlane(tid >> 6), lane = tid & 63;
#pragma unroll
    for (int q = 0; q < 4; ++q)
        __builtin_amdgcn_global_load_lds((const unsigned*)(src + (w * 4 + q) * 1024 + lane * 16), (LAS unsigned*)(kfl + (w * 4 + q) * 1024), 16, 0, 0);
}
__device__ __forceinline__ bf16_t* wbf(const Params& P, int l, size_t off) { return (bf16_t*)(P.ws + WS_WBF) + (size_t)l * WL_END + off; }
__device__ __forceinline__ const float* modp(const Params& P, int l, int which) { return (const float*)(P.ws + WS_MOD) + (size_t)l * NB * 6144 + which * 1024; }

__device__ __forceinline__ void ph_tconv(const Params& P, float* tile, const int wid_s) {
    const int tid = opaque_tid();
    for (int it = blockIdx.x; it < DEPTH * 2752; it += gridDim.x) {
        const int l = it / 2752; int r = it % 2752;
        const float* src; int ldsrc, lddst, tk, tn; bf16_t* dst;
        if (r < 384) { src = P.in[I_WIN] + (size_t)l * DM * 2048; ldsrc = 2048; lddst = DM; tk = r / 24; tn = r % 24; dst = wbf(P, l, WL_WIN); }
        else if (r < 640) { r -= 384; src = P.in[I_WOUT] + (size_t)l * DM * DM; ldsrc = DM; lddst = DM; tk = r / 16; tn = r % 16; dst = wbf(P, l, WL_WOUT); }
        else if (r < 2048) { r -= 640; src = P.in[I_WUP] + (size_t)l * DM * DUP; ldsrc = DUP; lddst = DM; tk = r / 88; tn = r % 88; dst = wbf(P, l, WL_WUP); }
        else { r -= 2048; src = P.in[I_WDOWN] + (size_t)l * DFF * DM; ldsrc = DM; lddst = DFF; tk = r / 16; tn = r % 16; dst = wbf(P, l, WL_WDN); }
        { const int kk = tid >> 3, c8 = (tid & 7) * 8; const float* s = src + (size_t)(tk * 64 + kk) * ldsrc + tn * 64 + c8; const f32x4v v0 = *(const f32x4v*)s, v1 = *(const f32x4v*)(s + 4);
          float* t = tile + kk * 65 + c8; t[0] = v0.x; t[1] = v0.y; t[2] = v0.z; t[3] = v0.w; t[4] = v1.x; t[5] = v1.y; t[6] = v1.z; t[7] = v1.w; }
        __syncthreads();
        { const int nn = tid >> 3, k8 = (tid & 7) * 8; const float* t = tile + k8 * 65 + nn;
          *(u32x4v*)(dst + (size_t)(tn * 64 + nn) * lddst + tk * 64 + k8) = (u32x4v){pack2(t[0], t[65]), pack2(t[130], t[195]), pack2(t[260], t[325]), pack2(t[390], t[455])}; }
        __syncthreads();
    }
}
__device__ __forceinline__ void ph_fold(const Params& P, float* lds, const int wid_s) {
    const int tid = opaque_tid();
    float* CW = lds; float* SWm = lds + 4096; float* ct = lds + 8192; float* st = lds + 8192 + 64;
    float* Wl = lds + 8192 + 128;
    bf16_t* ot = (bf16_t*)(Wl + 128 * 65);
    for (int it = blockIdx.x; it < DEPTH * 64; it += gridDim.x) {
        const int l = it >> 6, g = (it >> 3) & 7, kc = it & 7;
        const float* Wg = P.in[I_FNW] + ((size_t)l * 8 + g) * 4096;
        if (tid < 64) { float s, c; sincospif((float)tid * (1.0f / 32.0f), &s, &c); ct[tid] = c; st[tid] = s; }
#pragma unroll
        for (int i = 0; i < 16; ++i) { const int idx = tid + 512 * i, kk = idx >> 6, c = idx & 63; Wl[kk * 65 + c] = P.in[I_WIN][((size_t)l * DM + kc * 128 + kk) * 2048 + 1536 + 64 * g + c]; }
        __syncthreads();
        for (int idx = tid; idx < 4096; idx += NTHR) { const int c = idx >> 6, d = idx & 63; float ac = 0.f, as = 0.f;
            for (int m = 0; m < 64; ++m) { const float w = Wg[m * 64 + d]; const int ph = (c * m) & 63; ac += ct[ph] * w; as += st[ph] * w; }
            CW[idx] = ac * (1.0f / 512.0f); SWm[idx] = as * (1.0f / 512.0f); }
        __syncthreads();
        { const int kk = tid & 127, dg = tid >> 7;
          f32x4v ac[4], as[4];
#pragma unroll
          for (int u = 0; u < 4; ++u) { ac[u] = (f32x4v){0.f, 0.f, 0.f, 0.f}; as[u] = (f32x4v){0.f, 0.f, 0.f, 0.f}; }
          for (int c = 0; c < 64; ++c) { const float w = Wl[kk * 65 + c];
#pragma unroll
              for (int u = 0; u < 4; ++u) { ac[u] += *(const f32x4v*)(CW + c * 64 + dg * 16 + u * 4) * w; as[u] += *(const f32x4v*)(SWm + c * 64 + dg * 16 + u * 4) * w; } }
#pragma unroll
          for (int u = 0; u < 4; ++u) { const int d = dg * 16 + u * 4;
              ot[(d + 0) * 136 + kk] = f2bf(ac[u].x); ot[(d + 1) * 136 + kk] = f2bf(ac[u].y); ot[(d + 2) * 136 + kk] = f2bf(ac[u].z); ot[(d + 3) * 136 + kk] = f2bf(ac[u].w);
              ot[(64 + d + 0) * 136 + kk] = f2bf(as[u].x); ot[(64 + d + 1) * 136 + kk] = f2bf(as[u].y); ot[(64 + d + 2) * 136 + kk] = f2bf(as[u].z); ot[(64 + d + 3) * 136 + kk] = f2bf(as[u].w); } }
        __syncthreads();
        bf16_t* WinT = wbf(P, l, WL_WIN);
#pragma unroll
        for (int i = 0; i < 4; ++i) { const int idx = tid + 512 * i, r = idx >> 4, q = idx & 15, which = r >> 6, d = r & 63;
            *(u32x4v*)(WinT + (size_t)(1536 + which * 512 + g * 64 + d) * DM + kc * 128 + q * 8) = *(const u32x4v*)(ot + r * 136 + q * 8); }
        __syncthreads();
    }
}
__device__ __forceinline__ void ph_mod(const Params& P, float* lds, const int wid_s) {
    const int tid = opaque_tid();
    float* cact = lds;
    float* red = lds + 16384;
    if ((int)blockIdx.x >= DEPTH * 96) return;
    for (int idx = tid; idx < NB * DM; idx += NTHR) { const int b = idx >> 10, k = idx & 1023; const float v = P.in[I_C][idx]; cact[k * 16 + b] = v / (1.0f + __expf(-v)); }
    __syncthreads();
    for (int it = blockIdx.x; it < DEPTH * 96; it += gridDim.x) {
        const int l = it / 96, n0 = (it % 96) * 64, ks = tid >> 6, nn = tid & 63;
        float acc[16];
#pragma unroll
        for (int b = 0; b < 16; ++b) acc[b] = 0.f;
        const float* w = P.in[I_ADAW] + ((size_t)l * DM + ks * 128) * 6144 + n0 + nn;
        for (int k = 0; k < 128; ++k) { const float wv = w[(size_t)k * 6144]; const f32x4v* cp = (const f32x4v*)(cact + (ks * 128 + k) * 16);
#pragma unroll
            for (int q = 0; q < 4; ++q) { const f32x4v cv = cp[q]; acc[4 * q] += cv.x * wv; acc[4 * q + 1] += cv.y * wv; acc[4 * q + 2] += cv.z * wv; acc[4 * q + 3] += cv.w * wv; } }
#pragma unroll
        for (int b = 0; b < 16; ++b) red[(ks * 64 + nn) * 16 + b] = acc[b];
        __syncthreads();
        for (int idx = tid; idx < 1024; idx += NTHR) { const int b = idx >> 6, n = idx & 63; float s = P.in[I_ADAB][(size_t)l * 6144 + n0 + n];
#pragma unroll
            for (int q = 0; q < 8; ++q) s += red[(q * 64 + n) * 16 + b];
            ((float*)(P.ws + WS_MOD))[((size_t)l * NB + b) * 6144 + n0 + n] = s; }
        __syncthreads();
    }
}
__device__ __forceinline__ void ph_tw(const Params& P, const int wid_s) {
    f32x2v* TW = (f32x2v*)(P.ws + WS_TW);
    const int tid = opaque_tid();
    for (int j = blockIdx.x * NTHR + tid; j < 8192; j += gridDim.x * NTHR) { float s, c; sincospif((float)j * (1.0f / 4096.0f), &s, &c); TW[j] = (f32x2v){c, -s}; }
}
__device__ __forceinline__ void ph_fh2(const Params& P, float* lds, const int wid_s) {
    const int tid = opaque_tid(), p = tid >> 6, j = tid & 63;
    float* z = lds;
    float* h1 = lds + 8 * 36;
    for (int it = blockIdx.x; it < DEPTH * 512; it += gridDim.x) {
        const int l = it >> 9, pos = (it & 511) * 8 + p;
        if (j < 33) { float v;
            if (j == 0) v = (float)pos / 4095.0f;
            else { const int bi = (j - 1) & 15; const float band = 1e-4f + (float)bi * ((15.0f - 1e-4f) / 15.0f); float s, c; sincospif((float)pos * band * (2.0f / 4096.0f), &s, &c); v = (j <= 16) ? c : -s; }
            z[p * 36 + j] = v; }
        __syncthreads();
        const float fr = P.in[I_FFREQ][l * 64 + j];
        { float a = P.in[I_FB1][l * 64 + j]; const float* w1 = P.in[I_FW1] + (size_t)l * 33 * 64 + j;
          for (int i = 0; i < 33; ++i) a += z[p * 36 + i] * w1[i * 64];
          h1[p * 64 + j] = sinf(fr * a); }
        __syncthreads();
        { float a = P.in[I_FB2][l * 64 + j]; const float* w2 = P.in[I_FW2] + (size_t)l * 64 * 64 + j;
          for (int i = 0; i < 64; ++i) a += h1[p * 64 + i] * w2[i * 64];
          ((float*)(P.ws + WS_FH2))[((size_t)l * SEQ + pos) * 64 + j] = sinf(fr * a); }
        __syncthreads();
    }
}
__device__ __forceinline__ void ph_h3t(const Params& P, int l, float* lds, const int wid_s) {
    const int tid = opaque_tid(), pq = tid & 31, cq = tid >> 5;
    float* AT = lds;
    float* Bs = lds + 64 * 132;
    const float* FH2 = (const float*)(P.ws + WS_FH2) + (size_t)l * SEQ * 64; const float* w3 = P.in[I_FW3] + (size_t)l * 64 * 2048; float* H3T = (float*)(P.ws + WS_H3T);
    for (int it = blockIdx.x; it < 32 * 16; it += gridDim.x) {
        const int p0 = (it & 31) * 128, c0 = (it >> 5) * 128;
#pragma unroll
        for (int i = 0; i < 16; ++i) { const int idx = tid + 512 * i; { const int r = idx >> 6, q = idx & 63; AT[q * 132 + r] = FH2[(size_t)(p0 + r) * 64 + q]; } { const int q = idx >> 7, cc = idx & 127; Bs[q * 128 + cc] = w3[(size_t)q * 2048 + c0 + cc]; } }
        __syncthreads();
        f32x4v acc[8];
#pragma unroll
        for (int j = 0; j < 8; ++j) acc[j] = (f32x4v){0.f, 0.f, 0.f, 0.f};
#pragma unroll 4
        for (int q = 0; q < 64; ++q) { const f32x4v a = *(const f32x4v*)(AT + q * 132 + pq * 4), b0 = *(const f32x4v*)(Bs + q * 128 + cq * 8), b1 = *(const f32x4v*)(Bs + q * 128 + cq * 8 + 4);
            acc[0] += a * b0.x; acc[1] += a * b0.y; acc[2] += a * b0.z; acc[3] += a * b0.w; acc[4] += a * b1.x; acc[5] += a * b1.y; acc[6] += a * b1.z; acc[7] += a * b1.w; }
#pragma unroll
        for (int j = 0; j < 8; ++j) *(f32x4v*)(H3T + (size_t)(c0 + cq * 8 + j) * SEQ + p0 + pq * 4) = acc[j];
        __syncthreads();
    }
}
__device__ __forceinline__ void ph_kf(const Params& P, int l, float* lds, const int wid_s) {
    const int tid = opaque_tid(), hh = tid >> 8, t = tid & 255;
    f32x4v* buf = (f32x4v*)lds + hh * PBUF; float* red = (float*)((f32x4v*)lds + hh * PBUF);
    const f32x2v* TW = (const f32x2v*)(P.ws + WS_TW); const float* H3T = (const float*)(P.ws + WS_H3T); f16x4v* KF = (f16x4v*)(P.ws + WS_KF);
    const float min_decay = -4.605170185988091f / 1.5f, max_decay = -4.605170185988091f / 0.3f;
    for (int it0 = blockIdx.x * 2; it0 < 2 * DH; it0 += gridDim.x * 2) {
        const int it = it0 + hh, n = it >> 9, c = it & 511;
        int tv = t; asm volatile("" : "+v"(tv));
        const float ad = fabsf(min_decay + (float)c * ((max_decay - min_decay) / 511.0f));
        const float* fw = H3T + (size_t)(n * 1024 + c) * SEQ; const float* bw = H3T + (size_t)(n * 1024 + 512 + c) * SEQ;
        float fr[16], br[16]; float l1 = 0.f;
#pragma unroll
        for (int j = 0; j < 16; ++j) { const int m = tv + 256 * j;
            const float f = fw[m] * __expf(-((float)m * (1.0f / 4095.0f)) * ad);
            const float b = (m == 0) ? 0.f : bw[SEQ - m] * __expf(-((float)(SEQ - m) * (1.0f / 4095.0f)) * ad);
            l1 += fabsf(f) + fabsf(b); fr[j] = f; br[j] = b; }
        l1 = wave_sum(l1);
        __syncthreads();
        if ((tid & 63) == 0) red[(tid >> 6) & 3] = l1;
        __syncthreads();
        const float tot = red[0] + red[1] + red[2] + red[3];
        const float sc = 1.0f / (tot + 1e-6f);
        f32x2v wt = TW[tv]; asm volatile("" : "+v"(wt.x), "+v"(wt.y));
        f32x2v xr[16], xi[16];
#pragma unroll
        for (int j = 0; j < 16; ++j) { const f32x2v wj = w32(j); const float wx = wt.x * wj.x - wt.y * wj.y, wy = wt.x * wj.y + wt.y * wj.x; const float s = (fr[j] + br[j]) * sc, d = (fr[j] - br[j]) * sc;
            xr[j] = (f32x2v){s, d * wx}; xi[j] = (f32x2v){0.f, d * wy}; }
        fft4096_pk(xr, xi, buf, tv, TW);
        const float dsk = P.in[I_HD][(size_t)l * 2 * DH + it];
        f16x4v* o = KF + (size_t)it * SEQ;
#pragma unroll
        for (int j = 0; j < 16; ++j) o[tv + 256 * j] = (f16x4v){(_Float16)(xr[j].x + dsk), (_Float16)(xr[j].y + dsk), (_Float16)xi[j].x, (_Float16)xi[j].y};
    }
    __syncthreads();
}
__device__ __forceinline__ void ld8f(const float* p, float (&f)[16], int o) { const f32x4v a = *(const f32x4v*)p, b = *(const f32x4v*)(p + 4); f[o] = a.x; f[o + 1] = a.y; f[o + 2] = a.z; f[o + 3] = a.w; f[o + 4] = b.x; f[o + 5] = b.y; f[o + 6] = b.z; f[o + 7] = b.w; }
__device__ __forceinline__ void un8(const u32x4v w, float (&f)[16], int o) {
    f[o] = __uint_as_float(w.x << 16); f[o + 1] = __uint_as_float(w.x & 0xffff0000u); f[o + 2] = __uint_as_float(w.y << 16); f[o + 3] = __uint_as_float(w.y & 0xffff0000u);
    f[o + 4] = __uint_as_float(w.z << 16); f[o + 5] = __uint_as_float(w.z & 0xffff0000u); f[o + 6] = __uint_as_float(w.w << 16); f[o + 7] = __uint_as_float(w.w & 0xffff0000u);
}
template <int XI, int XO>
__device__ __forceinline__ void ph_resnorm(const void* xin_, void* xout_, const bf16_t* y, const bf16_t* y_hi  , const float* gpost, const float* gate, const float* gnext, const float* scale, const float* shift, bf16_t* hout, const int wid_s) {
    constexpr int RW = 4;
    const int tid = opaque_tid(); const int lane = tid & 63, wv = tid >> 6;
    for (int row0 = (blockIdx.x * 8 + wv) * RW; row0 < NTOK; row0 += gridDim.x * 8 * RW) {
        const int b = row0 >> 12; float x[RW][16]; u32x4v yw[RW][2];
        const bf16_t* ysel = (row0 < HTOK) ? y : y_hi - (size_t)HTOK * DM;
#pragma unroll
        for (int r = 0; r < RW; ++r)
#pragma unroll
            for (int q = 0; q < 2; ++q) { const size_t off = (size_t)(row0 + r) * DM + q * 512 + lane * 8;
                if (XI) un8(__builtin_nontemporal_load((const u32x4v*)((const bf16_t*)xin_ + off)), x[r], q * 8);
                else { const f32x4v a = __builtin_nontemporal_load((const f32x4v*)((const float*)xin_ + off)), c = __builtin_nontemporal_load((const f32x4v*)((const float*)xin_ + off + 4));
                    x[r][q * 8] = a.x; x[r][q * 8 + 1] = a.y; x[r][q * 8 + 2] = a.z; x[r][q * 8 + 3] = a.w; x[r][q * 8 + 4] = c.x; x[r][q * 8 + 5] = c.y; x[r][q * 8 + 6] = c.z; x[r][q * 8 + 7] = c.w; }
                if (y) yw[r][q] = __builtin_nontemporal_load((const u32x4v*)(ysel + off)); }
        if (y) {
            float g[16], gt[16];
#pragma unroll
            for (int q = 0; q < 2; ++q) { ld8f(gpost + q * 512 + lane * 8, g, q * 8); ld8f(gate + (size_t)b * 6144 + q * 512 + lane * 8, gt, q * 8); }
#pragma unroll
            for (int e = 0; e < 16; ++e) g[e] *= gt[e];
#pragma unroll
            for (int r = 0; r < RW; ++r) {
                float yv[16]; un8(yw[r][0], yv, 0); un8(yw[r][1], yv, 8); float ss = 0.f;
#pragma unroll
                for (int e = 0; e < 16; ++e) ss += yv[e] * yv[e];
                ss = wave_sum(ss); const float rinv = rsqrtf(ss * (1.0f / 1024.0f) + 1e-6f);
#pragma unroll
                for (int e = 0; e < 16; ++e) x[r][e] += g[e] * (yv[e] * rinv);
#pragma unroll
                for (int q = 0; q < 2; ++q) { const size_t off = (size_t)(row0 + r) * DM + q * 512 + lane * 8; const float* xs = &x[r][q * 8];
                    if (XO) { const u32x4v w = (u32x4v){pack2(xs[0], xs[1]), pack2(xs[2], xs[3]), pack2(xs[4], xs[5]), pack2(xs[6], xs[7])}; __builtin_nontemporal_store(w, (u32x4v*)((bf16_t*)xout_ + off)); un8(w, x[r], q * 8); }
                    else { __builtin_nontemporal_store((f32x4v){xs[0], xs[1], xs[2], xs[3]}, (f32x4v*)((float*)xout_ + off)); __builtin_nontemporal_store((f32x4v){xs[4], xs[5], xs[6], xs[7]}, (f32x4v*)((float*)xout_ + off + 4)); } }
            }
        }
        if (hout) {
            float g[16], sc[16], sh[16];
#pragma unroll
            for (int q = 0; q < 2; ++q) { ld8f(gnext + q * 512 + lane * 8, g, q * 8); ld8f(scale + (size_t)b * 6144 + q * 512 + lane * 8, sc, q * 8); ld8f(shift + (size_t)b * 6144 + q * 512 + lane * 8, sh, q * 8); }
#pragma unroll
            for (int e = 0; e < 16; ++e) g[e] *= (sc[e] + 1.0f);
#pragma unroll
            for (int r = 0; r < RW; ++r) {
                float ss = 0.f;
#pragma unroll
                for (int e = 0; e < 16; ++e) ss += x[r][e] * x[r][e];
                ss = wave_sum(ss); const float rinv = rsqrtf(ss * (1.0f / 1024.0f) + 1e-6f);
#pragma unroll
                for (int q = 0; q < 2; ++q) { float hv[8];
#pragma unroll
                    for (int e = 0; e < 8; ++e) hv[e] = x[r][q * 8 + e] * rinv * g[q * 8 + e] + sh[q * 8 + e];
                    *(u32x4v*)(hout + (size_t)(row0 + r) * DM + q * 512 + lane * 8) = (u32x4v){pack2(hv[0], hv[1]), pack2(hv[2], hv[3]), pack2(hv[4], hv[5]), pack2(hv[6], hv[7])}; }
            }
        }
    }
}
__device__ __forceinline__ void stage_sconv(const bf16_t* PT, int col, int b0, float w0, float w1, float w2, float bs, float* gl, int t) {
    const int rsel = t >> 7, seg = t & 127;
#pragma unroll
    for (int q = 0; q < 2; ++q) {
        const int e0 = q * 2048 + seg * 16; const bf16_t* row = PT + ((size_t)(b0 + rsel) * NPT + col) * SEQ + e0;
        const u32x4v A = *(const u32x4v*)row, B = *(const u32x4v*)(row + 8);
        float e[18]; e[0] = e0 ? bf2f(row[-1]) : 0.f; e[17] = (e0 + 16 < SEQ) ? bf2f(row[16]) : 0.f;
        e[1] = __uint_as_float(A.x << 16); e[2] = __uint_as_float(A.x & 0xffff0000u); e[3] = __uint_as_float(A.y << 16); e[4] = __uint_as_float(A.y & 0xffff0000u);
        e[5] = __uint_as_float(A.z << 16); e[6] = __uint_as_float(A.z & 0xffff0000u); e[7] = __uint_as_float(A.w << 16); e[8] = __uint_as_float(A.w & 0xffff0000u);
        e[9] = __uint_as_float(B.x << 16); e[10] = __uint_as_float(B.x & 0xffff0000u); e[11] = __uint_as_float(B.y << 16); e[12] = __uint_as_float(B.y & 0xffff0000u);
        e[13] = __uint_as_float(B.z << 16); e[14] = __uint_as_float(B.z & 0xffff0000u); e[15] = __uint_as_float(B.w << 16); e[16] = __uint_as_float(B.w & 0xffff0000u);
        f32x4v* o = (f32x4v*)(gl + rsel * SEQ + e0);
#pragma unroll
        for (int u = 0; u < 4; ++u) { f32x4v v;
            v.x = bs + e[4 * u] * w0 + e[4 * u + 1] * w1 + e[4 * u + 2] * w2; v.y = bs + e[4 * u + 1] * w0 + e[4 * u + 2] * w1 + e[4 * u + 3] * w2;
            v.z = bs + e[4 * u + 2] * w0 + e[4 * u + 3] * w1 + e[4 * u + 4] * w2; v.w = bs + e[4 * u + 3] * w0 + e[4 * u + 4] * w1 + e[4 * u + 5] * w2; o[u] = v; }
    }
}
__device__ __forceinline__ void store_rows2(const float (&v0)[16], const float (&v1)[16], bf16_t* st, bf16_t* o0, bf16_t* o1, int tv) {
#pragma unroll
    for (int j = 0; j < 16; ++j) { const unsigned w = pack2(v0[j], v1[j]); st[tv + 256 * j] = (bf16_t)(w & 0xffffu); st[SEQ + tv + 256 * j] = (bf16_t)(w >> 16); }
    __syncthreads();
    const int r = tv >> 7, seg = tv & 127; bf16_t* o = r ? o1 : o0;
#pragma unroll
    for (int q = 0; q < 4; ++q) *(u32x4v*)(o + q * 1024 + seg * 8) = *(const u32x4v*)(st + r * SEQ + q * 1024 + seg * 8);
}
__device__ __forceinline__ void ph_mix(const Params& P, int l, float* lds, const int wid_s) {
    const int tid = opaque_tid(), hh = tid >> 8, t = tid & 255;
    f32x4v* buf = (f32x4v*)lds + hh * PBUF; float* gl = (float*)buf;
    const f32x2v* TW = (const f32x2v*)(P.ws + WS_TW); const unsigned char* KF = P.ws + WS_KF; unsigned char* kfl = (unsigned char*)lds + LDS_KF;
    const bf16_t* PT = (const bf16_t*)(P.ws + WS_PT); bf16_t* YT = (bf16_t*)(P.ws + WS_YT);
    const float* sw = P.in[I_SW] + (size_t)l * 3 * 1536; const float* sb = P.in[I_SB] + (size_t)l * 1536;
    if ((int)blockIdx.x * 2 < DH * 8) kf_dma(KF + (size_t)(blockIdx.x >> 2) * 32768, kfl, tid);
    for (int it0 = blockIdx.x * 2; it0 < DH * 8; it0 += gridDim.x * 2) {
        const int it = it0 + hh, c = it >> 3, bp = it & 7, b0 = 2 * bp;
        int tv = t; asm volatile("" : "+v"(tv));
        float zr[16], zi[16];
        __syncthreads();
        stage_sconv(PT, c, b0, sw[c], sw[1536 + c], sw[3072 + c], sb[c], gl, tv);
        __syncthreads();
#pragma unroll
        for (int j = 0; j < 16; ++j) { zr[j] = gl[tv + 256 * j]; zi[j] = gl[SEQ + tv + 256 * j]; }
#pragma unroll 1
        for (int n = 0; n < 2; ++n) {
            f32x2v wt = TW[tv]; asm volatile("" : "+v"(wt.x), "+v"(wt.y));
            f32x2v xr[16], xi[16];
#pragma unroll
            for (int j = 0; j < 16; ++j) { const f32x2v wj = w32(j); const float wx = wt.x * wj.x - wt.y * wj.y, wy = wt.x * wj.y + wt.y * wj.x;
                xr[j] = (f32x2v){zr[j], zr[j] * wx - zi[j] * wy}; xi[j] = (f32x2v){zi[j], zr[j] * wy + zi[j] * wx}; }
            fft4096_pk(xr, xi, buf, tv, TW);
#pragma unroll
            for (int j = 0; j < 16; ++j) asm volatile("" : "+v"(xr[j]), "+v"(xi[j]));
            asm volatile("s_waitcnt vmcnt(0)" ::: "memory"); __syncthreads();
#pragma unroll
            for (int j = 0; j < 16; ++j) { const f16x4v k = *(const f16x4v*)(kfl + (tv + 256 * j) * 8); const f32x2v kr = (f32x2v){(float)k.x, (float)k.y}, ki = (f32x2v){(float)k.z, (float)k.w};
                const f32x2v pr = xr[j] * kr - xi[j] * ki, pi = xr[j] * ki + xi[j] * kr; xr[j] = pr; xi[j] = -pi; }
            __syncthreads();
            { const int cn = (n == 0) ? c : ((it0 + (int)gridDim.x * 2) >> 3);
              if (n == 0 || it0 + (int)gridDim.x * 2 < DH * 8) kf_dma(KF + (size_t)((1 - n) * DH + cn) * 32768, kfl, tid); }
            fft4096_pk(xr, xi, buf, tv, TW);
            const int col = (n + 1) * DH + c;
            __syncthreads();
            stage_sconv(PT, col, b0, sw[col] * (1.0f / 8192.0f), sw[1536 + col] * (1.0f / 8192.0f), sw[3072 + col] * (1.0f / 8192.0f), sb[col] * (1.0f / 8192.0f), gl, tv);
            __syncthreads();
#pragma unroll
            for (int j = 0; j < 16; ++j) { const int m = tv + 256 * j; const f32x2v wj = w32(j); const float wx = wt.x * wj.x - wt.y * wj.y, wy = wt.x * wj.y + wt.y * wj.x;
                const float er = xr[j].x, ei = -xi[j].x, orr = xr[j].y, oi = -xi[j].y;
                const float cr = er + (orr * wx + oi * wy), ci = ei + (oi * wx - orr * wy);
                zr[j] = gl[m] * cr; zi[j] = gl[SEQ + m] * ci; }
        }
        bf16_t* o0 = YT + ((size_t)b0 * DM + c) * SEQ;
        store_rows2(zr, zi, (bf16_t*)(gl + 2 * SEQ), o0, o0 + (size_t)DM * SEQ, tv);
    }
#ifndef REP_FNET
#define REP_FNET 1
#endif
    for (int rep = 0; rep < REP_FNET; ++rep)
    for (int it0 = blockIdx.x * 2; it0 < NB * DH / 2; it0 += gridDim.x * 2) {
        const int s = 2 * (it0 + hh), b = s >> 9, ch = s & 511;
        int tv = t; asm volatile("" : "+v"(tv));
        const bf16_t* ra = PT + ((size_t)b * NPT + 1536 + ch) * SEQ; const bf16_t* rb = PT + ((size_t)b * NPT + 2048 + ch) * SEQ;
        bf16_t* sta = (bf16_t*)gl; bf16_t* stb = sta + 2 * SEQ;
        __syncthreads();
        { u32x4v va[4], vb[4];
#pragma unroll
          for (int q = 0; q < 4; ++q) { va[q] = *(const u32x4v*)(ra + (q * 256 + tv) * 8); vb[q] = *(const u32x4v*)(rb + (q * 256 + tv) * 8); }
#pragma unroll
          for (int q = 0; q < 4; ++q) { *(u32x4v*)(sta + (q * 256 + tv) * 8) = va[q]; *(u32x4v*)(stb + (q * 256 + tv) * 8) = vb[q]; } }
        __syncthreads();
        f32x2v xr[16], xi[16];
#pragma unroll
        for (int j = 0; j < 16; ++j) { const int m = tv + 256 * j; xr[j] = (f32x2v){bf2f(sta[m]), bf2f(sta[SEQ + m])}; xi[j] = (f32x2v){-bf2f(stb[m]), -bf2f(stb[SEQ + m])}; }
        fft4096_pk(xr, xi, buf, tv, TW);
        float o0v[16], o1v[16];
#pragma unroll
        for (int j = 0; j < 16; ++j) { o0v[j] = xr[j].x; o1v[j] = xr[j].y; }
        __syncthreads();
        bf16_t* o = YT + ((size_t)b * DM + 512 + ch) * SEQ;
        store_rows2(o0v, o1v, (bf16_t*)gl, o, o + SEQ, tv);
    }
    __syncthreads();
}
__device__ __forceinline__ void ph_transpose(const Params& P, float* lds, const int wid_s) {
    const int tid = opaque_tid(); bf16_t* tile = (bf16_t*)lds;
    const bf16_t* YT = (const bf16_t*)(P.ws + WS_YT); bf16_t* Y = (bf16_t*)(P.ws + WS_Y);
    for (int it = blockIdx.x; it < NB * 4 * 64; it += gridDim.x) {
        const int b = it >> 8, cq = (it >> 6) & 3, lt = it & 63;
        { const int r = tid >> 3, q = tid & 7; u32x4v v[4];
#pragma unroll
          for (int u = 0; u < 4; ++u) v[u] = *(const u32x4v*)(YT + ((size_t)b * DM + cq * 256 + u * 64 + r) * SEQ + lt * 64 + q * 8);
#pragma unroll
          for (int u = 0; u < 4; ++u) *(u32x4v*)(tile + (u * 64 + r) * 72 + q * 8) = v[u]; }
        __syncthreads();
        { const int lr = tid >> 3, q = tid & 7;
#pragma unroll
          for (int u = 0; u < 4; ++u) { unsigned w[4];
#pragma unroll
            for (int i = 0; i < 4; ++i) w[i] = (unsigned)tile[(u * 64 + q * 8 + 2 * i) * 72 + lr] | ((unsigned)tile[(u * 64 + q * 8 + 2 * i + 1) * 72 + lr] << 16);
            *(u32x4v*)(Y + ((size_t)b * SEQ + lt * 64 + lr) * DM + cq * 256 + u * 64 + q * 8) = (u32x4v){w[0], w[1], w[2], w[3]}; } }
        __syncthreads();
    }
}
__device__ __forceinline__ void unpack8(const u32x4v w, float (&f)[8]) {
    f[0] = __uint_as_float(w.x << 16); f[1] = __uint_as_float(w.x & 0xffff0000u); f[2] = __uint_as_float(w.y << 16); f[3] = __uint_as_float(w.y & 0xffff0000u);
    f[4] = __uint_as_float(w.z << 16); f[5] = __uint_as_float(w.z & 0xffff0000u); f[6] = __uint_as_float(w.w << 16); f[7] = __uint_as_float(w.w & 0xffff0000u);
}
__device__ __forceinline__ void ph_geglu(const Params& P, int l, const int wid_s) {
    const bf16_t* U = (const bf16_t*)(P.ws + WS_U); bf16_t* G = (bf16_t*)(P.ws + WS_G);
    const float* dww = P.in[I_DWW] + (size_t)l * 3 * DUP; const float* dwb = P.in[I_DWB] + (size_t)l * DUP;
    const int tid = opaque_tid();
    if (tid < DFF / 8) {
        const int f0 = tid * 8;
        float wa[3][8], wb[3][8], ba[8], bb[8];
#pragma unroll
        for (int k = 0; k < 3; ++k) { const f32x4v a0 = *(const f32x4v*)(dww + k * DUP + f0), a1 = *(const f32x4v*)(dww + k * DUP + f0 + 4), b0 = *(const f32x4v*)(dww + k * DUP + DFF + f0), b1 = *(const f32x4v*)(dww + k * DUP + DFF + f0 + 4);
            wa[k][0] = a0.x; wa[k][1] = a0.y; wa[k][2] = a0.z; wa[k][3] = a0.w; wa[k][4] = a1.x; wa[k][5] = a1.y; wa[k][6] = a1.z; wa[k][7] = a1.w;
            wb[k][0] = b0.x; wb[k][1] = b0.y; wb[k][2] = b0.z; wb[k][3] = b0.w; wb[k][4] = b1.x; wb[k][5] = b1.y; wb[k][6] = b1.z; wb[k][7] = b1.w; }
        { const f32x4v a0 = *(const f32x4v*)(dwb + f0), a1 = *(const f32x4v*)(dwb + f0 + 4), b0 = *(const f32x4v*)(dwb + DFF + f0), b1 = *(const f32x4v*)(dwb + DFF + f0 + 4);
          ba[0] = a0.x; ba[1] = a0.y; ba[2] = a0.z; ba[3] = a0.w; ba[4] = a1.x; ba[5] = a1.y; ba[6] = a1.z; ba[7] = a1.w; bb[0] = b0.x; bb[1] = b0.y; bb[2] = b0.z; bb[3] = b0.w; bb[4] = b1.x; bb[5] = b1.y; bb[6] = b1.z; bb[7] = b1.w; }
        const u32x4v zero = (u32x4v){0u, 0u, 0u, 0u};
        for (int blk = blockIdx.x; blk < HTOK / 128; blk += gridDim.x) {
            const int rbeg = blk * 128; const bool halo_lo = (rbeg & (SEQ - 1)) != 0, halo_hi = ((rbeg + 128) & (SEQ - 1)) != 0;
            const bf16_t* ua = U + (size_t)rbeg * DUP + f0; const bf16_t* ub = ua + DFF; bf16_t* go = G + (size_t)rbeg * DFF + f0;
            u32x4v ra[4], rb[4];
#pragma unroll
            for (int j = 0; j < 4; ++j) { ra[j] = __builtin_nontemporal_load((const u32x4v*)(ua + (size_t)j * DUP)); rb[j] = __builtin_nontemporal_load((const u32x4v*)(ub + (size_t)j * DUP)); }
            float pa[8], pb[8], ca[8], cb[8], na[8], nb[8];
            { const u32x4v ha = halo_lo ? *(const u32x4v*)(ua - DUP) : zero, hb = halo_lo ? *(const u32x4v*)(ub - DUP) : zero; unpack8(ha, pa); unpack8(hb, pb); }
            unpack8(ra[0], ca); unpack8(rb[0], cb);
            for (int o = 0; o < 32; ++o) {
#pragma unroll
                for (int j = 0; j < 4; ++j) {
                    const int s = o * 4 + j;
                    { const bool last = (o == 31) && (j == 3); const bool ok = !last || halo_hi; unpack8(ok ? ra[(j + 1) & 3] : zero, na); unpack8(ok ? rb[(j + 1) & 3] : zero, nb); }
                    if (o < 31 || j == 0) { const int rr = (s + 4 < HTOK - rbeg) ? s + 4 : s;
                        ra[j] = __builtin_nontemporal_load((const u32x4v*)(ua + (size_t)rr * DUP)); rb[j] = __builtin_nontemporal_load((const u32x4v*)(ub + (size_t)rr * DUP)); }
                    float ov[8];
#pragma unroll
                    for (int e = 0; e < 8; e += 2) {
                        const f32x2v av = (f32x2v){ba[e] + pa[e] * wa[0][e] + ca[e] * wa[1][e] + na[e] * wa[2][e], ba[e + 1] + pa[e + 1] * wa[0][e + 1] + ca[e + 1] * wa[1][e + 1] + na[e + 1] * wa[2][e + 1]};
                        const f32x2v gv = pg8::gelu_pk(av);
                        ov[e] = gv.x * (bb[e] + pb[e] * wb[0][e] + cb[e] * wb[1][e] + nb[e] * wb[2][e]);
                        ov[e + 1] = gv.y * (bb[e + 1] + pb[e + 1] * wb[0][e + 1] + cb[e + 1] * wb[1][e + 1] + nb[e + 1] * wb[2][e + 1]); }
                    *(u32x4v*)(go + (size_t)s * DFF) = (u32x4v){pack2(ov[0], ov[1]), pack2(ov[2], ov[3]), pack2(ov[4], ov[5]), pack2(ov[6], ov[7])};
#pragma unroll
                    for (int e = 0; e < 8; ++e) { pa[e] = ca[e]; pb[e] = cb[e]; ca[e] = na[e]; cb[e] = nb[e]; }
                }
            }
        }
    }
}
constexpr int N_PHASES = 2 + 11 * DEPTH;
#ifndef NT_MODE
#define NT_MODE 1
#endif
#define NT_MASK(ld) ((NT_MODE == 1) ? ((ld) == DUP) : (NT_MODE == 2 ? 1 : 0))
#ifndef REP_PRO
#define REP_PRO 1
#endif
#ifndef REP_MIX
#define REP_MIX 1
#endif
#ifndef REP_GEGLU
#define REP_GEGLU 1
#endif
#ifndef REP_TR
#define REP_TR 1
#endif
#ifndef REP_GEMM
#define REP_GEMM 1
#endif
#ifndef MK_MULTI_LAUNCH
#define MK_MULTI_LAUNCH 0
#endif
__global__ __launch_bounds__(512, 2) void mk_fwd(Params P) {
    extern __shared__ __attribute__((aligned(16))) unsigned char smem[];
    float* lds = (float*)smem;
    cg::grid_group grid = cg::this_grid();
    const int wid_s = __builtin_amdgcn_readfirstlane((int)threadIdx.x >> 6);
    unsigned xst0 = 0u, xst1 = 0u;
    const XcdBarrier xb = xcd_barrier_post((unsigned*)(P.ws + WS_BAR), nullptr);
    bf16_t* H = (bf16_t*)(P.ws + WS_H);
    bf16_t* XB = (bf16_t*)(P.ws + WS_XB);
    for (int ph = P.ph_lo; ph < P.ph_hi; ++ph) {
        if (ph > P.ph_lo) { if (ph == 1) grid.sync(); else { xcd_barrier(xb, xst0, xst1, wid_s == 0 && lane_now() == 0); xst0 = __builtin_amdgcn_readfirstlane(xst0); xst1 = __builtin_amdgcn_readfirstlane(xst1); } }
        const int l = ph >= 2 ? (ph - 2) / 11 : -1, k = ph >= 2 ? (ph - 2) % 11 : -1;
        int ng = 0;
        if (ph == 0) { ph_tconv(P, lds, wid_s); ph_fold(P, lds, wid_s); ph_mod(P, lds, wid_s); ph_tw(P, wid_s); ph_fh2(P, lds, wid_s); }
        else if (ph == 1) { ph_h3t(P, 0, lds, wid_s); ph_resnorm<0, 0>(P.in[I_X], nullptr, nullptr, nullptr, nullptr, nullptr, P.in[I_GMPRE], modp(P, 0, 1), modp(P, 0, 0), H, wid_s); }
        else if (k == 0) { if (l == 0) ph_kf(P, 0, lds, wid_s); ng = 1; }
        else if (k == 1) { ph_mix(P, l, lds, wid_s); }
        else if (k == 2) { ph_transpose(P, lds, wid_s); if (l + 1 < DEPTH) ph_h3t(P, l + 1, lds, wid_s); }
        else if (k == 3) { ng = 1; }
        else if (k == 4) {
            if (l == 0) ph_resnorm<0, 1>(P.in[I_X], XB, (const bf16_t*)(P.ws + WS_YO), (const bf16_t*)(P.ws + WS_YO) + (size_t)HTOK * DM, P.in[I_GMPOST] + l * DM, modp(P, l, 2), P.in[I_GFPRE] + l * DM, modp(P, l, 4), modp(P, l, 3), H, wid_s);
            else ph_resnorm<1, 1>(XB, XB, (const bf16_t*)(P.ws + WS_YO), (const bf16_t*)(P.ws + WS_YO) + (size_t)HTOK * DM, P.in[I_GMPOST] + l * DM, modp(P, l, 2), P.in[I_GFPRE] + l * DM, modp(P, l, 4), modp(P, l, 3), H, wid_s);
            if (l + 1 < DEPTH) ph_kf(P, l + 1, lds, wid_s); }
        else if (k == 5 || k == 9) { ng = 1; }
        else if (k == 6 || k == 8) { ph_geglu(P, l, wid_s); }
        else if (k == 7) { ng = 2; }
        else { const bool more = (l + 1 < DEPTH);
            if (more) ph_resnorm<1, 1>(XB, XB, (const bf16_t*)(P.ws + WS_YD0), (const bf16_t*)(P.ws + WS_YD1), P.in[I_GFPOST] + l * DM, modp(P, l, 5), P.in[I_GMPRE] + (l + 1) * DM, modp(P, l + 1, 1), modp(P, l + 1, 0), H, wid_s);
            else ph_resnorm<1, 0>(XB, P.out, (const bf16_t*)(P.ws + WS_YD0), (const bf16_t*)(P.ws + WS_YD1), P.in[I_GFPOST] + l * DM, modp(P, l, 5), nullptr, nullptr, nullptr, nullptr, wid_s); }
        for (int gi = 0; gi < ng; ++gi) {
            const bf16_t* gA; const bf16_t* gB; int gM, gN, gK, gld, gsplit = 0; size_t gstride = 0; bf16_t* gO;
            if (k == 0) { gA = wbf(P, l, WL_WIN); gB = H; gM = NPT; gN = NTOK; gK = DM; gO = (bf16_t*)(P.ws + WS_PT); gld = SEQ; gsplit = SEQ; gstride = (size_t)NPT * SEQ; }
            else if (k == 3) { gA = (const bf16_t*)(P.ws + WS_Y); gB = wbf(P, l, WL_WOUT); gM = NTOK; gN = DM; gK = DM; gO = (bf16_t*)(P.ws + WS_YO); gld = DM; }
            else if (k == 5 || (k == 7 && gi == 1)) { const int hf = (k == 7); gA = H + (size_t)hf * HTOK * DM; gB = wbf(P, l, WL_WUP); gM = HTOK; gN = DUP; gK = DM; gO = (bf16_t*)(P.ws + WS_U); gld = DUP; }
            else { const int hf = (k == 9); gA = (const bf16_t*)(P.ws + WS_G); gB = wbf(P, l, WL_WDN); gM = HTOK; gN = DM; gK = DFF; gO = (bf16_t*)(P.ws + (hf ? WS_YD1 : WS_YD0)); gld = DM; }
            __syncthreads();
            pg8::Gemm g{gA, gB, gM, gN, gK}; pg8::StaticOrder S; S.init(gM, gN, (int)gridDim.x, (int)blockIdx.x);
            pg8::EpiBf16<0> E{gO, gld, nullptr, gsplit, gstride, gld == DUP};
            pg8::gemm_phase<pg8::EpiBf16<0>, pg8::StaticOrder, false>((PG8_LAS unsigned char*)smem, g, S, E, nullptr, wid_s);
            __syncthreads();
        }
    }
}

extern "C" void kernel_launch(void* const* d_in, const int* in_sizes, int n_in, void* d_out, int out_size, void* d_ws, size_t ws_size, hipStream_t stream) {
    static int grid = 0;
    if (grid == 0) {
        if (n_in != 24 || out_size != NTOK * DM || ws_size < WS_NEED) { fprintf(stderr, "kernel_launch: unexpected shapes (n_in %d out %d ws %zu need %zu)\n", n_in, out_size, ws_size, (size_t)WS_NEED); grid = -1; return; }
        int dev = 0, cus = 0, per_cu = 0;
        hipGetDevice(&dev); hipDeviceGetAttribute(&cus, hipDeviceAttributeMultiprocessorCount, dev);
        if (hipFuncSetAttribute((const void*)mk_fwd, hipFuncAttributeMaxDynamicSharedMemorySize, LDS_BYTES) != hipSuccess) { fprintf(stderr, "kernel_launch: hipFuncSetAttribute failed\n"); grid = -1; return; }
        hipOccupancyMaxActiveBlocksPerMultiprocessor(&per_cu, (const void*)mk_fwd, NTHR, LDS_BYTES);
        (void)hipGetLastError();
        if (per_cu < 1) fprintf(stderr, "kernel_launch: occupancy query says %d blocks per CU\n", per_cu);
        grid = cus > 0 ? cus : 256;
    }
    if (grid < 0) return;
    Params p{};
    for (int i = 0; i < 24; ++i) p.in[i] = (const float*)d_in[i];
    p.out = (float*)d_out; p.ws = (unsigned char*)d_ws;
#if MK_MULTI_LAUNCH
    for (int ph = 0; ph < N_PHASES; ++ph) { p.ph_lo = ph; p.ph_hi = ph + 1; hipLaunchKernelGGL(mk_fwd, dim3(grid), dim3(NTHR), LDS_BYTES, stream, p); }
#else
    p.ph_lo = 0; p.ph_hi = N_PHASES;
    if (hipMemsetAsync((unsigned char*)d_ws + WS_BAR, 0, XCD_BAR_WORDS * 4, stream) != hipSuccess) { fprintf(stderr, "kernel_launch: memset of the barrier words failed\n"); return; }
    void* args[] = {&p};
    hipError_t e = hipLaunchCooperativeKernel((const void*)mk_fwd, dim3(grid), dim3(NTHR), args, LDS_BYTES, stream);
    if (e != hipSuccess) fprintf(stderr, "cooperative launch failed: %s (grid %d)\n", hipGetErrorString(e), grid);
#endif
}
```

```cpp
#include <hip/hip_runtime.h>
#include <hip/hip_cooperative_groups.h>
#include <cstdio>
namespace cg = cooperative_groups;
#define MK_MULTI_LAUNCH 0
namespace pg8 {
#define PG8_LAS __attribute__((address_space(3)))
typedef unsigned short bf16_t;
typedef short bf16x8 __attribute__((ext_vector_type(8)));
typedef float f32x4 __attribute__((ext_vector_type(4)));
typedef unsigned u32x4 __attribute__((ext_vector_type(4)));
constexpr int BM = 256, BK = 64, HALF = 128, HTB = HALF * BK * 2  , STAGE_BYTES = 8 * HTB, NXCD = 8, WGM = 8;

__host__ __device__ __forceinline__ int lds_byte(int r, int c) { const int st = (r >> 4) * 2 + (c >> 5), rr = r & 15, cc = c & 31, ob = rr * 64 + cc * 2; return st * 1024 + (ob ^ (((ob >> 9) & 1) << 5)); }
__host__ __device__ __forceinline__ void stage_rc(int b, int& R, int& C) { const int st = b / 1024, sb = b % 1024, swz = sb ^ (((sb >> 9) & 1) << 5); R = (st >> 1) * 16 + swz / 64; C = (st & 1) * 32 + (swz % 64) / 2; }
__host__ __device__ __forceinline__ int perm32(int rho) { const int n = rho >> 4, i = rho & 15; return 8 * (i >> 2) + 4 * n + (i & 3); }

struct Unit { int pm, pn; };
struct Gemm { const bf16_t* A; const bf16_t* Bt; int M, N, K; };

struct StaticOrder {
    int nM, nN, nwg, G, c;
    __host__ __device__ void init(int M, int N, int G_, int c_) { nM = M / BM; nN = N / BM; nwg = nM * nN; G = G_; c = c_; }
    __host__ __device__ bool next(int i, Unit& u) const {
        const long L = (long)i * G + c; if (L >= nwg) return false;
        int wgid = (int)L; { const int q = nwg / NXCD, r = nwg % NXCD, xcd = wgid % NXCD, off = wgid / NXCD; wgid = (xcd < r ? xcd * (q + 1) : r * (q + 1) + (xcd - r) * q) + off; }
        const int nig = WGM * nN, gid = wgid / nig, fm = gid * WGM, gsz = (nM - fm) < WGM ? (nM - fm) : WGM;
        u.pm = fm + ((wgid % nig) % gsz); u.pn = (wgid % nig) / gsz; return true;
    }
    __device__ __forceinline__ void a_ready(const Unit&) const {}
    __device__ __forceinline__ void done(const Unit&) const {}
};
__device__ __forceinline__ unsigned cvt_pk_bf16(float lo, float hi) { unsigned r; asm volatile("v_cvt_pk_bf16_f32 %0, %1, %2" : "=v"(r) : "v"(lo), "v"(hi)); return r; }
typedef float f32x2 __attribute__((ext_vector_type(2)));
__device__ __forceinline__ f32x2 gelu_pk(f32x2 v) {
    const f32x2 av = __builtin_elementwise_abs(v), d = av * 0.2316418882f + 1.0f;
    f32x2 t; t.x = __builtin_amdgcn_rcpf(d.x); t.y = __builtin_amdgcn_rcpf(d.y);
    f32x2 q = t * 0.5307027145f + (-0.7265760135f); q = q * t + 0.7107068705f; q = q * t + (-0.142248368f); q = q * t + 0.127414796f; q = q * t;
    const f32x2 s = (v * v) * (-0.72134752044f);
    f32x2 e; e.x = __builtin_amdgcn_exp2f(s.x); e.y = __builtin_amdgcn_exp2f(s.y);
    const f32x2 m = v * (q * e), r = v - m;
    f32x2 o; o.x = v.x < 0.f ? m.x : r.x; o.y = v.y < 0.f ? m.y : r.y; return o;
}

struct EpiF32 {
    static constexpr bool PERM = false, AFTER_DRAIN = false;
    float* C; int ldc; const float* bias;
    __device__ __forceinline__ void operator()(const f32x4 (&acc)[2][2][4][2], const Unit& u, int wr, int wc, int fr, int fq) const {
        const int row0 = u.pm * BM + wr * 64 + fr, col0 = u.pn * BM + wc * 32 + 4 * fq;
        f32x4 bv[2][2];
#pragma unroll
        for (int bj = 0; bj < 2; ++bj)
#pragma unroll
            for (int n = 0; n < 2; ++n) bv[bj][n] = bias ? *(const f32x4*)(bias + col0 + bj * HALF + n * 16) : (f32x4){0.f, 0.f, 0.f, 0.f};
#pragma unroll
        for (int ai = 0; ai < 2; ++ai)
#pragma unroll
            for (int m = 0; m < 4; ++m) { float* rowp = C + (size_t)(row0 + ai * HALF + m * 16) * ldc + col0;
#pragma unroll
                for (int bj = 0; bj < 2; ++bj)
#pragma unroll
                    for (int n = 0; n < 2; ++n) *(f32x4*)(rowp + bj * HALF + n * 16) = acc[ai][bj][m][n] + bv[bj][n]; }
    }
};
template <int ACT  > struct EpiBf16 {
    static constexpr bool PERM = true, AFTER_DRAIN = false;
    bf16_t* O; int ldc; const float* bias; int split_cols; size_t split_stride; int nt;
    __device__ __forceinline__ void operator()(const f32x4 (&acc)[2][2][4][2], const Unit& u, int wr, int wc, int fr, int fq) const {
        const int row0 = u.pm * BM + wr * 64 + fr; int colt = u.pn * BM; bf16_t* base = O;
        if (split_cols) { const int t = colt / split_cols; base += (size_t)t * split_stride; colt -= t * split_cols; }
        const int col0 = colt + wc * 32 + 8 * fq, bcol0 = u.pn * BM + wc * 32 + 8 * fq;
        f32x4 bv[2][2];
#pragma unroll
        for (int bj = 0; bj < 2; ++bj)
#pragma unroll
            for (int n = 0; n < 2; ++n) bv[bj][n] = bias ? *(const f32x4*)(bias + bcol0 + bj * HALF + 4 * n) : (f32x4){0.f, 0.f, 0.f, 0.f};
#pragma unroll
        for (int ai = 0; ai < 2; ++ai)
#pragma unroll
            for (int m = 0; m < 4; ++m) { bf16_t* rowp = base + (size_t)(row0 + ai * HALF + m * 16) * ldc + col0;
#pragma unroll
                for (int bj = 0; bj < 2; ++bj) { f32x4 v0 = acc[ai][bj][m][0] + bv[bj][0], v1 = acc[ai][bj][m][1] + bv[bj][1];
                    if (ACT == 1) { f32x2 a = gelu_pk((f32x2){v0[0], v0[1]}), b = gelu_pk((f32x2){v0[2], v0[3]}), c = gelu_pk((f32x2){v1[0], v1[1]}), d = gelu_pk((f32x2){v1[2], v1[3]});
                        v0 = (f32x4){a.x, a.y, b.x, b.y}; v1 = (f32x4){c.x, c.y, d.x, d.y}; }
                    if (ACT == 2) {
#pragma unroll
                        for (int j = 0; j < 4; ++j) { v0[j] = 0.5f * v0[j] * (1.0f + erff(v0[j] * 0.70710678f)); v1[j] = 0.5f * v1[j] * (1.0f + erff(v1[j] * 0.70710678f)); } }
                    u32x4 w; w.x = cvt_pk_bf16(v0[0], v0[1]); w.y = cvt_pk_bf16(v0[2], v0[3]); w.z = cvt_pk_bf16(v1[0], v1[1]); w.w = cvt_pk_bf16(v1[2], v1[3]);
                    if (nt) __builtin_nontemporal_store(w, (u32x4*)(rowp + bj * HALF)); else *(u32x4*)(rowp + bj * HALF) = w; } }
    }
};
template <class Epi, class Sched, bool STAMP = false>
__device__ __forceinline__ void gemm_phase(PG8_LAS unsigned char* lds, const Gemm g, const Sched& S, const Epi& E, unsigned long long* stamps, const int wid_s) {
    int tid_; asm volatile("v_mbcnt_lo_u32_b32 %0, -1, 0\n\tv_mbcnt_hi_u32_b32 %0, -1, %0" : "=v"(tid_)); tid_ += wid_s * 64; const int tid = tid_, wid = __builtin_amdgcn_readfirstlane(tid >> 6), lane = tid & 63, wr = wid >> 2, wc = wid & 3, fr = lane & 15, fq = lane >> 4;
    const int K = g.K, nt = K / BK;
    int ts_lo = 0, ts_hi = 0, nts = 0; const unsigned long long rt_entry = STAMP ? (unsigned long long)wall_clock64() : 0ull;
#define PG8_STAMP() do { if (STAMP && wid == 0 && nts < 64) { const unsigned long long _c = (unsigned long long)clock64(); \
        ts_lo = (lane == nts) ? (int)(unsigned)_c : ts_lo; ts_hi = (lane == nts) ? (int)(unsigned)(_c >> 32) : ts_hi; ++nts; } } while (0)
    PG8_STAMP();
    unsigned voffA[2], voffB[2];
#pragma unroll
    for (int i = 0; i < 2; ++i) { int R, C; stage_rc(tid * 16 + i * 8192, R, C); const int Rb = Epi::PERM ? ((R & ~31) + perm32(R & 31)) : R;
        voffA[i] = (unsigned)(R * K + C) * 2u; voffB[i] = (unsigned)(Rb * K + C) * 2u; }
    const size_t kstep = (size_t)(BK * 2);
    const size_t hstep = (size_t)HALF * K * 2;
    const size_t tstep = 2 * hstep;
    const unsigned ldsw = (unsigned)wid * 1024u;
    const int aoff = lds_byte(wr * 64 + fr, fq * 8), boff = lds_byte(wc * 32 + fr, fq * 8);
#define PG8_SA(b, h) (((b) * 2 + (h)) * HTB)
#define PG8_SB(b, h) ((4 + (b) * 2 + (h)) * HTB)
#define PG8_STAGE(bufoff, gbase, voff) do { _Pragma("unroll") for (int _i = 0; _i < 2; ++_i) \
        __builtin_amdgcn_global_load_lds((const unsigned*)((const char*)(gbase) + (voff)[_i]), (PG8_LAS unsigned*)(lds + (bufoff) + ldsw + _i * 8192), 16, 0, 0); } while (0)
#define PG8_LDA(dst, b, h) do { _Pragma("unroll") for (int m = 0; m < 4; ++m) _Pragma("unroll") for (int k = 0; k < 2; ++k) dst[m][k] = *(const PG8_LAS bf16x8*)(lds + PG8_SA(b, h) + aoff + m * 2048 + k * 1024); } while (0)
#define PG8_LDB(dst, b, h) do { _Pragma("unroll") for (int n = 0; n < 2; ++n) _Pragma("unroll") for (int k = 0; k < 2; ++k) dst[n][k] = *(const PG8_LAS bf16x8*)(lds + PG8_SB(b, h) + boff + n * 2048 + k * 1024); } while (0)
#define PG8_MMA(ai, bj, At, Bt) do { __builtin_amdgcn_s_setprio(1); _Pragma("unroll") for (int m = 0; m < 4; ++m) _Pragma("unroll") for (int n = 0; n < 2; ++n) _Pragma("unroll") for (int k = 0; k < 2; ++k) \
        acc[ai][bj][m][n] = __builtin_amdgcn_mfma_f32_16x16x32_bf16(Bt[n][k], At[m][k], acc[ai][bj][m][n], 0, 0, 0); __builtin_amdgcn_s_setprio(0); } while (0)
#define PG8_WAIT_V(n) asm volatile("s_waitcnt vmcnt(" #n ")" ::: "memory")
#define PG8_WAIT_L(n) asm volatile("s_waitcnt lgkmcnt(" #n ")" ::: "memory")
#define PG8_BAR __builtin_amdgcn_s_barrier()
#define PG8_SCHED __builtin_amdgcn_sched_barrier(0)
    Unit cur, nxt; int ui = 0;
    if (!S.next(0, cur)) return;
    f32x4 acc[2][2][4][2];
#pragma unroll
    for (int a = 0; a < 2; ++a)
#pragma unroll
        for (int b = 0; b < 2; ++b)
#pragma unroll
            for (int m = 0; m < 4; ++m)
#pragma unroll
                for (int n = 0; n < 2; ++n) acc[a][b][m][n] = (f32x4){0.f, 0.f, 0.f, 0.f};
    bf16x8 At[4][2], B0[2][2], B1[2][2];
    const char* cA = (const char*)g.A + (size_t)cur.pm * tstep; const char* cB = (const char*)g.Bt + (size_t)cur.pn * tstep;
    S.a_ready(cur);
    PG8_STAGE(PG8_SB(0, 0), cB, voffB); PG8_STAGE(PG8_SA(0, 0), cA, voffA); PG8_STAGE(PG8_SB(0, 1), cB + hstep, voffB); PG8_STAGE(PG8_SA(0, 1), cA + hstep, voffA);
    if (wr == 1) PG8_BAR;
    PG8_WAIT_V(4); PG8_BAR;
    PG8_STAGE(PG8_SB(1, 0), cB + kstep, voffB); PG8_STAGE(PG8_SA(1, 0), cA + kstep, voffA); PG8_STAGE(PG8_SB(1, 1), cB + hstep + kstep, voffB);
    PG8_WAIT_V(6); PG8_BAR;
    PG8_STAMP();
    for (;;) {
        const bool has_next = S.next(ui + 1, nxt);
        const char* nA = has_next ? (const char*)g.A + (size_t)nxt.pm * tstep : cA; const char* nB = has_next ? (const char*)g.Bt + (size_t)nxt.pn * tstep : cB;
        for (int t = 0; t < nt; t += 2) {
            const bool last = (t == nt - 2);
            const char* a1 = cA + (size_t)(t + 1) * kstep;
            const char* a2 = last ? nA : cA + (size_t)(t + 2) * kstep; const char* b2 = last ? nB : cB + (size_t)(t + 2) * kstep;
            const char* a3 = a2 + kstep; const char* b3 = b2 + kstep;
            if (last && has_next) S.a_ready(nxt);
            PG8_LDB(B0, 0, 0); PG8_SCHED; PG8_LDA(At, 0, 0); PG8_STAGE(PG8_SA(1, 1), a1 + hstep, voffA);
            PG8_WAIT_L(8); PG8_BAR; PG8_WAIT_L(0); PG8_MMA(0, 0, At, B0); PG8_BAR; PG8_SCHED;
            PG8_LDB(B1, 0, 1); PG8_STAGE(PG8_SB(0, 0), b2, voffB);
            PG8_BAR; PG8_WAIT_L(0); PG8_MMA(0, 1, At, B1); PG8_BAR;
            PG8_LDA(At, 0, 1); PG8_STAGE(PG8_SA(0, 0), a2, voffA);
            PG8_BAR; PG8_WAIT_L(0); PG8_MMA(1, 0, At, B0); PG8_BAR; PG8_SCHED;
            PG8_STAGE(PG8_SB(0, 1), b2 + hstep, voffB);
            PG8_WAIT_V(6); PG8_BAR; PG8_MMA(1, 1, At, B1); PG8_BAR;
            PG8_LDB(B0, 1, 0); PG8_SCHED; PG8_LDA(At, 1, 0); PG8_STAGE(PG8_SA(0, 1), a2 + hstep, voffA);
            PG8_WAIT_L(8); PG8_BAR; PG8_WAIT_L(0); PG8_MMA(0, 0, At, B0); PG8_BAR; PG8_SCHED;
            PG8_LDB(B1, 1, 1); PG8_STAGE(PG8_SB(1, 0), b3, voffB);
            PG8_BAR; PG8_WAIT_L(0); PG8_MMA(0, 1, At, B1); PG8_BAR;
            PG8_LDA(At, 1, 1); PG8_STAGE(PG8_SA(1, 0), a3, voffA);
            PG8_BAR; PG8_WAIT_L(0); PG8_MMA(1, 0, At, B0); PG8_BAR; PG8_SCHED;
            PG8_STAGE(PG8_SB(1, 1), b3 + hstep, voffB);
            PG8_WAIT_V(6); PG8_BAR; PG8_MMA(1, 1, At, B1); PG8_BAR;
        }
        PG8_STAMP();
        if constexpr (!Epi::AFTER_DRAIN) { E(acc, cur, wr, wc, fr, fq); S.done(cur); }
        PG8_STAMP();
        if (!has_next) break;
#pragma unroll
        for (int a = 0; a < 2; ++a)
#pragma unroll
            for (int b = 0; b < 2; ++b)
#pragma unroll
                for (int m = 0; m < 4; ++m)
#pragma unroll
                    for (int n = 0; n < 2; ++n) acc[a][b][m][n] = (f32x4){0.f, 0.f, 0.f, 0.f};
        cur = nxt; cA = nA; cB = nB; ++ui;
    }
    PG8_WAIT_V(0);
    if (wr == 0) PG8_BAR;
    PG8_BAR;
    if constexpr (Epi::AFTER_DRAIN) { E.fused(acc, cur, wr, wc, fr, fq, lds, wid, lane); S.done(cur); }
    PG8_STAMP();
    if (STAMP && wid == 0) { stamps[lane] = lane < nts ? (((unsigned long long)(unsigned)ts_hi << 32) | (unsigned)ts_lo) : 0ull;
        if (lane == 62) stamps[62] = rt_entry; if (lane == 63) stamps[63] = (unsigned long long)wall_clock64(); }
#undef PG8_STAMP
#undef PG8_SA
#undef PG8_SB
#undef PG8_STAGE
#undef PG8_LDA
#undef PG8_LDB
#undef PG8_MMA
#undef PG8_WAIT_V
#undef PG8_WAIT_L
#undef PG8_BAR
#undef PG8_SCHED
}
}
#define XB_TMO      128
#define XB_XCNT(j)  (256  + 64 * (j))
#define XB_XSUB(j)  (1280 + 64 * (j))
#define XB_XGEN(j)  (2304 + 64 * (j))
#define XB_TOP      3328
#define XB_TOPGEN   3392
#define XCD_BAR_WORDS 3456
#define XB_SPIN_CAP (1u << 18)
#define LAS __attribute__((address_space(3)))

__device__ __forceinline__ unsigned xb_ld(unsigned* p)              { return __hip_atomic_load(p, __ATOMIC_RELAXED, __HIP_MEMORY_SCOPE_AGENT); }
__device__ __forceinline__ unsigned xb_add(unsigned* p, unsigned v) { return __hip_atomic_fetch_add(p, v, __ATOMIC_RELAXED, __HIP_MEMORY_SCOPE_AGENT); }
__device__ __forceinline__ unsigned xb_xcc_id() { return (unsigned)__builtin_amdgcn_s_getreg((3 << 11) | 20) & 0xFu; }
#define XB_SPIN(cond, bar) do { unsigned _sp = 0; while (cond) { __builtin_amdgcn_s_sleep(1); \
    if ((++_sp & 255u) == 0u) { if (xb_ld(&(bar)[XB_TMO])) break; if (_sp > XB_SPIN_CAP) { atomicAdd(&(bar)[XB_TMO], 1u); break; } } } } while (0)

struct XcdBarrier {
    unsigned* bar; unsigned x;
    volatile LAS unsigned* st;
};

__device__ __forceinline__ XcdBarrier xcd_barrier_post(unsigned* bar, volatile LAS unsigned* st) {
    XcdBarrier b; b.bar = bar; b.x = xb_xcc_id(); b.st = st;
    if (threadIdx.x == 0) (void)xb_add(&bar[XB_XCNT(b.x)], 1u);
    return b;
}
__device__ __forceinline__ void xcd_barrier_complete(unsigned* bar, unsigned x, unsigned& nloc, unsigned& nx) {
    const unsigned G = gridDim.x * gridDim.y * gridDim.z;
    unsigned sum, cnt, mine, sp = 0u;
    for (;;) {
        sum = 0u; cnt = 0u; mine = 0u;
#pragma unroll
        for (unsigned j = 0; j < 16; ++j) { const unsigned c = xb_ld(&bar[XB_XCNT(j)]); sum += c; cnt += (c > 0u) ? 1u : 0u; mine = (j == x) ? c : mine; }
        if (sum == G) break;
        __builtin_amdgcn_s_sleep(1);
        if ((++sp & 255u) == 0u) { if (xb_ld(&bar[XB_TMO])) break; if (sp > XB_SPIN_CAP) { atomicAdd(&bar[XB_TMO], 1u); break; } }
    }
    nloc = mine > 0u ? mine : 1u; nx = cnt > 0u ? cnt : 1u;
}

__device__ __forceinline__ void xcd_barrier(const XcdBarrier& b, unsigned& st0, unsigned& st1, const bool t0  ) {
    asm volatile("s_waitcnt vmcnt(0)" ::: "memory");
    __syncthreads();
    if (t0) {
        unsigned* bar = b.bar;
        __builtin_amdgcn_s_waitcnt(0);
        unsigned nloc = st0, nx = st1;
        if (nloc == 0u) { xcd_barrier_complete(bar, b.x, nloc, nx); st0 = nloc; st1 = nx; }
        const unsigned old = xb_add(&bar[XB_XSUB(b.x)], 1u);
        const unsigned gen = old / nloc;
        if (old + 1u == (gen + 1u) * nloc) {
            __builtin_amdgcn_fence(__ATOMIC_RELEASE, "agent");
            asm volatile("s_waitcnt vmcnt(0)" ::: "memory");
            const unsigned og = xb_add(&bar[XB_TOP], 1u);
            const unsigned tg = og / nx;
            if (og + 1u == (tg + 1u) * nx) xb_add(&bar[XB_TOPGEN], 1u);
            else XB_SPIN(xb_ld(&bar[XB_TOPGEN]) == tg, bar);
            __builtin_amdgcn_fence(__ATOMIC_ACQUIRE, "agent");
            xb_add(&bar[XB_XGEN(b.x)], 1u);
            asm volatile("s_waitcnt vmcnt(0)" ::: "memory");
        } else {
            XB_SPIN(xb_ld(&bar[XB_XGEN(b.x)]) == gen, bar);
            __builtin_amdgcn_fence(__ATOMIC_ACQUIRE, "agent");
            asm volatile("s_waitcnt vmcnt(0)" ::: "memory");
        }
    }
    __syncthreads();
}

using pg8::bf16_t;
typedef float f32x4v __attribute__((ext_vector_type(4)));
typedef float f32x2v __attribute__((ext_vector_type(2)));
typedef unsigned u32x4v __attribute__((ext_vector_type(4)));
typedef unsigned u32x2v __attribute__((ext_vector_type(2)));

constexpr int DM = 1024, NB = 16, SEQ = 4096, DEPTH = 4, NTOK = NB * SEQ;
constexpr int DH = 512, NPT = 2560, DFF = 2816, DUP = 5632, HTOK = NTOK / 2;
constexpr int NTHR = 512;

constexpr size_t WL_WIN = 0, WL_WOUT = WL_WIN + (size_t)NPT * DM, WL_WUP = WL_WOUT + (size_t)DM * DM, WL_WDN = WL_WUP + (size_t)DUP * DM, WL_END = WL_WDN + (size_t)DM * DFF;
constexpr size_t WS_WBF = 0;
constexpr size_t WS_KF = WS_WBF + WL_END * 2 * DEPTH;
constexpr size_t WS_H3T = WS_KF + (size_t)2 * DH * SEQ * 8;
constexpr size_t WS_FH2 = WS_H3T + (size_t)2048 * SEQ * 4;
constexpr size_t WS_MOD = WS_FH2 + (size_t)DEPTH * SEQ * 64 * 4;
constexpr size_t WS_TW = WS_MOD + (size_t)DEPTH * NB * 6144 * 4;
constexpr size_t WS_H = WS_TW + 8192 * 8;
constexpr size_t WS_BIG = WS_H + (size_t)NTOK * DM * 2;
constexpr size_t WS_PT = WS_BIG, WS_YT = WS_PT + (size_t)NB * NPT * SEQ * 2, WS_Y = WS_YT + (size_t)NTOK * DM * 2, WS_MIX_END = WS_Y + (size_t)NTOK * DM * 2;
constexpr size_t WS_YO = WS_PT;
constexpr size_t WS_U = WS_BIG, WS_G = WS_U + (size_t)HTOK * DUP * 2, WS_YD0 = WS_G + (size_t)HTOK * DFF * 2, WS_FFN_END = WS_YD0 + (size_t)HTOK * DM * 2;
constexpr size_t WS_YD1 = WS_U;
constexpr size_t WS_XB = WS_MIX_END > WS_FFN_END ? WS_MIX_END : WS_FFN_END;
constexpr size_t WS_BAR = WS_XB + (size_t)NTOK * DM * 2;
constexpr size_t WS_NEED = WS_BAR + XCD_BAR_WORDS * 4;

static_assert(WS_KF % 256 == 0 && WS_H % 256 == 0 && WS_BIG % 256 == 0 && WS_G % 256 == 0 && WS_YD0 % 256 == 0 && WS_XB % 256 == 0, "align");

enum { I_X = 0, I_C, I_ADAW, I_ADAB, I_GMPRE, I_GMPOST, I_WIN, I_SW, I_SB, I_FW1, I_FB1, I_FW2, I_FB2, I_FFREQ, I_FW3, I_HD, I_FNW, I_WOUT, I_GFPRE, I_GFPOST, I_WUP, I_DWW, I_DWB, I_WDOWN };
struct Params { const float* in[24]; float* out; unsigned char* ws; int ph_lo, ph_hi; };

__device__ __forceinline__ float bf2f(bf16_t v) { return __uint_as_float(((unsigned)v) << 16); }
__device__ __forceinline__ unsigned pack2(float lo, float hi) { unsigned r; asm("v_cvt_pk_bf16_f32 %0, %1, %2" : "=v"(r) : "v"(lo), "v"(hi)); return r; }
__device__ __forceinline__ bf16_t f2bf(float f) { return (bf16_t)(pack2(f, f) & 0xffffu); }
__device__ __forceinline__ int lane_now() { int l; asm volatile("v_mbcnt_lo_u32_b32 %0, -1, 0\n\tv_mbcnt_hi_u32_b32 %0, -1, %0" : "=v"(l)); return l; }
__device__ __forceinline__ int opaque_tid_(int wid_s) { return wid_s * 64 + lane_now(); }
#define opaque_tid() opaque_tid_(wid_s)
__device__ __forceinline__ float wave_sum(float v) {
#pragma unroll
    for (int o = 32; o >= 1; o >>= 1) v += __shfl_xor(v, o);
    return v;
}

template <class T> __device__ __forceinline__ void dft4(T& r0, T& i0, T& r1, T& i1, T& r2, T& i2, T& r3, T& i3) {
    const T s0r = r0 + r2, s0i = i0 + i2, s1r = r0 - r2, s1i = i0 - i2;
    const T s2r = r1 + r3, s2i = i1 + i3, s3r = r1 - r3, s3i = i1 - i3;
    r0 = s0r + s2r; i0 = s0i + s2i; r2 = s0r - s2r; i2 = s0i - s2i;
    r1 = s1r + s3i; i1 = s1i - s3r; r3 = s1r - s3i; i3 = s1i + s3r;
}
template <int K, class T> __device__ __forceinline__ void tw16(T& r, T& i) {
    if constexpr (K == 0) { }
    else if constexpr (K == 4) { const T t = r; r = i; i = -t; }
    else {
        constexpr float C[10] = {1.f, 0.92387953251128674f, 0.70710678118654752f, 0.38268343236508977f, 0.f, -0.38268343236508977f, -0.70710678118654752f, -0.92387953251128674f, -1.f, -0.92387953251128674f};
        constexpr float S[10] = {0.f, -0.38268343236508977f, -0.70710678118654752f, -0.92387953251128674f, -1.f, -0.92387953251128674f, -0.70710678118654752f, -0.38268343236508977f, 0.f, 0.38268343236508977f};
        const float c = C[K], s = S[K]; const T t = r * c - i * s; i = r * s + i * c; r = t;
    }
}
template <class T> __device__ __forceinline__ void dft16(T (&xr)[16], T (&xi)[16]) {
#pragma unroll
    for (int b = 0; b < 4; ++b) dft4(xr[b], xi[b], xr[4 + b], xi[4 + b], xr[8 + b], xi[8 + b], xr[12 + b], xi[12 + b]);
    tw16<1>(xr[5], xi[5]); tw16<2>(xr[6], xi[6]); tw16<3>(xr[7], xi[7]);
    tw16<2>(xr[9], xi[9]); tw16<4>(xr[10], xi[10]); tw16<6>(xr[11], xi[11]);
    tw16<3>(xr[13], xi[13]); tw16<6>(xr[14], xi[14]); tw16<9>(xr[15], xi[15]);
#pragma unroll
    for (int c = 0; c < 4; ++c) dft4(xr[4 * c], xi[4 * c], xr[4 * c + 1], xi[4 * c + 1], xr[4 * c + 2], xi[4 * c + 2], xr[4 * c + 3], xi[4 * c + 3]);
#pragma unroll
    for (int c = 0; c < 4; ++c)
#pragma unroll
        for (int d = c + 1; d < 4; ++d) { T t = xr[4 * c + d]; xr[4 * c + d] = xr[4 * d + c]; xr[4 * d + c] = t; t = xi[4 * c + d]; xi[4 * c + d] = xi[4 * d + c]; xi[4 * d + c] = t; }
}
constexpr int PBUF = 4096;
constexpr int LDS_MAIN = 2 * PBUF * 16;
constexpr int LDS_KF = LDS_MAIN;
__device__ __forceinline__ void fft4096_pk(f32x2v (&xr)[16], f32x2v (&xi)[16], f32x4v* buf, const int t, const f32x2v* __restrict__ TW) {
    dft16(xr, xi);
    __syncthreads();
    {
        f32x2v w1 = TW[2 * t]; asm volatile("" : "+v"(w1.x), "+v"(w1.y));
        float wr = w1.x, wi = w1.y;
        buf[t] = (f32x4v){xr[0].x, xr[0].y, xi[0].x, xi[0].y};
#pragma unroll
        for (int k = 1; k < 16; ++k) {
            const f32x2v r = xr[k], i = xi[k]; const f32x2v nr = r * wr - i * wi, ni = r * wi + i * wr;
            buf[k * 256 + t] = (f32x4v){nr.x, nr.y, ni.x, ni.y};
            if (k < 15) { const float n2 = wr * w1.x - wi * w1.y; wi = wr * w1.y + wi * w1.x; wr = n2; }
        }
    }
    __syncthreads();
    const int k1 = t >> 4, m2 = t & 15;
#pragma unroll
    for (int m = 0; m < 16; ++m) { const f32x4v v = buf[k1 * 256 + 16 * m + m2]; xr[m] = (f32x2v){v.x, v.y}; xi[m] = (f32x2v){v.z, v.w}; }
    __syncthreads();
    dft16(xr, xi);
    {
        f32x2v w1 = TW[32 * m2]; asm volatile("" : "+v"(w1.x), "+v"(w1.y));
        float wr = w1.x, wi = w1.y;
        buf[m2 * 256 + (k1 ^ (m2 & 7))] = (f32x4v){xr[0].x, xr[0].y, xi[0].x, xi[0].y};
#pragma unroll
        for (int j = 1; j < 16; ++j) {
            const f32x2v r = xr[j], i = xi[j]; const f32x2v nr = r * wr - i * wi, ni = r * wi + i * wr;
            buf[m2 * 256 + ((k1 + 16 * j) ^ (m2 & 7))] = (f32x4v){nr.x, nr.y, ni.x, ni.y};
            if (j < 15) { const float n2 = wr * w1.x - wi * w1.y; wi = wr * w1.y + wi * w1.x; wr = n2; }
        }
    }
    __syncthreads();
#pragma unroll
    for (int m = 0; m < 16; ++m) { const f32x4v v = buf[m * 256 + (t ^ (m & 7))]; xr[m] = (f32x2v){v.x, v.y}; xi[m] = (f32x2v){v.z, v.w}; }
    dft16(xr, xi);
}
__device__ __forceinline__ f32x2v w32(int j) {
    constexpr float C[16] = {1.f, 0.98078528040323043f, 0.92387953251128674f, 0.83146961230254524f, 0.70710678118654752f, 0.55557023301960218f, 0.38268343236508977f, 0.19509032201612825f, 0.f, -0.19509032201612825f, -0.38268343236508977f, -0.55557023301960218f, -0.70710678118654752f, -0.83146961230254524f, -0.92387953251128674f, -0.98078528040323043f};
    constexpr float S[16] = {0.f, -0.19509032201612825f, -0.38268343236508977f, -0.55557023301960218f, -0.70710678118654752f, -0.83146961230254524f, -0.92387953251128674f, -0.98078528040323043f, -1.f, -0.98078528040323043f, -0.92387953251128674f, -0.83146961230254524f, -0.70710678118654752f, -0.55557023301960218f, -0.38268343236508977f, -0.19509032201612825f};
    return (f32x2v){C[j], S[j]};
}
constexpr int LDS_BYTES = LDS_MAIN + 32768;
static_assert(LDS_MAIN >= pg8::STAGE_BYTES, "lds");
typedef _Float16 f16x4v __attribute__((ext_vector_type(4)));
__device__ __forceinline__ void kf_dma(const unsigned char* src, unsigned char* kfl, int tid) {
    const int w = __builtin_amdgcn_readfirstlane(tid >> 6), lane = tid & 63;
#pragma unroll
    for (int q = 0; q < 4; ++q)
        __builtin_amdgcn_global_load_lds((const unsigned*)(src + (w * 4 + q) * 1024 + lane * 16), (LAS unsigned*)(kfl + (w * 4 + q) * 1024), 16, 0, 0);
}
__device__ __forceinline__ bf16_t* wbf(const Params& P, int l, size_t off) { return (bf16_t*)(P.ws + WS_WBF) + (size_t)l * WL_END + off; }
__device__ __forceinline__ const float* modp(const Params& P, int l, int which) { return (const float*)(P.ws + WS_MOD) + (size_t)l * NB * 6144 + which * 1024; }

__device__ __forceinline__ void ph_tconv(const Params& P, float* tile, const int wid_s) {
    const int tid = opaque_tid();
    for (int it = blockIdx.x; it < DEPTH * 2752; it += gridDim.x) {
        const int l = it / 2752; int r = it % 2752;
        const float* src; int ldsrc, lddst, tk, tn; bf16_t* dst;
        if (r < 384) { src = P.in[I_WIN] + (size_t)l * DM * 2048; ldsrc = 2048; lddst = DM; tk = r / 24; tn = r % 24; dst = wbf(P, l, WL_WIN); }
        else if (r < 640) { r -= 384; src = P.in[I_WOUT] + (size_t)l * DM * DM; ldsrc = DM; lddst = DM; tk = r / 16; tn = r % 16; dst = wbf(P, l, WL_WOUT); }
        else if (r < 2048) { r -= 640; src = P.in[I_WUP] + (size_t)l * DM * DUP; ldsrc = DUP; lddst = DM; tk = r / 88; tn = r % 88; dst = wbf(P, l, WL_WUP); }
        else { r -= 2048; src = P.in[I_WDOWN] + (size_t)l * DFF * DM; ldsrc = DM; lddst = DFF; tk = r / 16; tn = r % 16; dst = wbf(P, l, WL_WDN); }
        { const int kk = tid >> 3, c8 = (tid & 7) * 8; const float* s = src + (size_t)(tk * 64 + kk) * ldsrc + tn * 64 + c8; const f32x4v v0 = *(const f32x4v*)s, v1 = *(const f32x4v*)(s + 4);
          float* t = tile + kk * 65 + c8; t[0] = v0.x; t[1] = v0.y; t[2] = v0.z; t[3] = v0.w; t[4] = v1.x; t[5] = v1.y; t[6] = v1.z; t[7] = v1.w; }
        __syncthreads();
        { const int nn = tid >> 3, k8 = (tid & 7) * 8; const float* t = tile + k8 * 65 + nn;
          *(u32x4v*)(dst + (size_t)(tn * 64 + nn) * lddst + tk * 64 + k8) = (u32x4v){pack2(t[0], t[65]), pack2(t[130], t[195]), pack2(t[260], t[325]), pack2(t[390], t[455])}; }
        __syncthreads();
    }
}
__device__ __forceinline__ void ph_fold(const Params& P, float* lds, const int wid_s) {
    const int tid = opaque_tid();
    float* CW = lds; float* SWm = lds + 4096; float* ct = lds + 8192; float* st = lds + 8192 + 64;
    float* Wl = lds + 8192 + 128;
    bf16_t* ot = (bf16_t*)(Wl + 128 * 65);
    for (int it = blockIdx.x; it < DEPTH * 64; it += gridDim.x) {
        const int l = it >> 6, g = (it >> 3) & 7, kc = it & 7;
        const float* Wg = P.in[I_FNW] + ((size_t)l * 8 + g) * 4096;
        if (tid < 64) { float s, c; sincospif((float)tid * (1.0f / 32.0f), &s, &c); ct[tid] = c; st[tid] = s; }
#pragma unroll
        for (int i = 0; i < 16; ++i) { const int idx = tid + 512 * i, kk = idx >> 6, c = idx & 63; Wl[kk * 65 + c] = P.in[I_WIN][((size_t)l * DM + kc * 128 + kk) * 2048 + 1536 + 64 * g + c]; }
        __syncthreads();
        for (int idx = tid; idx < 4096; idx += NTHR) { const int c = idx >> 6, d = idx & 63; float ac = 0.f, as = 0.f;
            for (int m = 0; m < 64; ++m) { const float w = Wg[m * 64 + d]; const int ph = (c * m) & 63; ac += ct[ph] * w; as += st[ph] * w; }
            CW[idx] = ac * (1.0f / 512.0f); SWm[idx] = as * (1.0f / 512.0f); }
        __syncthreads();
        { const int kk = tid & 127, dg = tid >> 7;
          f32x4v ac[4], as[4];
#pragma unroll
          for (int u = 0; u < 4; ++u) { ac[u] = (f32x4v){0.f, 0.f, 0.f, 0.f}; as[u] = (f32x4v){0.f, 0.f, 0.f, 0.f}; }
          for (int c = 0; c < 64; ++c) { const float w = Wl[kk * 65 + c];
#pragma unroll
              for (int u = 0; u < 4; ++u) { ac[u] += *(const f32x4v*)(CW + c * 64 + dg * 16 + u * 4) * w; as[u] += *(const f32x4v*)(SWm + c * 64 + dg * 16 + u * 4) * w; } }
#pragma unroll
          for (int u = 0; u < 4; ++u) { const int d = dg * 16 + u * 4;
              ot[(d + 0) * 136 + kk] = f2bf(ac[u].x); ot[(d + 1) * 136 + kk] = f2bf(ac[u].y); ot[(d + 2) * 136 + kk] = f2bf(ac[u].z); ot[(d + 3) * 136 + kk] = f2bf(ac[u].w);
              ot[(64 + d + 0) * 136 + kk] = f2bf(as[u].x); ot[(64 + d + 1) * 136 + kk] = f2bf(as[u].y); ot[(64 + d + 2) * 136 + kk] = f2bf(as[u].z); ot[(64 + d + 3) * 136 + kk] = f2bf(as[u].w); } }
        __syncthreads();
        bf16_t* WinT = wbf(P, l, WL_WIN);
#pragma unroll
        for (int i = 0; i < 4; ++i) { const int idx = tid + 512 * i, r = idx >> 4, q = idx & 15, which = r >> 6, d = r & 63;
            *(u32x4v*)(WinT + (size_t)(1536 + which * 512 + g * 64 + d) * DM + kc * 128 + q * 8) = *(const u32x4v*)(ot + r * 136 + q * 8); }
        __syncthreads();
    }
}
__device__ __forceinline__ void ph_mod(const Params& P, float* lds, const int wid_s) {
    const int tid = opaque_tid();
    float* cact = lds;
    float* red = lds + 16384;
    if ((int)blockIdx.x >= DEPTH * 96) return;
    for (int idx = tid; idx < NB * DM; idx += NTHR) { const int b = idx >> 10, k = idx & 1023; const float v = P.in[I_C][idx]; cact[k * 16 + b] = v / (1.0f + __expf(-v)); }
    __syncthreads();
    for (int it = blockIdx.x; it < DEPTH * 96; it += gridDim.x) {
        const int l = it / 96, n0 = (it % 96) * 64, ks = tid >> 6, nn = tid & 63;
        float acc[16];
#pragma unroll
        for (int b = 0; b < 16; ++b) acc[b] = 0.f;
        const float* w = P.in[I_ADAW] + ((size_t)l * DM + ks * 128) * 6144 + n0 + nn;
        for (int k = 0; k < 128; ++k) { const float wv = w[(size_t)k * 6144]; const f32x4v* cp = (const f32x4v*)(cact + (ks * 128 + k) * 16);
#pragma unroll
            for (int q = 0; q < 4; ++q) { const f32x4v cv = cp[q]; acc[4 * q] += cv.x * wv; acc[4 * q + 1] += cv.y * wv; acc[4 * q + 2] += cv.z * wv; acc[4 * q + 3] += cv.w * wv; } }
#pragma unroll
        for (int b = 0; b < 16; ++b) red[(ks * 64 + nn) * 16 + b] = acc[b];
        __syncthreads();
        for (int idx = tid; idx < 1024; idx += NTHR) { const int b = idx >> 6, n = idx & 63; float s = P.in[I_ADAB][(size_t)l * 6144 + n0 + n];
#pragma unroll
            for (int q = 0; q < 8; ++q) s += red[(q * 64 + n) * 16 + b];
            ((float*)(P.ws + WS_MOD))[((size_t)l * NB + b) * 6144 + n0 + n] = s; }
        __syncthreads();
    }
}
__device__ __forceinline__ void ph_tw(const Params& P, const int wid_s) {
    f32x2v* TW = (f32x2v*)(P.ws + WS_TW);
    const int tid = opaque_tid();
    for (int j = blockIdx.x * NTHR + tid; j < 8192; j += gridDim.x * NTHR) { float s, c; sincospif((float)j * (1.0f / 4096.0f), &s, &c); TW[j] = (f32x2v){c, -s}; }
}
__device__ __forceinline__ void ph_fh2(const Params& P, float* lds, const int wid_s) {
    const int tid = opaque_tid(), p = tid >> 6, j = tid & 63;
    float* z = lds;
    float* h1 = lds + 8 * 36;
    for (int it = blockIdx.x; it < DEPTH * 512; it += gridDim.x) {
        const int l = it >> 9, pos = (it & 511) * 8 + p;
        if (j < 33) { float v;
            if (j == 0) v = (float)pos / 4095.0f;
            else { const int bi = (j - 1) & 15; const float band = 1e-4f + (float)bi * ((15.0f - 1e-4f) / 15.0f); float s, c; sincospif((float)pos * band * (2.0f / 4096.0f), &s, &c); v = (j <= 16) ? c : -s; }
            z[p * 36 + j] = v; }
        __syncthreads();
        const float fr = P.in[I_FFREQ][l * 64 + j];
        { float a = P.in[I_FB1][l * 64 + j]; const float* w1 = P.in[I_FW1] + (size_t)l * 33 * 64 + j;
          for (int i = 0; i < 33; ++i) a += z[p * 36 + i] * w1[i * 64];
          h1[p * 64 + j] = sinf(fr * a); }
        __syncthreads();
        { float a = P.in[I_FB2][l * 64 + j]; const float* w2 = P.in[I_FW2] + (size_t)l * 64 * 64 + j;
          for (int i = 0; i < 64; ++i) a += h1[p * 64 + i] * w2[i * 64];
          ((float*)(P.ws + WS_FH2))[((size_t)l * SEQ + pos) * 64 + j] = sinf(fr * a); }
        __syncthreads();
    }
}
__device__ __forceinline__ void ph_h3t(const Params& P, int l, float* lds, const int wid_s) {
    const int tid = opaque_tid(), pq = tid & 31, cq = tid >> 5;
    float* AT = lds;
    float* Bs = lds + 64 * 132;
    const float* FH2 = (const float*)(P.ws + WS_FH2) + (size_t)l * SEQ * 64; const float* w3 = P.in[I_FW3] + (size_t)l * 64 * 2048; float* H3T = (float*)(P.ws + WS_H3T);
    for (int it = blockIdx.x; it < 32 * 16; it += gridDim.x) {
        const int p0 = (it & 31) * 128, c0 = (it >> 5) * 128;
#pragma unroll
        for (int i = 0; i < 16; ++i) { const int idx = tid + 512 * i; { const int r = idx >> 6, q = idx & 63; AT[q * 132 + r] = FH2[(size_t)(p0 + r) * 64 + q]; } { const int q = idx >> 7, cc = idx & 127; Bs[q * 128 + cc] = w3[(size_t)q * 2048 + c0 + cc]; } }
        __syncthreads();
        f32x4v acc[8];
#pragma unroll
        for (int j = 0; j < 8; ++j) acc[j] = (f32x4v){0.f, 0.f, 0.f, 0.f};
#pragma unroll 4
        for (int q = 0; q < 64; ++q) { const f32x4v a = *(const f32x4v*)(AT + q * 132 + pq * 4), b0 = *(const f32x4v*)(Bs + q * 128 + cq * 8), b1 = *(const f32x4v*)(Bs + q * 128 + cq * 8 + 4);
            acc[0] += a * b0.x; acc[1] += a * b0.y; acc[2] += a * b0.z; acc[3] += a * b0.w; acc[4] += a * b1.x; acc[5] += a * b1.y; acc[6] += a * b1.z; acc[7] += a * b1.w; }
#pragma unroll
        for (int j = 0; j < 8; ++j) *(f32x4v*)(H3T + (size_t)(c0 + cq * 8 + j) * SEQ + p0 + pq * 4) = acc[j];
        __syncthreads();
    }
}
__device__ __forceinline__ void ph_kf(const Params& P, int l, float* lds, const int wid_s) {
    const int tid = opaque_tid(), hh = tid >> 8, t = tid & 255;
    f32x4v* buf = (f32x4v*)lds + hh * PBUF; float* red = (float*)((f32x4v*)lds + hh * PBUF);
    const f32x2v* TW = (const f32x2v*)(P.ws + WS_TW); const float* H3T = (const float*)(P.ws + WS_H3T); f16x4v* KF = (f16x4v*)(P.ws + WS_KF);
    const float min_decay = -4.605170185988091f / 1.5f, max_decay = -4.605170185988091f / 0.3f;
    for (int it0 = blockIdx.x * 2; it0 < 2 * DH; it0 += gridDim.x * 2) {
        const int it = it0 + hh, n = it >> 9, c = it & 511;
        int tv = t; asm volatile("" : "+v"(tv));
        const float ad = fabsf(min_decay + (float)c * ((max_decay - min_decay) / 511.0f));
        const float* fw = H3T + (size_t)(n * 1024 + c) * SEQ; const float* bw = H3T + (size_t)(n * 1024 + 512 + c) * SEQ;
        float fr[16], br[16]; float l1 = 0.f;
#pragma unroll
        for (int j = 0; j < 16; ++j) { const int m = tv + 256 * j;
            const float f = fw[m] * __expf(-((float)m * (1.0f / 4095.0f)) * ad);
            const float b = (m == 0) ? 0.f : bw[SEQ - m] * __expf(-((float)(SEQ - m) * (1.0f / 4095.0f)) * ad);
            l1 += fabsf(f) + fabsf(b); fr[j] = f; br[j] = b; }
        l1 = wave_sum(l1);
        __syncthreads();
        if ((tid & 63) == 0) red[(tid >> 6) & 3] = l1;
        __syncthreads();
        const float tot = red[0] + red[1] + red[2] + red[3];
        const float sc = 1.0f / (tot + 1e-6f);
        f32x2v wt = TW[tv]; asm volatile("" : "+v"(wt.x), "+v"(wt.y));
        f32x2v xr[16], xi[16];
#pragma unroll
        for (int j = 0; j < 16; ++j) { const f32x2v wj = w32(j); const float wx = wt.x * wj.x - wt.y * wj.y, wy = wt.x * wj.y + wt.y * wj.x; const float s = (fr[j] + br[j]) * sc, d = (fr[j] - br[j]) * sc;
            xr[j] = (f32x2v){s, d * wx}; xi[j] = (f32x2v){0.f, d * wy}; }
        fft4096_pk(xr, xi, buf, tv, TW);
        const float dsk = P.in[I_HD][(size_t)l * 2 * DH + it];
        f16x4v* o = KF + (size_t)it * SEQ;
#pragma unroll
        for (int j = 0; j < 16; ++j) o[tv + 256 * j] = (f16x4v){(_Float16)(xr[j].x + dsk), (_Float16)(xr[j].y + dsk), (_Float16)xi[j].x, (_Float16)xi[j].y};
    }
    __syncthreads();
}
__device__ __forceinline__ void ld8f(const float* p, float (&f)[16], int o) { const f32x4v a = *(const f32x4v*)p, b = *(const f32x4v*)(p + 4); f[o] = a.x; f[o + 1] = a.y; f[o + 2] = a.z; f[o + 3] = a.w; f[o + 4] = b.x; f[o + 5] = b.y; f[o + 6] = b.z; f[o + 7] = b.w; }
__device__ __forceinline__ void un8(const u32x4v w, float (&f)[16], int o) {
    f[o] = __uint_as_float(w.x << 16); f[o + 1] = __uint_as_float(w.x & 0xffff0000u); f[o + 2] = __uint_as_float(w.y << 16); f[o + 3] = __uint_as_float(w.y & 0xffff0000u);
    f[o + 4] = __uint_as_float(w.z << 16); f[o + 5] = __uint_as_float(w.z & 0xffff0000u); f[o + 6] = __uint_as_float(w.w << 16); f[o + 7] = __uint_as_float(w.w & 0xffff0000u);
}
template <int XI, int XO>
__device__ __forceinline__ void ph_resnorm(const void* xin_, void* xout_, const bf16_t* y, const bf16_t* y_hi  , const float* gpost, const float* gate, const float* gnext, const float* scale, const float* shift, bf16_t* hout, const int wid_s) {
    constexpr int RW = 4;
    const int tid = opaque_tid(); const int lane = tid & 63, wv = tid >> 6;
    for (int row0 = (blockIdx.x * 8 + wv) * RW; row0 < NTOK; row0 += gridDim.x * 8 * RW) {
        const int b = row0 >> 12; float x[RW][16]; u32x4v yw[RW][2];
        const bf16_t* ysel = (row0 < HTOK) ? y : y_hi - (size_t)HTOK * DM;
#pragma unroll
        for (int r = 0; r < RW; ++r)
#pragma unroll
            for (int q = 0; q < 2; ++q) { const size_t off = (size_t)(row0 + r) * DM + q * 512 + lane * 8;
                if (XI) un8(__builtin_nontemporal_load((const u32x4v*)((const bf16_t*)xin_ + off)), x[r], q * 8);
                else { const f32x4v a = __builtin_nontemporal_load((const f32x4v*)((const float*)xin_ + off)), c = __builtin_nontemporal_load((const f32x4v*)((const float*)xin_ + off + 4));
                    x[r][q * 8] = a.x; x[r][q * 8 + 1] = a.y; x[r][q * 8 + 2] = a.z; x[r][q * 8 + 3] = a.w; x[r][q * 8 + 4] = c.x; x[r][q * 8 + 5] = c.y; x[r][q * 8 + 6] = c.z; x[r][q * 8 + 7] = c.w; }
                if (y) yw[r][q] = __builtin_nontemporal_load((const u32x4v*)(ysel + off)); }
        if (y) {
            float g[16], gt[16];
#pragma unroll
            for (int q = 0; q < 2; ++q) { ld8f(gpost + q * 512 + lane * 8, g, q * 8); ld8f(gate + (size_t)b * 6144 + q * 512 + lane * 8, gt, q * 8); }
#pragma unroll
            for (int e = 0; e < 16; ++e) g[e] *= gt[e];
#pragma unroll
            for (int r = 0; r < RW; ++r) {
                float yv[16]; un8(yw[r][0], yv, 0); un8(yw[r][1], yv, 8); float ss = 0.f;
#pragma unroll
                for (int e = 0; e < 16; ++e) ss += yv[e] * yv[e];
                ss = wave_sum(ss); const float rinv = rsqrtf(ss * (1.0f / 1024.0f) + 1e-6f);
#pragma unroll
                for (int e = 0; e < 16; ++e) x[r][e] += g[e] * (yv[e] * rinv);
#pragma unroll
                for (int q = 0; q < 2; ++q) { const size_t off = (size_t)(row0 + r) * DM + q * 512 + lane * 8; const float* xs = &x[r][q * 8];
                    if (XO) { const u32x4v w = (u32x4v){pack2(xs[0], xs[1]), pack2(xs[2], xs[3]), pack2(xs[4], xs[5]), pack2(xs[6], xs[7])}; __builtin_nontemporal_store(w, (u32x4v*)((bf16_t*)xout_ + off)); un8(w, x[r], q * 8); }
                    else { __builtin_nontemporal_store((f32x4v){xs[0], xs[1], xs[2], xs[3]}, (f32x4v*)((float*)xout_ + off)); __builtin_nontemporal_store((f32x4v){xs[4], xs[5], xs[6], xs[7]}, (f32x4v*)((float*)xout_ + off + 4)); } }
            }
        }
        if (hout) {
            float g[16], sc[16], sh[16];
#pragma unroll
            for (int q = 0; q < 2; ++q) { ld8f(gnext + q * 512 + lane * 8, g, q * 8); ld8f(scale + (size_t)b * 6144 + q * 512 + lane * 8, sc, q * 8); ld8f(shift + (size_t)b * 6144 + q * 512 + lane * 8, sh, q * 8); }
#pragma unroll
            for (int e = 0; e < 16; ++e) g[e] *= (sc[e] + 1.0f);
#pragma unroll
            for (int r = 0; r < RW; ++r) {
                float ss = 0.f;
#pragma unroll
                for (int e = 0; e < 16; ++e) ss += x[r][e] * x[r][e];
                ss = wave_sum(ss); const float rinv = rsqrtf(ss * (1.0f / 1024.0f) + 1e-6f);
#pragma unroll
                for (int q = 0; q < 2; ++q) { float hv[8];
#pragma unroll
                    for (int e = 0; e < 8; ++e) hv[e] = x[r][q * 8 + e] * rinv * g[q * 8 + e] + sh[q * 8 + e];
                    *(u32x4v*)(hout + (size_t)(row0 + r) * DM + q * 512 + lane * 8) = (u32x4v){pack2(hv[0], hv[1]), pack2(hv[2], hv[3]), pack2(hv[4], hv[5]), pack2(hv[6], hv[7])}; }
            }
        }
    }
}
__device__ __forceinline__ void stage_sconv(const bf16_t* PT, int col, int b0, float w0, float w1, float w2, float bs, float* gl, int t) {
    const int rsel = t >> 7, seg = t & 127;
#pragma unroll
    for (int q = 0; q < 2; ++q) {
        const int e0 = q * 2048 + seg * 16; const bf16_t* row = PT + ((size_t)(b0 + rsel) * NPT + col) * SEQ + e0;
        const u32x4v A = *(const u32x4v*)row, B = *(const u32x4v*)(row + 8);
        float e[18]; e[0] = e0 ? bf2f(row[-1]) : 0.f; e[17] = (e0 + 16 < SEQ) ? bf2f(row[16]) : 0.f;
        e[1] = __uint_as_float(A.x << 16); e[2] = __uint_as_float(A.x & 0xffff0000u); e[3] = __uint_as_float(A.y << 16); e[4] = __uint_as_float(A.y & 0xffff0000u);
        e[5] = __uint_as_float(A.z << 16); e[6] = __uint_as_float(A.z & 0xffff0000u); e[7] = __uint_as_float(A.w << 16); e[8] = __uint_as_float(A.w & 0xffff0000u);
        e[9] = __uint_as_float(B.x << 16); e[10] = __uint_as_float(B.x & 0xffff0000u); e[11] = __uint_as_float(B.y << 16); e[12] = __uint_as_float(B.y & 0xffff0000u);
        e[13] = __uint_as_float(B.z << 16); e[14] = __uint_as_float(B.z & 0xffff0000u); e[15] = __uint_as_float(B.w << 16); e[16] = __uint_as_float(B.w & 0xffff0000u);
        f32x4v* o = (f32x4v*)(gl + rsel * SEQ + e0);
#pragma unroll
        for (int u = 0; u < 4; ++u) { f32x4v v;
            v.x = bs + e[4 * u] * w0 + e[4 * u + 1] * w1 + e[4 * u + 2] * w2; v.y = bs + e[4 * u + 1] * w0 + e[4 * u + 2] * w1 + e[4 * u + 3] * w2;
            v.z = bs + e[4 * u + 2] * w0 + e[4 * u + 3] * w1 + e[4 * u + 4] * w2; v.w = bs + e[4 * u + 3] * w0 + e[4 * u + 4] * w1 + e[4 * u + 5] * w2; o[u] = v; }
    }
}
__device__ __forceinline__ void store_rows2(const float (&v0)[16], const float (&v1)[16], bf16_t* st, bf16_t* o0, bf16_t* o1, int tv) {
#pragma unroll
    for (int j = 0; j < 16; ++j) { const unsigned w = pack2(v0[j], v1[j]); st[tv + 256 * j] = (bf16_t)(w & 0xffffu); st[SEQ + tv + 256 * j] = (bf16_t)(w >> 16); }
    __syncthreads();
    const int r = tv >> 7, seg = tv & 127; bf16_t* o = r ? o1 : o0;
#pragma unroll
    for (int q = 0; q < 4; ++q) *(u32x4v*)(o + q * 1024 + seg * 8) = *(const u32x4v*)(st + r * SEQ + q * 1024 + seg * 8);
}
__device__ __forceinline__ void ph_mix(const Params& P, int l, float* lds, const int wid_s) {
    const int tid = opaque_tid(), hh = tid >> 8, t = tid & 255;
    f32x4v* buf = (f32x4v*)lds + hh * PBUF; float* gl = (float*)buf;
    const f32x2v* TW = (const f32x2v*)(P.ws + WS_TW); const unsigned char* KF = P.ws + WS_KF; unsigned char* kfl = (unsigned char*)lds + LDS_KF;
    const bf16_t* PT = (const bf16_t*)(P.ws + WS_PT); bf16_t* YT = (bf16_t*)(P.ws + WS_YT);
    const float* sw = P.in[I_SW] + (size_t)l * 3 * 1536; const float* sb = P.in[I_SB] + (size_t)l * 1536;
    if ((int)blockIdx.x * 2 < DH * 8) kf_dma(KF + (size_t)(blockIdx.x >> 2) * 32768, kfl, tid);
    for (int it0 = blockIdx.x * 2; it0 < DH * 8; it0 += gridDim.x * 2) {
        const int it = it0 + hh, c = it >> 3, bp = it & 7, b0 = 2 * bp;
        int tv = t; asm volatile("" : "+v"(tv));
        float zr[16], zi[16];
        __syncthreads();
        stage_sconv(PT, c, b0, sw[c], sw[1536 + c], sw[3072 + c], sb[c], gl, tv);
        __syncthreads();
#pragma unroll
        for (int j = 0; j < 16; ++j) { zr[j] = gl[tv + 256 * j]; zi[j] = gl[SEQ + tv + 256 * j]; }
#pragma unroll 1
        for (int n = 0; n < 2; ++n) {
            f32x2v wt = TW[tv]; asm volatile("" : "+v"(wt.x), "+v"(wt.y));
            f32x2v xr[16], xi[16];
#pragma unroll
            for (int j = 0; j < 16; ++j) { const f32x2v wj = w32(j); const float wx = wt.x * wj.x - wt.y * wj.y, wy = wt.x * wj.y + wt.y * wj.x;
                xr[j] = (f32x2v){zr[j], zr[j] * wx - zi[j] * wy}; xi[j] = (f32x2v){zi[j], zr[j] * wy + zi[j] * wx}; }
            fft4096_pk(xr, xi, buf, tv, TW);
#pragma unroll
            for (int j = 0; j < 16; ++j) asm volatile("" : "+v"(xr[j]), "+v"(xi[j]));
            asm volatile("s_waitcnt vmcnt(0)" ::: "memory"); __syncthreads();
#pragma unroll
            for (int j = 0; j < 16; ++j) { const f16x4v k = *(const f16x4v*)(kfl + (tv + 256 * j) * 8); const f32x2v kr = (f32x2v){(float)k.x, (float)k.y}, ki = (f32x2v){(float)k.z, (float)k.w};
                const f32x2v pr = xr[j] * kr - xi[j] * ki, pi = xr[j] * ki + xi[j] * kr; xr[j] = pr; xi[j] = -pi; }
            __syncthreads();
            { const int cn = (n == 0) ? c : ((it0 + (int)gridDim.x * 2) >> 3);
              if (n == 0 || it0 + (int)gridDim.x * 2 < DH * 8) kf_dma(KF + (size_t)((1 - n) * DH + cn) * 32768, kfl, tid); }
            fft4096_pk(xr, xi, buf, tv, TW);
            const int col = (n + 1) * DH + c;
            __syncthreads();
            stage_sconv(PT, col, b0, sw[col] * (1.0f / 8192.0f), sw[1536 + col] * (1.0f / 8192.0f), sw[3072 + col] * (1.0f / 8192.0f), sb[col] * (1.0f / 8192.0f), gl, tv);
            __syncthreads();
#pragma unroll
            for (int j = 0; j < 16; ++j) { const int m = tv + 256 * j; const f32x2v wj = w32(j); const float wx = wt.x * wj.x - wt.y * wj.y, wy = wt.x * wj.y + wt.y * wj.x;
                const float er = xr[j].x, ei = -xi[j].x, orr = xr[j].y, oi = -xi[j].y;
                const float cr = er + (orr * wx + oi * wy), ci = ei + (oi * wx - orr * wy);
                zr[j] = gl[m] * cr; zi[j] = gl[SEQ + m] * ci; }
        }
        bf16_t* o0 = YT + ((size_t)b0 * DM + c) * SEQ;
        store_rows2(zr, zi, (bf16_t*)(gl + 2 * SEQ), o0, o0 + (size_t)DM * SEQ, tv);
    }
#ifndef REP_FNET
#define REP_FNET 1
#endif
    for (int rep = 0; rep < REP_FNET; ++rep)
    for (int it0 = blockIdx.x * 2; it0 < NB * DH / 2; it0 += gridDim.x * 2) {
        const int s = 2 * (it0 + hh), b = s >> 9, ch = s & 511;
        int tv = t; asm volatile("" : "+v"(tv));
        const bf16_t* ra = PT + ((size_t)b * NPT + 1536 + ch) * SEQ; const bf16_t* rb = PT + ((size_t)b * NPT + 2048 + ch) * SEQ;
        bf16_t* sta = (bf16_t*)gl; bf16_t* stb = sta + 2 * SEQ;
        __syncthreads();
        { u32x4v va[4], vb[4];
#pragma unroll
          for (int q = 0; q < 4; ++q) { va[q] = *(const u32x4v*)(ra + (q * 256 + tv) * 8); vb[q] = *(const u32x4v*)(rb + (q * 256 + tv) * 8); }
#pragma unroll
          for (int q = 0; q < 4; ++q) { *(u32x4v*)(sta + (q * 256 + tv) * 8) = va[q]; *(u32x4v*)(stb + (q * 256 + tv) * 8) = vb[q]; } }
        __syncthreads();
        f32x2v xr[16], xi[16];
#pragma unroll
        for (int j = 0; j < 16; ++j) { const int m = tv + 256 * j; xr[j] = (f32x2v){bf2f(sta[m]), bf2f(sta[SEQ + m])}; xi[j] = (f32x2v){-bf2f(stb[m]), -bf2f(stb[SEQ + m])}; }
        fft4096_pk(xr, xi, buf, tv, TW);
        float o0v[16], o1v[16];
#pragma unroll
        for (int j = 0; j < 16; ++j) { o0v[j] = xr[j].x; o1v[j] = xr[j].y; }
        __syncthreads();
        bf16_t* o = YT + ((size_t)b * DM + 512 + ch) * SEQ;
        store_rows2(o0v, o1v, (bf16_t*)gl, o, o + SEQ, tv);
    }
    __syncthreads();
}
__device__ __forceinline__ void ph_transpose(const Params& P, float* lds, const int wid_s) {
    const int tid = opaque_tid(); bf16_t* tile = (bf16_t*)lds;
    const bf16_t* YT = (const bf16_t*)(P.ws + WS_YT); bf16_t* Y = (bf16_t*)(P.ws + WS_Y);
    for (int it = blockIdx.x; it < NB * 2 * 64; it += gridDim.x) {
        const int b = it >> 7, cq = (it >> 6) & 1, lt = it & 63;
        { const int r = tid >> 3, q = tid & 7; u32x4v v[8];
#pragma unroll
          for (int u = 0; u < 8; ++u) v[u] = *(const u32x4v*)(YT + ((size_t)b * DM + cq * 512 + u * 64 + r) * SEQ + lt * 64 + q * 8);
#pragma unroll
          for (int u = 0; u < 8; ++u) *(u32x4v*)(tile + (u * 64 + r) * 72 + q * 8) = v[u]; }
        __syncthreads();
        { const int lr = tid >> 3, q = tid & 7;
#pragma unroll
          for (int u = 0; u < 8; ++u) { unsigned w[4];
#pragma unroll
            for (int i = 0; i < 4; ++i) w[i] = (unsigned)tile[(u * 64 + q * 8 + 2 * i) * 72 + lr] | ((unsigned)tile[(u * 64 + q * 8 + 2 * i + 1) * 72 + lr] << 16);
            *(u32x4v*)(Y + ((size_t)b * SEQ + lt * 64 + lr) * DM + cq * 512 + u * 64 + q * 8) = (u32x4v){w[0], w[1], w[2], w[3]}; } }
        __syncthreads();
    }
}
__device__ __forceinline__ void unpack8(const u32x4v w, float (&f)[8]) {
    f[0] = __uint_as_float(w.x << 16); f[1] = __uint_as_float(w.x & 0xffff0000u); f[2] = __uint_as_float(w.y << 16); f[3] = __uint_as_float(w.y & 0xffff0000u);
    f[4] = __uint_as_float(w.z << 16); f[5] = __uint_as_float(w.z & 0xffff0000u); f[6] = __uint_as_float(w.w << 16); f[7] = __uint_as_float(w.w & 0xffff0000u);
}
__device__ __forceinline__ void ph_geglu(const Params& P, int l, const int wid_s) {
    const bf16_t* U = (const bf16_t*)(P.ws + WS_U); bf16_t* G = (bf16_t*)(P.ws + WS_G);
    const float* dww = P.in[I_DWW] + (size_t)l * 3 * DUP; const float* dwb = P.in[I_DWB] + (size_t)l * DUP;
    const int tid = opaque_tid();
    if (tid < DFF / 8) {
        const int f0 = tid * 8;
        float wa[3][8], wb[3][8], ba[8], bb[8];
#pragma unroll
        for (int k = 0; k < 3; ++k) { const f32x4v a0 = *(const f32x4v*)(dww + k * DUP + f0), a1 = *(const f32x4v*)(dww + k * DUP + f0 + 4), b0 = *(const f32x4v*)(dww + k * DUP + DFF + f0), b1 = *(const f32x4v*)(dww + k * DUP + DFF + f0 + 4);
            wa[k][0] = a0.x; wa[k][1] = a0.y; wa[k][2] = a0.z; wa[k][3] = a0.w; wa[k][4] = a1.x; wa[k][5] = a1.y; wa[k][6] = a1.z; wa[k][7] = a1.w;
            wb[k][0] = b0.x; wb[k][1] = b0.y; wb[k][2] = b0.z; wb[k][3] = b0.w; wb[k][4] = b1.x; wb[k][5] = b1.y; wb[k][6] = b1.z; wb[k][7] = b1.w; }
        { const f32x4v a0 = *(const f32x4v*)(dwb + f0), a1 = *(const f32x4v*)(dwb + f0 + 4), b0 = *(const f32x4v*)(dwb + DFF + f0), b1 = *(const f32x4v*)(dwb + DFF + f0 + 4);
          ba[0] = a0.x; ba[1] = a0.y; ba[2] = a0.z; ba[3] = a0.w; ba[4] = a1.x; ba[5] = a1.y; ba[6] = a1.z; ba[7] = a1.w; bb[0] = b0.x; bb[1] = b0.y; bb[2] = b0.z; bb[3] = b0.w; bb[4] = b1.x; bb[5] = b1.y; bb[6] = b1.z; bb[7] = b1.w; }
        const u32x4v zero = (u32x4v){0u, 0u, 0u, 0u};
        for (int blk = blockIdx.x; blk < HTOK / 128; blk += gridDim.x) {
            const int rbeg = blk * 128; const bool halo_lo = (rbeg & (SEQ - 1)) != 0, halo_hi = ((rbeg + 128) & (SEQ - 1)) != 0;
            const bf16_t* ua = U + (size_t)rbeg * DUP + f0; const bf16_t* ub = ua + DFF; bf16_t* go = G + (size_t)rbeg * DFF + f0;
            u32x4v ra[4], rb[4];
#pragma unroll
            for (int j = 0; j < 4; ++j) { ra[j] = __builtin_nontemporal_load((const u32x4v*)(ua + (size_t)j * DUP)); rb[j] = __builtin_nontemporal_load((const u32x4v*)(ub + (size_t)j * DUP)); }
            float pa[8], pb[8], ca[8], cb[8], na[8], nb[8];
            { const u32x4v ha = halo_lo ? *(const u32x4v*)(ua - DUP) : zero, hb = halo_lo ? *(const u32x4v*)(ub - DUP) : zero; unpack8(ha, pa); unpack8(hb, pb); }
            unpack8(ra[0], ca); unpack8(rb[0], cb);
            for (int o = 0; o < 32; ++o) {
#pragma unroll
                for (int j = 0; j < 4; ++j) {
                    const int s = o * 4 + j;
                    { const bool last = (o == 31) && (j == 3); const bool ok = !last || halo_hi; unpack8(ok ? ra[(j + 1) & 3] : zero, na); unpack8(ok ? rb[(j + 1) & 3] : zero, nb); }
                    if (o < 31 || j == 0) { const int rr = (s + 4 < HTOK - rbeg) ? s + 4 : s;
                        ra[j] = __builtin_nontemporal_load((const u32x4v*)(ua + (size_t)rr * DUP)); rb[j] = __builtin_nontemporal_load((const u32x4v*)(ub + (size_t)rr * DUP)); }
                    float ov[8];
#pragma unroll
                    for (int e = 0; e < 8; e += 2) {
                        const f32x2v av = (f32x2v){ba[e] + pa[e] * wa[0][e] + ca[e] * wa[1][e] + na[e] * wa[2][e], ba[e + 1] + pa[e + 1] * wa[0][e + 1] + ca[e + 1] * wa[1][e + 1] + na[e + 1] * wa[2][e + 1]};
                        const f32x2v gv = pg8::gelu_pk(av);
                        ov[e] = gv.x * (bb[e] + pb[e] * wb[0][e] + cb[e] * wb[1][e] + nb[e] * wb[2][e]);
                        ov[e + 1] = gv.y * (bb[e + 1] + pb[e + 1] * wb[0][e + 1] + cb[e + 1] * wb[1][e + 1] + nb[e + 1] * wb[2][e + 1]); }
                    *(u32x4v*)(go + (size_t)s * DFF) = (u32x4v){pack2(ov[0], ov[1]), pack2(ov[2], ov[3]), pack2(ov[4], ov[5]), pack2(ov[6], ov[7])};
#pragma unroll
                    for (int e = 0; e < 8; ++e) { pa[e] = ca[e]; pb[e] = cb[e]; ca[e] = na[e]; cb[e] = nb[e]; }
                }
            }
        }
    }
}
constexpr int N_PHASES = 2 + 11 * DEPTH;
#ifndef NT_MODE
#define NT_MODE 1
#endif
#define NT_MASK(ld) ((NT_MODE == 1) ? ((ld) == DUP) : (NT_MODE == 2 ? 1 : 0))
#ifndef REP_PRO
#define REP_PRO 1
#endif
#ifndef REP_MIX
#define REP_MIX 1
#endif
#ifndef REP_GEGLU
#define REP_GEGLU 1
#endif
#ifndef REP_TR
#define REP_TR 1
#endif
#ifndef REP_GEMM
#define REP_GEMM 1
#endif
#ifndef MK_MULTI_LAUNCH
#define MK_MULTI_LAUNCH 0
#endif
__global__ __launch_bounds__(512, 2) void mk_fwd(Params P) {
    extern __shared__ __attribute__((aligned(16))) unsigned char smem[];
    float* lds = (float*)smem;
    cg::grid_group grid = cg::this_grid();
    const int wid_s = __builtin_amdgcn_readfirstlane((int)threadIdx.x >> 6);
    unsigned xst0 = 0u, xst1 = 0u;
    const XcdBarrier xb = xcd_barrier_post((unsigned*)(P.ws + WS_BAR), nullptr);
    bf16_t* H = (bf16_t*)(P.ws + WS_H);
    bf16_t* XB = (bf16_t*)(P.ws + WS_XB);
    for (int ph = P.ph_lo; ph < P.ph_hi; ++ph) {
        if (ph > P.ph_lo) { if (ph == 1) grid.sync(); else { xcd_barrier(xb, xst0, xst1, wid_s == 0 && lane_now() == 0); xst0 = __builtin_amdgcn_readfirstlane(xst0); xst1 = __builtin_amdgcn_readfirstlane(xst1); } }
        const int l = ph >= 2 ? (ph - 2) / 11 : -1, k = ph >= 2 ? (ph - 2) % 11 : -1;
        int ng = 0;
        if (ph == 0) { ph_tconv(P, lds, wid_s); ph_fold(P, lds, wid_s); ph_mod(P, lds, wid_s); ph_tw(P, wid_s); ph_fh2(P, lds, wid_s); }
        else if (ph == 1) { ph_h3t(P, 0, lds, wid_s); ph_resnorm<0, 0>(P.in[I_X], nullptr, nullptr, nullptr, nullptr, nullptr, P.in[I_GMPRE], modp(P, 0, 1), modp(P, 0, 0), H, wid_s); }
        else if (k == 0) { if (l == 0) ph_kf(P, 0, lds, wid_s); ng = 1; }
        else if (k == 1) { ph_mix(P, l, lds, wid_s); }
        else if (k == 2) { ph_transpose(P, lds, wid_s); if (l + 1 < DEPTH) ph_h3t(P, l + 1, lds, wid_s); }
        else if (k == 3) { ng = 1; }
        else if (k == 4) {
            if (l == 0) ph_resnorm<0, 1>(P.in[I_X], XB, (const bf16_t*)(P.ws + WS_YO), (const bf16_t*)(P.ws + WS_YO) + (size_t)HTOK * DM, P.in[I_GMPOST] + l * DM, modp(P, l, 2), P.in[I_GFPRE] + l * DM, modp(P, l, 4), modp(P, l, 3), H, wid_s);
            else ph_resnorm<1, 1>(XB, XB, (const bf16_t*)(P.ws + WS_YO), (const bf16_t*)(P.ws + WS_YO) + (size_t)HTOK * DM, P.in[I_GMPOST] + l * DM, modp(P, l, 2), P.in[I_GFPRE] + l * DM, modp(P, l, 4), modp(P, l, 3), H, wid_s);
            if (l + 1 < DEPTH) ph_kf(P, l + 1, lds, wid_s); }
        else if (k == 5 || k == 9) { ng = 1; }
        else if (k == 6 || k == 8) { ph_geglu(P, l, wid_s); }
        else if (k == 7) { ng = 2; }
        else { const bool more = (l + 1 < DEPTH);
            if (more) ph_resnorm<1, 1>(XB, XB, (const bf16_t*)(P.ws + WS_YD0), (const bf16_t*)(P.ws + WS_YD1), P.in[I_GFPOST] + l * DM, modp(P, l, 5), P.in[I_GMPRE] + (l + 1) * DM, modp(P, l + 1, 1), modp(P, l + 1, 0), H, wid_s);
            else ph_resnorm<1, 0>(XB, P.out, (const bf16_t*)(P.ws + WS_YD0), (const bf16_t*)(P.ws + WS_YD1), P.in[I_GFPOST] + l * DM, modp(P, l, 5), nullptr, nullptr, nullptr, nullptr, wid_s); }
        for (int gi = 0; gi < ng; ++gi) {
            const bf16_t* gA; const bf16_t* gB; int gM, gN, gK, gld, gsplit = 0; size_t gstride = 0; bf16_t* gO;
            if (k == 0) { gA = wbf(P, l, WL_WIN); gB = H; gM = NPT; gN = NTOK; gK = DM; gO = (bf16_t*)(P.ws + WS_PT); gld = SEQ; gsplit = SEQ; gstride = (size_t)NPT * SEQ; }
            else if (k == 3) { gA = (const bf16_t*)(P.ws + WS_Y); gB = wbf(P, l, WL_WOUT); gM = NTOK; gN = DM; gK = DM; gO = (bf16_t*)(P.ws + WS_YO); gld = DM; }
            else if (k == 5 || (k == 7 && gi == 1)) { const int hf = (k == 7); gA = H + (size_t)hf * HTOK * DM; gB = wbf(P, l, WL_WUP); gM = HTOK; gN = DUP; gK = DM; gO = (bf16_t*)(P.ws + WS_U); gld = DUP; }
            else { const int hf = (k == 9); gA = (const bf16_t*)(P.ws + WS_G); gB = wbf(P, l, WL_WDN); gM = HTOK; gN = DM; gK = DFF; gO = (bf16_t*)(P.ws + (hf ? WS_YD1 : WS_YD0)); gld = DM; }
            __syncthreads();
            pg8::Gemm g{gA, gB, gM, gN, gK}; pg8::StaticOrder S; S.init(gM, gN, (int)gridDim.x, (int)blockIdx.x);
            pg8::EpiBf16<0> E{gO, gld, nullptr, gsplit, gstride, gld == DUP};
            pg8::gemm_phase<pg8::EpiBf16<0>, pg8::StaticOrder, false>((PG8_LAS unsigned char*)smem, g, S, E, nullptr, wid_s);
            __syncthreads();
        }
    }
}

extern "C" void kernel_launch(void* const* d_in, const int* in_sizes, int n_in, void* d_out, int out_size, void* d_ws, size_t ws_size, hipStream_t stream) {
    static int grid = 0;
    if (grid == 0) {
        if (n_in != 24 || out_size != NTOK * DM || ws_size < WS_NEED) { fprintf(stderr, "kernel_launch: unexpected shapes (n_in %d out %d ws %zu need %zu)\n", n_in, out_size, ws_size, (size_t)WS_NEED); grid = -1; return; }
        int dev = 0, cus = 0, per_cu = 0;
        hipGetDevice(&dev); hipDeviceGetAttribute(&cus, hipDeviceAttributeMultiprocessorCount, dev);
        if (hipFuncSetAttribute((const void*)mk_fwd, hipFuncAttributeMaxDynamicSharedMemorySize, LDS_BYTES) != hipSuccess) { fprintf(stderr, "kernel_launch: hipFuncSetAttribute failed\n"); grid = -1; return; }
        hipOccupancyMaxActiveBlocksPerMultiprocessor(&per_cu, (const void*)mk_fwd, NTHR, LDS_BYTES);
        (void)hipGetLastError();
        if (per_cu < 1) fprintf(stderr, "kernel_launch: occupancy query says %d blocks per CU\n", per_cu);
        grid = cus > 0 ? cus : 256;
    }
    if (grid < 0) return;
    Params p{};
    for (int i = 0; i < 24; ++i) p.in[i] = (const float*)d_in[i];
    p.out = (float*)d_out; p.ws = (unsigned char*)d_ws;
#if MK_MULTI_LAUNCH
    for (int ph = 0; ph < N_PHASES; ++ph) { p.ph_lo = ph; p.ph_hi = ph + 1; hipLaunchKernelGGL(mk_fwd, dim3(grid), dim3(NTHR), LDS_BYTES, stream, p); }
#else
    p.ph_lo = 0; p.ph_hi = N_PHASES;
    if (hipMemsetAsync((unsigned char*)d_ws + WS_BAR, 0, XCD_BAR_WORDS * 4, stream) != hipSuccess) { fprintf(stderr, "kernel_launch: memset of the barrier words failed\n"); return; }
    void* args[] = {&p};
    hipError_t e = hipLaunchCooperativeKernel((const void*)mk_fwd, dim3(grid), dim3(NTHR), args, LDS_BYTES, stream);
    if (e != hipSuccess) fprintf(stderr, "cooperative launch failed: %s (grid %d)\n", hipGetErrorString(e), grid);
#endif
}
```
